# Optimizing an MI355X kernel written in HIP

```python
import jax, jax.numpy as jnp
from jax import lax
import numpy as np

D_MODEL = 1024
BATCH = 16
SEQ = 256
DEPTH = 4
DEC_BATCH = 8
DEC_SEQ = 1024
PAST_LEN = 256

GRID_W = 64
A_W = D_MODEL // 2
NA_HEADS = 8
NA_DH = (D_MODEL // 2) // NA_HEADS
NA_W = NA_HEADS * NA_DH
KH_MAX = 8
KW = 16
QB = 16
KB = QB + KW
POOL_W = D_MODEL // 2
POOL_WINDOWS = (2, 4, 8, 16)
N_POOL_GROUPS = 4
POOL_G = POOL_W // N_POOL_GROUPS
MLA_HEADS = 8
NOPE = 64
ROPE = 32
QK_DIM = NOPE + ROPE
V_DIM = 64
Q_LORA = 384
KV_LORA = 256
ROPE_BASE = 10000.0
MLP_HIDDEN = 4 * D_MODEL
N_EVEN = (DEPTH + 1) // 2
N_ODD = DEPTH // 2
Q_BLOCK = 128
DENSE_KEY_LIMIT = 1024
NEG_INF = -1e30
EPS = 1e-6

kernel_name = "hybrid_dit_prefix_ctx_step"


def rms_norm(x, g):
    xf = x.astype(jnp.float32)
    y = xf * lax.rsqrt(jnp.mean(xf * xf, axis=-1, keepdims=True) + EPS)
    return (y * g.astype(jnp.float32)).astype(x.dtype)


def ada_mod(s, w, b):
    m = (s @ w + b)[:, None, :]
    return jnp.split(m, 6, axis=-1)


def modulate(x, g, shift, scale):
    return rms_norm(x, g) * (1 + scale) + shift


def sq_relu_mlp(h, w1, w2):
    a = jax.nn.relu(h @ w1)
    return (a * a) @ w2


def short_conv(u, w):
    up = jnp.pad(u, ((0, 0), (1, 1), (0, 0)))
    return up[:, :-2] * w[0] + up[:, 1:-1] * w[1] + up[:, 2:] * w[2]


def pool_mixer(u, w_groups, scale):
    B, L, _ = u.shape
    ug = u.reshape(B, L, N_POOL_GROUPS, POOL_G)
    cs = jnp.pad(jnp.cumsum(ug.astype(jnp.float32), axis=1), ((0, 0), (1, 0), (0, 0), (0, 0)))
    t = jnp.arange(L)
    means = []
    for g, w in enumerate(POOL_WINDOWS):
        lo = jnp.clip(t - w // 2, 0, L)
        hi = jnp.clip(t - w // 2 + w, 0, L)
        s = cs[:, hi, g] - cs[:, lo, g]
        means.append(s / (hi - lo).astype(jnp.float32)[None, :, None])
    pooled = jnp.stack(means, axis=2).astype(u.dtype)
    y = jnp.einsum('blgc,gcd->blgd', pooled - ug, w_groups).reshape(B, L, POOL_W)
    return y * scale


def axial_rope(n):
    t = jnp.arange(n)
    row = (t // GRID_W).astype(jnp.float32)
    col = (t % GRID_W).astype(jnp.float32)
    axis_dim = ROPE // 2
    inv = 1.0 / (ROPE_BASE ** (jnp.arange(0, axis_dim, 2, dtype=jnp.float32) / axis_dim))
    ang = jnp.concatenate([row[:, None] * inv, col[:, None] * inv], axis=-1)
    return jnp.cos(ang), jnp.sin(ang)


def apply_rope(x, cos, sin):
    x1, x2 = x[..., :ROPE // 2], x[..., ROPE // 2:]
    c = cos[None, :, None, :].astype(x.dtype)
    s = sin[None, :, None, :].astype(x.dtype)
    return jnp.concatenate([x1 * c - x2 * s, x2 * c + x1 * s], axis=-1)


def rope_heads(x, cos, sin):
    return jnp.concatenate([x[..., :NOPE], apply_rope(x[..., NOPE:], cos, sin)], axis=-1)


def dense_attn(q, k, v):
    B, Lq, H, d = q.shape
    Lk = k.shape[1]
    scale = d ** -0.5

    def attend(qb):
        s = jnp.einsum('bqhd,bkhd->bhqk', qb, k).astype(jnp.float32) * scale
        p = jax.nn.softmax(s, axis=-1).astype(v.dtype)
        return jnp.einsum('bhqk,bkhd->bqhd', p, v)

    if Lk < DENSE_KEY_LIMIT:
        return attend(q)
    nb = Lq // Q_BLOCK
    qb = jnp.moveaxis(q.reshape(B, nb, Q_BLOCK, H, d), 1, 0)
    out = lax.map(attend, qb)
    return jnp.moveaxis(out, 0, 1).reshape(B, Lq, H, v.shape[-1])


def na_latent(q, k, v, k_ctx, v_ctx, rpb):
    B, N, H, dh = q.shape
    R = N // GRID_W
    KH = min(KH_MAX, R)
    NCB = GRID_W // QB
    scale = dh ** -0.5
    qg = q.reshape(B, R, NCB, QB, H, dh)
    kg = k.reshape(B, R, GRID_W, H, dh)
    vg = v.reshape(B, R, GRID_W, H, dh)
    r = jnp.arange(R)
    rows_idx = jnp.clip(r - KH // 2, 0, R - KH)[:, None] + jnp.arange(KH)
    col_start = jnp.clip(jnp.arange(GRID_W) - KW // 2, 0, GRID_W - KW)
    j = jnp.arange(NCB)
    cols_idx = jnp.clip(j * QB - KW // 2, 0, GRID_W - KB)[:, None] + jnp.arange(KB)
    kb = kg[:, rows_idx][:, :, :, cols_idx]
    vb = vg[:, rows_idx][:, :, :, cols_idx]
    s_loc = jnp.einsum('brcqhd,brkcjhd->bhrcqkj', qg, kb).astype(jnp.float32) * scale
    qcol = (j * QB)[:, None] + jnp.arange(QB)
    qcs = col_start[qcol]
    keycol = cols_idx[:, None, :]
    valid = (keycol >= qcs[:, :, None]) & (keycol < qcs[:, :, None] + KW)
    dr = rows_idx - r[:, None] + KH_MAX - 1
    dc = jnp.clip(keycol - qcol[:, :, None] + KW - 1, 0, 2 * KW - 2)
    bias = rpb[:, dr[:, None, None, :, None], dc[None, :, :, None, :]]
    s_loc = s_loc + bias[None].astype(jnp.float32)
    s_loc = jnp.where(valid[:, :, None, :], s_loc, NEG_INF).reshape(B, H, R, NCB, QB, KH * KB)
    s_ctx = jnp.einsum('brcqhd,bmhd->bhrcqm', qg, k_ctx).astype(jnp.float32) * scale
    p = jax.nn.softmax(jnp.concatenate([s_loc, s_ctx], axis=-1), axis=-1)
    p_loc = p[..., :KH * KB].reshape(B, H, R, NCB, QB, KH, KB).astype(v.dtype)
    p_ctx = p[..., KH * KB:].astype(v.dtype)
    out = (jnp.einsum('bhrcqkj,brkcjhd->brcqhd', p_loc, vb)
           + jnp.einsum('bhrcqm,bmhd->brcqhd', p_ctx, v_ctx))
    return out.reshape(B, N, H * dh)


def even_proj(h, w_in, conv_w, gq, gk):
    B, L, _ = h.shape
    bg, cg, xa, q, k, v = jnp.split(h @ w_in, 6, axis=-1)
    a = bg * short_conv(cg * xa, conv_w)
    q = rms_norm(q.reshape(B, L, NA_HEADS, NA_DH), gq)
    k = rms_norm(k.reshape(B, L, NA_HEADS, NA_DH), gk)
    v = v.reshape(B, L, NA_HEADS, NA_DH)
    return a, q, k, v


def odd_proj(h, w_in, pool_w, pool_scale, q_a_norm, w_q_b, kv_a_norm, gq):
    B, L, _ = h.shape
    u, q_lat, kv_lat, kpe = jnp.split(
        h @ w_in, [POOL_W, POOL_W + Q_LORA, POOL_W + Q_LORA + KV_LORA], axis=-1)
    p = pool_mixer(u, pool_w, pool_scale)
    q = (rms_norm(q_lat, q_a_norm) @ w_q_b).reshape(B, L, MLA_HEADS, QK_DIM)
    q = rms_norm(q, gq)
    ckv = rms_norm(kv_lat, kv_a_norm)
    return p, q, ckv, kpe


def mla_kv(ckv, kpe, w_kv_b, gk):
    B, L, _ = ckv.shape
    kv = (ckv @ w_kv_b).reshape(B, L, MLA_HEADS, NOPE + V_DIM)
    k_nope, v = kv[..., :NOPE], kv[..., NOPE:]
    k = jnp.concatenate(
        [k_nope, jnp.broadcast_to(kpe[:, :, None, :], (B, L, MLA_HEADS, ROPE))], axis=-1)
    return rms_norm(k, gk), v


def setup_inputs(seed: int = 0) -> dict:
    key = jax.random.key(seed)
    ks = jax.random.split(key, 32)
    f32 = jnp.float32

    def nrm(k, shape, scale=1.0):
        return jax.random.normal(k, shape, f32) * scale

    def gain(k, shape):
        return 1.0 + 0.1 * jax.random.normal(k, shape, f32)

    D = D_MODEL
    even_in = 3 * A_W + 3 * NA_W
    odd_in = POOL_W + Q_LORA + KV_LORA + ROPE
    return {
        "x_prompt": nrm(ks[0], (BATCH, SEQ, D)),
        "x_sample": nrm(ks[1], (DEC_BATCH, DEC_SEQ, D)),
        "cache_na_k": nrm(ks[2], (DEC_BATCH, N_EVEN, PAST_LEN, NA_HEADS, NA_DH)),
        "cache_na_v": nrm(ks[3], (DEC_BATCH, N_EVEN, PAST_LEN, NA_HEADS, NA_DH)),
        "cache_mla_ckv": nrm(ks[4], (DEC_BATCH, N_ODD, PAST_LEN, KV_LORA)),
        "cache_mla_kpe": nrm(ks[5], (DEC_BATCH, N_ODD, PAST_LEN, ROPE)),
        "c": nrm(ks[6], (DEC_BATCH, D)),
        "c_ctx": nrm(ks[7], (D,)),
        "ada_w": nrm(ks[8], (DEPTH, D, 6 * D), 0.5 * D ** -0.5),
        "ada_b": nrm(ks[9], (DEPTH, 6 * D), 0.02),
        "norm1_g": gain(ks[10], (DEPTH, D)),
        "norm2_g": gain(ks[11], (DEPTH, D)),
        "mlp_w1": nrm(ks[12], (DEPTH, D, MLP_HIDDEN), D ** -0.5),
        "mlp_w2": nrm(ks[13], (DEPTH, MLP_HIDDEN, D), MLP_HIDDEN ** -0.5),
        "even_w_in": nrm(ks[14], (N_EVEN, D, even_in), D ** -0.5),
        "even_conv_w": nrm(ks[15], (N_EVEN, 3, A_W), 3 ** -0.5),
        "na_q_norm": gain(ks[16], (N_EVEN, NA_DH)),
        "na_k_norm": gain(ks[17], (N_EVEN, NA_DH)),
        "na_rpb": nrm(ks[18], (N_EVEN, NA_HEADS, 2 * KH_MAX - 1, 2 * KW - 1), 0.1),
        "even_w_out": nrm(ks[19], (N_EVEN, A_W + NA_W, D), (A_W + NA_W) ** -0.5),
        "odd_w_in": nrm(ks[20], (N_ODD, D, odd_in), D ** -0.5),
        "pool_w": nrm(ks[21], (N_ODD, N_POOL_GROUPS, POOL_G, POOL_G), POOL_G ** -0.5),
        "pool_scale": gain(ks[22], (N_ODD, POOL_W)),
        "q_a_norm": gain(ks[23], (N_ODD, Q_LORA)),
        "w_q_b": nrm(ks[24], (N_ODD, Q_LORA, MLA_HEADS * QK_DIM), Q_LORA ** -0.5),
        "kv_a_norm": gain(ks[25], (N_ODD, KV_LORA)),
        "w_kv_b": nrm(ks[26], (N_ODD, KV_LORA, MLA_HEADS * (NOPE + V_DIM)), KV_LORA ** -0.5),
        "mla_q_norm": gain(ks[27], (N_ODD, QK_DIM)),
        "mla_k_norm": gain(ks[28], (N_ODD, QK_DIM)),
        "odd_w_out": nrm(ks[29], (N_ODD, POOL_W + MLA_HEADS * V_DIM, D), (POOL_W + MLA_HEADS * V_DIM) ** -0.5),
    }


def reference(x_prompt, x_sample, cache_na_k, cache_na_v, cache_mla_ckv, cache_mla_kpe, c, c_ctx,
              ada_w, ada_b, norm1_g, norm2_g, mlp_w1, mlp_w2,
              even_w_in, even_conv_w, na_q_norm, na_k_norm, na_rpb, even_w_out,
              odd_w_in, pool_w, pool_scale, q_a_norm, w_q_b, kv_a_norm, w_kv_b,
              mla_q_norm, mla_k_norm, odd_w_out):
    Bp, Lp, _ = x_prompt.shape
    Bs, Ls, _ = x_sample.shape
    cos, sin = axial_rope(Ls)
    s_ctx = jax.nn.silu(c_ctx)[None, :]
    s_lat = jax.nn.silu(c)
    yp, ys = x_prompt, x_sample
    new_na_k, new_na_v, new_ckv, new_kpe = [], [], [], []
    for l in range(DEPTH):
        sh1p, sc1p, g1p, sh2p, sc2p, g2p = ada_mod(s_ctx, ada_w[l], ada_b[l])
        sh1s, sc1s, g1s, sh2s, sc2s, g2s = ada_mod(s_lat, ada_w[l], ada_b[l])
        hp = modulate(yp, norm1_g[l], sh1p, sc1p)
        hs = modulate(ys, norm1_g[l], sh1s, sc1s)
        i = l // 2
        if l % 2 == 0:
            ap, qp, kp, vp = even_proj(hp, even_w_in[i], even_conv_w[i], na_q_norm[i], na_k_norm[i])
            att_p = dense_attn(qp, kp, vp).reshape(Bp, Lp, NA_W)
            mix_p = jnp.concatenate([ap, att_p], axis=-1) @ even_w_out[i]
            new_na_k.append(kp)
            new_na_v.append(vp)
            a_s, qs, k_s, vs = even_proj(hs, even_w_in[i], even_conv_w[i], na_q_norm[i], na_k_norm[i])
            att_s = na_latent(qs, k_s, vs, cache_na_k[:, i], cache_na_v[:, i], na_rpb[i])
            mix_s = jnp.concatenate([a_s, att_s], axis=-1) @ even_w_out[i]
        else:
            pp, qp, ckvp, kpep = odd_proj(hp, odd_w_in[i], pool_w[i], pool_scale[i], q_a_norm[i],
                                          w_q_b[i], kv_a_norm[i], mla_q_norm[i])
            kp, vp = mla_kv(ckvp, kpep, w_kv_b[i], mla_k_norm[i])
            att_p = dense_attn(qp, kp, vp).reshape(Bp, Lp, MLA_HEADS * V_DIM)
            mix_p = jnp.concatenate([pp, att_p], axis=-1) @ odd_w_out[i]
            new_ckv.append(ckvp)
            new_kpe.append(kpep)
            ps, qs, ckvs, kpes = odd_proj(hs, odd_w_in[i], pool_w[i], pool_scale[i], q_a_norm[i],
                                          w_q_b[i], kv_a_norm[i], mla_q_norm[i])
            k_s, vs = mla_kv(ckvs, kpes, w_kv_b[i], mla_k_norm[i])
            qs = rope_heads(qs, cos, sin)
            k_s = rope_heads(k_s, cos, sin)
            kc, vc = mla_kv(cache_mla_ckv[:, i], cache_mla_kpe[:, i], w_kv_b[i], mla_k_norm[i])
            att_s = dense_attn(qs, jnp.concatenate([kc, k_s], axis=1),
                               jnp.concatenate([vc, vs], axis=1)).reshape(Bs, Ls, MLA_HEADS * V_DIM)
            mix_s = jnp.concatenate([ps, att_s], axis=-1) @ odd_w_out[i]
        yp = yp + g1p * mix_p
        ys = ys + g1s * mix_s
        yp = yp + g2p * sq_relu_mlp(modulate(yp, norm2_g[l], sh2p, sc2p), mlp_w1[l], mlp_w2[l])
        ys = ys + g2s * sq_relu_mlp(modulate(ys, norm2_g[l], sh2s, sc2s), mlp_w1[l], mlp_w2[l])
    return (yp, ys, jnp.stack(new_na_k, axis=1), jnp.stack(new_na_v, axis=1),
            jnp.stack(new_ckv, axis=1), jnp.stack(new_kpe, axis=1))
```

```cpp
#include <hip/hip_runtime.h>
#include <hip/hip_cooperative_groups.h>
#include <cstdio>
#include <cstdint>
#include <cstring>
namespace cg = cooperative_groups;

typedef unsigned short bf16_t;
using bf16x8 = __attribute__((ext_vector_type(8))) short;
using f32x16 = __attribute__((ext_vector_type(16))) float;
typedef __bf16 bf16v2 __attribute__((ext_vector_type(2)));
typedef unsigned u32x4 __attribute__((ext_vector_type(4)));
typedef unsigned u32x2 __attribute__((ext_vector_type(2)));
typedef float f32x4 __attribute__((ext_vector_type(4)));
#define DI __device__ __forceinline__
#define MFMA(a, b, c) __builtin_amdgcn_mfma_f32_32x32x16_bf16((a), (b), (c), 0, 0, 0)
#define CROW(i, h) (((i) & 3) + 8 * ((i) >> 2) + 4 * (h))

#ifndef REP_PH0
#define REP_PH0 1
#endif
#ifndef REP_PH1
#define REP_PH1 1
#endif
#ifndef REP_E2
#define REP_E2 1
#endif
#ifndef REP_E3
#define REP_E3 1
#endif
#ifndef REP_O3
#define REP_O3 1
#endif
#ifndef REP_O4
#define REP_O4 1
#endif
#ifndef REP_M1
#define REP_M1 1
#endif
#ifndef REP_MODS
#define REP_MODS 1
#endif
#ifndef REP_WCONV
#define REP_WCONV 1
#endif
#ifndef REP_CACHE
#define REP_CACHE 1
#endif

#ifndef PROBE_M1
#define PROBE_M1 0
#endif
#ifndef REP_PH0
#define REP_PH0 1
#endif
#ifndef REP_PH1
#define REP_PH1 1
#endif
#ifndef REP_E2
#define REP_E2 1
#endif
#ifndef REP_E3
#define REP_E3 1
#endif
#ifndef REP_O2
#define REP_O2 1
#endif
#ifndef REP_O3
#define REP_O3 1
#endif
#ifndef REP_O4
#define REP_O4 1
#endif
#ifndef PROBE_RESID
#define PROBE_RESID 0
#endif
#ifndef PROBE_M2
#define PROBE_M2 0
#endif
constexpr int T = 12288, TP = 4096;
constexpr float EPS = 1e-6f;
constexpr int NTHREADS = 512;
constexpr int NWAVES = 8;
constexpr int SMEM_BYTES = 147456 + 8192;
constexpr int SIDE_OFF = 147456;

constexpr size_t al(size_t x) { return (x + 255) & ~size_t(255); }
constexpr size_t OFF_BAR   = 0;
constexpr size_t OFF_MOD   = 16384;
constexpr size_t OFF_SHW1  = al(OFF_MOD + 4ull * 9 * 6144 * 4);
constexpr size_t OFF_SHW2  = al(OFF_SHW1 + 4ull * 9 * 3072 * 4);
constexpr size_t OFF_SSQ1  = al(OFF_SHW2 + 4ull * 9 * 4096 * 4);
constexpr size_t OFF_SSQ2  = al(OFF_SSQ1 + 16ull * T * 4);
constexpr size_t OFF_SSQQ  = al(OFF_SSQ2 + 16ull * T * 4);
constexpr size_t OFF_SSQKV = al(OFF_SSQQ + 3ull * T * 4);
constexpr size_t OFF_KPE   = al(OFF_SSQKV + 2ull * T * 4);
constexpr size_t OFF_KVRAW = al(OFF_KPE + (size_t)T * 32 * 4);
constexpr size_t OFF_CNK   = al(OFF_KVRAW + 4096ull * 256 * 4);
constexpr size_t OFF_CNVT  = al(OFF_CNK + 2ull * 2048 * 512 * 2);
constexpr size_t OFF_CCKV  = al(OFF_CNVT + 2ull * 2048 * 512 * 2);
constexpr size_t OFF_W1T   = al(OFF_CCKV + 2ull * 2048 * 256 * 2);
constexpr size_t OFF_W2T   = al(OFF_W1T + 4ull * 4096 * 1024 * 2);
constexpr size_t OFF_EWIN  = al(OFF_W2T + 4ull * 4096 * 1024 * 2);
constexpr size_t OFF_EWOUT = al(OFF_EWIN + 2ull * 3072 * 1024 * 2);
constexpr size_t OFF_OWIN  = al(OFF_EWOUT + 2ull * 1024 * 1024 * 2);
constexpr size_t OFF_WQB   = al(OFF_OWIN + 2ull * 1280 * 1024 * 2);
constexpr size_t OFF_WKVB  = al(OFF_WQB + 2ull * 1024 * 384 * 2);
constexpr size_t OFF_OWOUT = al(OFF_WKVB + 2ull * 1024 * 256 * 2);
constexpr size_t OFF_POOLW = al(OFF_OWOUT + 2ull * 1024 * 1024 * 2);
constexpr size_t OFF_ABUF  = al(OFF_POOLW + 2ull * 512 * 512 * 2);
constexpr size_t OFF_CAT   = al(OFF_ABUF + (size_t)T * 1024 * 2);
constexpr size_t OFF_ACT   = al(OFF_CAT + (size_t)T * 1024 * 2);
constexpr size_t WS_NEED   = al(OFF_ACT + (size_t)T * 4096 * 2);
constexpr size_t OFF_BCONV = OFF_ACT;
constexpr size_t OFF_QBUF  = al(OFF_BCONV + (size_t)T * 1536 * 2);
constexpr size_t OFF_KBUF  = al(OFF_QBUF + (size_t)T * 512 * 2);
constexpr size_t OFF_VTP   = al(OFF_KBUF + (size_t)T * 512 * 2);
constexpr size_t OFF_VTS   = al(OFF_VTP + 16ull * 8 * 64 * 256 * 2);
constexpr size_t OFF_UBUF  = OFF_ACT;
constexpr size_t OFF_QLAT  = al(OFF_UBUF + (size_t)T * 512 * 2);
constexpr size_t OFF_KVLAT = al(OFF_QLAT + (size_t)T * 384 * 2);
constexpr size_t OFF_XP    = al(OFF_KVLAT + (size_t)T * 256 * 2);
constexpr size_t OFF_QMLA  = al(OFF_XP + (size_t)T * 512 * 2);
constexpr size_t OFF_KPM   = al(OFF_QMLA + (size_t)T * 768 * 2);
constexpr size_t OFF_KSM   = al(OFF_KPM + 16ull * 8 * 256 * 96 * 2);
constexpr size_t OFF_VTPM  = al(OFF_KSM + 8ull * 8 * 1280 * 96 * 2);
constexpr size_t OFF_VTSM  = al(OFF_VTPM + 16ull * 8 * 64 * 256 * 2);
static_assert(OFF_VTSM + 8ull * 8 * 64 * 1280 * 2 <= WS_NEED, "odd buffers overflow");
static_assert(OFF_VTS + 8ull * 8 * 64 * 1024 * 2 <= WS_NEED, "even buffers overflow");

constexpr size_t OUT_Y   = 0;
constexpr size_t OUT_NAK = (size_t)T * 1024;
constexpr size_t OUT_NAV = OUT_NAK + 16ull * 2 * 256 * 512;
constexpr size_t OUT_CKV = OUT_NAV + 16ull * 2 * 256 * 512;
constexpr size_t OUT_KPE = OUT_CKV + 16ull * 2 * 256 * 256;

struct MatDesc { const float* src; const float* rscale; unsigned long long dst; int K, N, Npad, headpad, tile0, blockdiag; };
constexpr int NMATS = 22;
struct Params {
  const float* in[30];
  float* out;
  unsigned char* ws;
  MatDesc mats[NMATS];
  int conv_tiles;
  int pad_;
};

__device__ __forceinline__ f32x4 make_f32x4(float a, float b, float c, float d) { f32x4 v = {a, b, c, d}; return v; }
#define GAS __attribute__((address_space(1)))
template <class T> DI void gst(T* p, const T& v) { *(GAS T*)p = v; }
template <class T> DI T gld(const T* p) { return *(const GAS T*)p; }
DI unsigned char* uniform_ptr(const void* p) { const unsigned long long v = (unsigned long long)p; const unsigned lo = __builtin_amdgcn_readfirstlane((unsigned)v), hi = __builtin_amdgcn_readfirstlane((unsigned)(v >> 32)); return (unsigned char*)(((unsigned long long)hi << 32) | lo); }
DI int otid() { int t = threadIdx.x; asm volatile("" : "+v"(t)); return t; }
DI unsigned pack2(float a, float b) { bf16v2 v = {(__bf16)a, (__bf16)b}; return __builtin_bit_cast(unsigned, v); }
DI bf16_t f2bf(float a) { return __builtin_bit_cast(unsigned short, (__bf16)a); }
DI float bf2f(unsigned v16) { return __uint_as_float(v16 << 16); }
DI float bflo(unsigned u) { return __uint_as_float(u << 16); }
DI float bfhi(unsigned u) { return __uint_as_float(u & 0xffff0000u); }
DI int mi_of(int m) { return m < TP ? 0 : 1 + ((m - TP) >> 10); }
DI float xor32(float v) { return __shfl_xor(v, 32, 64); }
DI void store_bf4(bf16_t* p, float a, float b, float c, float d) { u32x2 u; u.x = pack2(a, b); u.y = pack2(c, d); *(GAS u32x2*)p = u; }
template <int NP> DI float rstd_parts(const float* ssq, int m, float invn) {
  float v[NP];
#pragma unroll
  for (int p = 0; p < NP; ++p) v[p] = gld(ssq + (size_t)p * T + m);
  float s = 0.f;
#pragma unroll
  for (int p = 0; p < NP; ++p) s += v[p];
  return rsqrtf(s * invn + EPS);
}

#define XB_TMO      128
#define XB_XCNT(j)  (256  + 64 * (j))
#define XB_XSUB(j)  (1280 + 64 * (j))
#define XB_XGEN(j)  (2304 + 64 * (j))
#define XB_TOP      3328
#define XB_TOPGEN   3392
#define XCD_BAR_WORDS 3456
#define XB_SPIN_CAP (1u << 20)
#define LAS __attribute__((address_space(3)))
DI unsigned xb_ld(unsigned* p)              { return __hip_atomic_load(p, __ATOMIC_RELAXED, __HIP_MEMORY_SCOPE_AGENT); }
DI unsigned xb_add(unsigned* p, unsigned v) { return __hip_atomic_fetch_add(p, v, __ATOMIC_RELAXED, __HIP_MEMORY_SCOPE_AGENT); }
DI unsigned xb_xcc_id() { return (unsigned)__builtin_amdgcn_s_getreg((3 << 11) | 20) & 0xFu; }
#define XB_SPIN(cond, bar) do { unsigned _sp = 0; while (cond) { __builtin_amdgcn_s_sleep(1); \
    if ((++_sp & 255u) == 0u) { if (xb_ld(&(bar)[XB_TMO])) break; if (_sp > XB_SPIN_CAP) { atomicAdd(&(bar)[XB_TMO], 1u); break; } } } } while (0)
struct XcdBarrier { unsigned* bar; unsigned x; volatile LAS unsigned* st; };
DI XcdBarrier xcd_barrier_post(unsigned* bar, volatile LAS unsigned* st) {
  XcdBarrier b; b.bar = bar; b.x = xb_xcc_id(); b.st = st;
  if (threadIdx.x == 0) (void)xb_add(&bar[XB_XCNT(b.x)], 1u);
  return b;
}
DI void xcd_barrier_complete(unsigned* bar, unsigned x, unsigned& nloc, unsigned& nx) {
  const unsigned G = gridDim.x * gridDim.y * gridDim.z;
  unsigned sum, cnt, mine, sp = 0u;
  for (;;) {
    sum = 0u; cnt = 0u; mine = 0u;
#pragma unroll
    for (unsigned j = 0; j < 16; ++j) { const unsigned c = xb_ld(&bar[XB_XCNT(j)]); sum += c; cnt += (c > 0u) ? 1u : 0u; mine = (j == x) ? c : mine; }
    if (sum == G) break;
    __builtin_amdgcn_s_sleep(1);
    if ((++sp & 255u) == 0u) { if (xb_ld(&bar[XB_TMO])) break; if (sp > XB_SPIN_CAP) { atomicAdd(&bar[XB_TMO], 1u); break; } }
  }
  nloc = mine > 0u ? mine : 1u; nx = cnt > 0u ? cnt : 1u;
}
DI void xcd_barrier(const XcdBarrier& b) {
  asm volatile("s_waitcnt vmcnt(0)" ::: "memory");
  __syncthreads();
  if (threadIdx.x == 0) {
    unsigned* bar = b.bar;
    __builtin_amdgcn_s_waitcnt(0);
    unsigned nloc = b.st[0], nx = b.st[1];
    if (nloc == 0u) { xcd_barrier_complete(bar, b.x, nloc, nx); b.st[0] = nloc; b.st[1] = nx; }
    const unsigned old = xb_add(&bar[XB_XSUB(b.x)], 1u);
    const unsigned gen = old / nloc;
    if (old + 1u == (gen + 1u) * nloc) {
      __builtin_amdgcn_fence(__ATOMIC_RELEASE, "agent");
      asm volatile("s_waitcnt vmcnt(0)" ::: "memory");
      const unsigned og = xb_add(&bar[XB_TOP], 1u);
      const unsigned tg = og / nx;
      if (og + 1u == (tg + 1u) * nx) xb_add(&bar[XB_TOPGEN], 1u);
      else XB_SPIN(xb_ld(&bar[XB_TOPGEN]) == tg, bar);
      __builtin_amdgcn_fence(__ATOMIC_ACQUIRE, "agent");
      xb_add(&bar[XB_XGEN(b.x)], 1u);
      asm volatile("s_waitcnt vmcnt(0)" ::: "memory");
    } else {
      XB_SPIN(xb_ld(&bar[XB_XGEN(b.x)]) == gen, bar);
      __builtin_amdgcn_fence(__ATOMIC_ACQUIRE, "agent");
      asm volatile("s_waitcnt vmcnt(0)" ::: "memory");
    }
  }
  __syncthreads();
}

typedef __attribute__((address_space(3))) unsigned lds_u32_t;
template <int OFF> DI bf16x8 lds_rd128(unsigned addr) { bf16x8 v; asm volatile("ds_read_b128 %0, %1 offset:%2" : "=v"(v) : "v"(addr), "n"(OFF) : "memory"); return v; }
template <int N, int NW, int NA> DI void lgkm_wait(bf16x8 (&wf)[NW], bf16x8 (&af)[NA]) {
  if constexpr (NW == 4 && NA == 2) asm volatile("s_waitcnt lgkmcnt(%6)" : "+v"(wf[0]), "+v"(wf[1]), "+v"(wf[2]), "+v"(wf[3]), "+v"(af[0]), "+v"(af[1]) : "n"(N) : "memory");
  else if constexpr (NW == 2 && NA == 3) asm volatile("s_waitcnt lgkmcnt(%5)" : "+v"(wf[0]), "+v"(wf[1]), "+v"(af[0]), "+v"(af[1]), "+v"(af[2]) : "n"(N) : "memory");
  else asm volatile("s_waitcnt lgkmcnt(%5)" : "+v"(wf[0]), "+v"(wf[1]), "+v"(wf[2]), "+v"(wf[3]), "+v"(af[0]) : "n"(N) : "memory");
}
template <int TM, int WNW, bool DRY = false, class Epi>
DI void gemm_tile(const bf16_t* __restrict__ A, int lda, const bf16_t* __restrict__ W, int K, int m0, int n0, const Epi& epi, unsigned char* smem) {
  constexpr int WMW = 8 / WNW, NT = 256 / WNW / 32, MT = TM / WMW / 32, NLA = TM / 64, WAVE_N = 256 / WNW, WAVE_M = TM / WMW;
  constexpr int STAGE = (TM + 256) * 128;
  static_assert((NT == 4 && MT == 2) || (NT == 2 && MT == 3) || (NT == 4 && MT == 1), "fragment wait helper covers these shapes");
  const int tid = otid(), lane = tid & 63, w = tid >> 6, r = lane & 31, h = lane >> 5;
  const int wn = w % WNW, wm = w / WNW;
  f32x16 acc[NT][MT];
#pragma unroll
  for (int a = 0; a < NT; ++a)
#pragma unroll
    for (int b = 0; b < MT; ++b)
#pragma unroll
      for (int i = 0; i < 16; ++i) acc[a][b][i] = 0.f;
  const int KT = K >> 6;
  const int lrow = tid >> 3, lkc = (tid & 7) ^ ((tid >> 4) & 7);
  typedef const __attribute__((address_space(1))) unsigned* gsrc_t;
  const bf16_t* ga = A + (size_t)(m0 + lrow) * lda + lkc * 8;
  const bf16_t* gw = W + (size_t)(n0 + lrow) * K + lkc * 8;
#define DMA_TILE(KT_, ST_) do { \
    unsigned char* sa_ = smem + (ST_) * STAGE + tid * 16; \
    _Pragma("unroll") for (int i = 0; i < NLA; ++i) \
      __builtin_amdgcn_global_load_lds((gsrc_t)(ga + (size_t)(64 * i) * lda + (KT_) * 64), (lds_u32_t*)(sa_ + i * 8192), 16, 0, 0); \
    _Pragma("unroll") for (int i = 0; i < 4; ++i) \
      __builtin_amdgcn_global_load_lds((gsrc_t)(gw + (size_t)(64 * i) * K + (KT_) * 64), (lds_u32_t*)(sa_ + TM * 128 + i * 8192), 16, 0, 0); } while (0)
  __syncthreads();
  epi.side(n0, m0, tid, smem + SIDE_OFF);
  DMA_TILE(0, 0);
  const int swz = (r >> 1) & 7;
  const unsigned lbase = (unsigned)(size_t)smem;
  const unsigned offw = lbase + TM * 128 + (wn * WAVE_N + r) * 128, offa = lbase + (wm * WAVE_M + r) * 128;
  unsigned cx[4];
#pragma unroll
  for (int ks = 0; ks < 4; ++ks) cx[ks] = ((2 * ks + h) ^ swz) << 4;
#define FRAGS(BUF, KS_) do { \
    wf[BUF][0] = lds_rd128<0>(pw + cx[KS_]); wf[BUF][1] = lds_rd128<4096>(pw + cx[KS_]); \
    if constexpr (NT == 4) { wf[BUF][2] = lds_rd128<8192>(pw + cx[KS_]); wf[BUF][3] = lds_rd128<12288>(pw + cx[KS_]); } \
    af[BUF][0] = lds_rd128<0>(pa + cx[KS_]); \
    if constexpr (MT >= 2) af[BUF][1] = lds_rd128<4096>(pa + cx[KS_]); \
    if constexpr (MT >= 3) af[BUF][2] = lds_rd128<8192>(pa + cx[KS_]); } while (0)
#define MMAS(BUF) do { _Pragma("unroll") for (int a = 0; a < NT; ++a) _Pragma("unroll") for (int b = 0; b < MT; ++b) acc[a][b] = MFMA(wf[BUF][a], af[BUF][b], acc[a][b]); } while (0)
  for (int kt = 0; kt < KT; ++kt) {
    asm volatile("s_waitcnt vmcnt(0)" ::: "memory");
    __syncthreads();
    if (kt + 1 < KT) DMA_TILE(kt + 1, (kt + 1) & 1);
    __builtin_amdgcn_sched_barrier(0);
    const unsigned pw = offw + (kt & 1) * STAGE, pa = offa + (kt & 1) * STAGE;
    bf16x8 wf[2][NT], af[2][MT];
    FRAGS(0, 0);
    FRAGS(1, 1);
    lgkm_wait<NT + MT>(wf[0], af[0]);
    MMAS(0);
    __builtin_amdgcn_sched_barrier(0);
    FRAGS(0, 2);
    lgkm_wait<NT + MT>(wf[1], af[1]);
    MMAS(1);
    __builtin_amdgcn_sched_barrier(0);
    FRAGS(1, 3);
    lgkm_wait<NT + MT>(wf[0], af[0]);
    MMAS(0);
    __builtin_amdgcn_sched_barrier(0);
    lgkm_wait<0>(wf[1], af[1]);
    MMAS(1);
    __builtin_amdgcn_sched_barrier(0);
  }
#undef DMA_TILE
#undef FRAGS
#undef MMAS
  if (DRY) {
    float sdry = 0.f;
#pragma unroll
    for (int a = 0; a < NT; ++a)
#pragma unroll
      for (int b = 0; b < MT; ++b)
#pragma unroll
        for (int i = 0; i < 16; ++i) sdry += acc[a][b][i];
    if (sdry != 12345.678f) return;
  }
  __syncthreads();
  epi(acc, n0 + wn * WAVE_N, m0 + wm * WAVE_M, lane, smem + w * 9216, smem + SIDE_OFF, n0, m0);
}

struct EpiEvenIn {
  const float* ssq; const float* shw; const float* gq; const float* gk;
  bf16_t* bconv; bf16_t* qbuf; bf16_t* kbuf; bf16_t* vtp; bf16_t* vts; float* out_k; float* out_v; int li;
  DI void side(int n0, int m0, int tid, unsigned char* sd) const {
    float* f = (float*)sd;
    if (tid < 192) f[tid] = rstd_parts<16>(ssq, m0 + tid, 1.f / 1024.f);
    const int mi = mi_of(tid < 256 ? m0 : m0 + 191);
    f[192 + tid] = gld(shw + mi * 3072 + n0 + (tid & 255));
  }
  template <int MT> DI void operator()(f32x16 (&acc)[2][MT], int nb, int mb, int lane, unsigned char* wlds, const unsigned char* side, int n0, int m0) const {
    const int r = lane & 31, h = lane >> 5;
    const int region = nb >> 9;
#pragma unroll
    for (int mt = 0; mt < MT; ++mt) {
      const int m = mb + mt * 32 + r;
      const float* sf = (const float*)side;
      const float rs = sf[m - m0];
      const float* sw = sf + 192 + (mi_of(m) != mi_of(m0) ? 256 : 0) + (nb - n0);
      float ss = 0.f;
#pragma unroll
      for (int nt = 0; nt < 2; ++nt)
#pragma unroll
        for (int g = 0; g < 4; ++g) {
          const f32x4 s4 = *(const f32x4*)(sw + nt * 32 + 8 * g + 4 * h);
          acc[nt][mt][4 * g + 0] = rs * acc[nt][mt][4 * g + 0] + s4.x;
          acc[nt][mt][4 * g + 1] = rs * acc[nt][mt][4 * g + 1] + s4.y;
          acc[nt][mt][4 * g + 2] = rs * acc[nt][mt][4 * g + 2] + s4.z;
          acc[nt][mt][4 * g + 3] = rs * acc[nt][mt][4 * g + 3] + s4.w;
#pragma unroll
          for (int j = 0; j < 4; ++j) ss += acc[nt][mt][4 * g + j] * acc[nt][mt][4 * g + j];
        }
      if (region < 3) {
#pragma unroll
        for (int nt = 0; nt < 2; ++nt)
#pragma unroll
          for (int g = 0; g < 4; ++g)
            store_bf4(bconv + (size_t)m * 1536 + nb + nt * 32 + 8 * g + 4 * h, acc[nt][mt][4 * g], acc[nt][mt][4 * g + 1], acc[nt][mt][4 * g + 2], acc[nt][mt][4 * g + 3]);
      } else if (region < 5) {
        const bool isk = region == 4;
        const float* gain = isk ? gk : gq;
        bf16_t* dst = (isk ? kbuf : qbuf) + (size_t)m * 512 + (nb - (isk ? 2048 : 1536));
        float* od = nullptr;
        if (isk && m < TP) od = out_k + ((size_t)(((m >> 8) * 2 + li) * 256 + (m & 255))) * 512 + (nb - 2048);
        ss += xor32(ss);
        const float rn = rsqrtf(ss * (1.f / 64.f) + EPS);
#pragma unroll
        for (int nt = 0; nt < 2; ++nt)
#pragma unroll
          for (int g = 0; g < 4; ++g) {
            const int d = nt * 32 + 8 * g + 4 * h;
            const f32x4 g4 = gld((const f32x4*)(gain + d));
            const float o0 = acc[nt][mt][4 * g] * rn * g4.x, o1 = acc[nt][mt][4 * g + 1] * rn * g4.y, o2 = acc[nt][mt][4 * g + 2] * rn * g4.z, o3 = acc[nt][mt][4 * g + 3] * rn * g4.w;
            store_bf4(dst + d, o0, o1, o2, o3);
            if (od) *(GAS f32x4*)(od + d) = make_f32x4(o0, o1, o2, o3);
          }
      } else {
        const bool pr = m < TP;
        const int s = m - TP;
        const int hd = (nb - 2560) >> 6;
        float* od = pr ? out_v + ((size_t)(((m >> 8) * 2 + li) * 256 + (m & 255))) * 512 + (nb - 2560) : nullptr;
        bf16_t* vt0 = pr ? vtp + ((size_t)((m >> 8) * 8 + hd) * 64) * 256 + (m & 255) : vts + ((size_t)((s >> 10) * 8 + hd) * 64) * 1024 + (s & 1023);
        const int st = pr ? 256 : 1024;
#pragma unroll
        for (int nt = 0; nt < 2; ++nt)
#pragma unroll
          for (int g = 0; g < 4; ++g) {
            const int d = nt * 32 + 8 * g + 4 * h;
#pragma unroll
            for (int j = 0; j < 4; ++j) gst(vt0 + (size_t)(d + j) * st, f2bf(acc[nt][mt][4 * g + j]));
            if (pr) *(GAS f32x4*)(od + d) = make_f32x4(acc[nt][mt][4 * g], acc[nt][mt][4 * g + 1], acc[nt][mt][4 * g + 2], acc[nt][mt][4 * g + 3]);
          }
      }
    }
  }
};

struct EpiResid {
  float* y; const float* gate; const float* ng; const float* nsc; bf16_t* abuf; float* ssq_out; float gscale;
  DI void side(int n0, int m0, int tid, unsigned char* sd) const {
    float* f = (float*)sd;
    const int mi = mi_of(tid < 256 ? m0 : m0 + 191), n = n0 + (tid & 255);
    f[tid] = gld(gate + mi * 6144 + n) * gscale;
    f[512 + tid] = ng ? gld(ng + n) * (1.f + gld(nsc + mi * 6144 + n)) : 0.f;
  }
  template <int MT> DI void operator()(f32x16 (&acc)[2][MT], int nb, int mb, int lane, unsigned char* wlds, const unsigned char* side, int n0, int m0) const {
    const int r = lane & 31, h = lane >> 5, cc = lane & 15, rq = lane >> 4;
    const int mi0 = mi_of(m0);
#pragma unroll
    for (int mt = 0; mt < MT; ++mt) {
#pragma unroll
      for (int nt = 0; nt < 2; ++nt)
#pragma unroll
        for (int g = 0; g < 4; ++g)
          *(f32x4*)(wlds + r * 272 + (nt * 32 + 8 * g + 4 * h) * 4) = make_f32x4(acc[nt][mt][4 * g], acc[nt][mt][4 * g + 1], acc[nt][mt][4 * g + 2], acc[nt][mt][4 * g + 3]);
#pragma unroll
      for (int i = 0; i < 8; ++i) {
        const int row = rq + 4 * i;
        const int m = mb + mt * 32 + row, n = nb + cc * 4;
        const float* sf = (const float*)side + (mi_of(m) != mi0 ? 256 : 0) + (n - n0);
        const f32x4 a = *(const f32x4*)(wlds + row * 272 + cc * 16);
        f32x4 yo = gld((const f32x4*)(y + (size_t)m * 1024 + n));
        const f32x4 gt = *(const f32x4*)sf;
        yo.x += gt.x * a.x; yo.y += gt.y * a.y; yo.z += gt.z * a.z; yo.w += gt.w * a.w;
        *(GAS f32x4*)(y + (size_t)m * 1024 + n) = yo;
        if (ng) {
          const f32x4 gg = *(const f32x4*)(sf + 512);
          store_bf4(abuf + (size_t)m * 1024 + n, yo.x * gg.x, yo.y * gg.y, yo.z * gg.z, yo.w * gg.w);
          float ss = yo.x * yo.x + yo.y * yo.y + yo.z * yo.z + yo.w * yo.w;
          ss += __shfl_xor(ss, 1, 64); ss += __shfl_xor(ss, 2, 64); ss += __shfl_xor(ss, 4, 64); ss += __shfl_xor(ss, 8, 64);
          if (cc == 0) gst(ssq_out + (size_t)(nb >> 6) * T + m, ss);
        }
      }
    }
  }
};

struct EpiMlp1 {
  const float* ssq; const float* shw; bf16_t* act;
  DI void side(int n0, int m0, int tid, unsigned char* sd) const {
    float* f = (float*)sd;
    if (tid < 256) f[tid] = rstd_parts<16>(ssq, m0 + tid, 1.f / 1024.f);
    else f[tid] = gld(shw + mi_of(m0) * 4096 + n0 + (tid - 256));
  }
  template <int NT, int MT> DI void operator()(f32x16 (&acc)[NT][MT], int nb, int mb, int lane, unsigned char* wlds, const unsigned char* side, int n0, int m0) const {
    const int r = lane & 31, h = lane >> 5;
    constexpr int RS = NT * 64 + 16;
    constexpr int CPR = NT * 4;
#pragma unroll
    for (int mt = 0; mt < MT; ++mt) {
      const float* sf = (const float*)side;
      const float rs = sf[mb - m0 + mt * 32 + r];
#pragma unroll
      for (int nt = 0; nt < NT; ++nt)
#pragma unroll
        for (int g = 0; g < 4; ++g) {
          const int nl = nt * 32 + 8 * g + 4 * h;
          const f32x4 s4 = *(const f32x4*)(sf + 256 + (nb - n0) + nl);
          float v0 = fmaxf(rs * acc[nt][mt][4 * g] + s4.x, 0.f), v1 = fmaxf(rs * acc[nt][mt][4 * g + 1] + s4.y, 0.f);
          float v2 = fmaxf(rs * acc[nt][mt][4 * g + 2] + s4.z, 0.f), v3 = fmaxf(rs * acc[nt][mt][4 * g + 3] + s4.w, 0.f);
          u32x2 u; u.x = pack2(v0 * v0, v1 * v1); u.y = pack2(v2 * v2, v3 * v3);
          *(u32x2*)(wlds + r * RS + nl * 2) = u;
        }
#pragma unroll
      for (int i = 0; i < 32 * CPR / 64; ++i) {
        const int c = lane + 64 * i, row = c / CPR, cc = c % CPR;
        const u32x4 v = *(const u32x4*)(wlds + row * RS + cc * 16);
        *(GAS u32x4*)(act + (size_t)(mb + mt * 32 + row) * 4096 + nb + cc * 8) = v;
      }
    }
  }
};

struct EpiOddIn {
  const float* ssq; const float* shw; bf16_t* ubuf; bf16_t* qlat; bf16_t* kvlat; float* kpebuf; float* ssqq; float* ssqkv; float* out_ckv; float* out_kpe; int li;
  DI void side(int n0, int m0, int tid, unsigned char* sd) const {
    float* f = (float*)sd;
    if (tid < 256) f[tid] = rstd_parts<16>(ssq, m0 + tid, 1.f / 1024.f);
    else f[tid] = gld(shw + mi_of(m0) * 3072 + n0 + (tid - 256));
  }
  template <int MT> DI void operator()(f32x16 (&acc)[4][MT], int nb, int mb, int lane, unsigned char* wlds, const unsigned char* side, int n0, int m0) const {
    const int r = lane & 31, h = lane >> 5;
#pragma unroll
    for (int mt = 0; mt < MT; ++mt) {
      __builtin_amdgcn_sched_barrier(0);
      const int m = mb + mt * 32 + r;
      const float* sf = (const float*)side;
      const float rs = sf[m - m0];
      const float* sw = sf + 256 + (nb - n0);
      float ss = 0.f;
#pragma unroll
      for (int nt = 0; nt < 4; ++nt)
#pragma unroll
        for (int g = 0; g < 4; ++g) {
          const f32x4 s4 = *(const f32x4*)(sw + nt * 32 + 8 * g + 4 * h);
          acc[nt][mt][4 * g + 0] = rs * acc[nt][mt][4 * g + 0] + s4.x;
          acc[nt][mt][4 * g + 1] = rs * acc[nt][mt][4 * g + 1] + s4.y;
          acc[nt][mt][4 * g + 2] = rs * acc[nt][mt][4 * g + 2] + s4.z;
          acc[nt][mt][4 * g + 3] = rs * acc[nt][mt][4 * g + 3] + s4.w;
#pragma unroll
          for (int j = 0; j < 4; ++j) ss += acc[nt][mt][4 * g + j] * acc[nt][mt][4 * g + j];
        }
      ss += xor32(ss);
      const size_t prow = (size_t)(((m >> 8) * 2 + li) * 256 + (m & 255));
      if (nb < 512) {
#pragma unroll
        for (int nt = 0; nt < 4; ++nt)
#pragma unroll
          for (int g = 0; g < 4; ++g)
            store_bf4(ubuf + (size_t)m * 512 + nb + nt * 32 + 8 * g + 4 * h, acc[nt][mt][4 * g], acc[nt][mt][4 * g + 1], acc[nt][mt][4 * g + 2], acc[nt][mt][4 * g + 3]);
      } else if (nb < 896) {
#pragma unroll
        for (int nt = 0; nt < 4; ++nt)
#pragma unroll
          for (int g = 0; g < 4; ++g)
            store_bf4(qlat + (size_t)m * 384 + (nb - 512) + nt * 32 + 8 * g + 4 * h, acc[nt][mt][4 * g], acc[nt][mt][4 * g + 1], acc[nt][mt][4 * g + 2], acc[nt][mt][4 * g + 3]);
        if (h == 0) gst(ssqq + (size_t)((nb - 512) >> 7) * T + m, ss);
      } else if (nb < 1152) {
#pragma unroll
        for (int nt = 0; nt < 4; ++nt)
#pragma unroll
          for (int g = 0; g < 4; ++g) {
            const int c = (nb - 896) + nt * 32 + 8 * g + 4 * h;
            store_bf4(kvlat + (size_t)m * 256 + c, acc[nt][mt][4 * g], acc[nt][mt][4 * g + 1], acc[nt][mt][4 * g + 2], acc[nt][mt][4 * g + 3]);
            if (m < TP) *(GAS f32x4*)(out_ckv + (size_t)m * 256 + c) = make_f32x4(acc[nt][mt][4 * g], acc[nt][mt][4 * g + 1], acc[nt][mt][4 * g + 2], acc[nt][mt][4 * g + 3]);
          }
        if (h == 0) gst(ssqkv + (size_t)((nb - 896) >> 7) * T + m, ss);
      } else {
#pragma unroll
        for (int g = 0; g < 4; ++g) {
          const int c = 8 * g + 4 * h;
          const f32x4 v = make_f32x4(acc[0][mt][4 * g], acc[0][mt][4 * g + 1], acc[0][mt][4 * g + 2], acc[0][mt][4 * g + 3]);
          *(GAS f32x4*)(kpebuf + (size_t)m * 32 + c) = v;
          if (m < TP) *(GAS f32x4*)(out_kpe + prow * 32 + c) = v;
        }
      }
    }
  }
};

DI void rope_cs(int j8, float posv, float& c, float& s) {
  const float inv = __builtin_amdgcn_exp2f(-1.6609640474436813f * (float)j8);
  const float ang = posv * inv;
  c = __cosf(ang); s = __sinf(ang);
}

struct EpiQUp {
  DI void side(int, int, int, unsigned char*) const {}
  const float* ssqq; const float* gq; bf16_t* qmla;
  template <int MT> DI void operator()(f32x16 (&acc)[4][MT], int nb, int mb, int lane, unsigned char* wlds, const unsigned char* side, int n0, int m0) const {
   const int r = lane & 31, h = lane >> 5, hd = nb >> 7;
#pragma unroll
   for (int mt = 0; mt < MT; ++mt) {
    __builtin_amdgcn_sched_barrier(0);
    const int m = mb + mt * 32 + r;
    const float rq = rstd_parts<3>(ssqq, m, 1.f / 384.f);
    float ss = 0.f;
#pragma unroll
    for (int nt = 0; nt < 3; ++nt)
#pragma unroll
      for (int i = 0; i < 16; ++i) { acc[nt][mt][i] *= rq; ss += acc[nt][mt][i] * acc[nt][mt][i]; }
    ss += xor32(ss);
    const float rn = rsqrtf(ss * (1.f / 96.f) + EPS);
#pragma unroll
    for (int nt = 0; nt < 3; ++nt)
#pragma unroll
      for (int g = 0; g < 4; ++g) {
        const f32x4 g4 = gld((const f32x4*)(gq + nt * 32 + 8 * g + 4 * h));
        acc[nt][mt][4 * g] *= rn * g4.x; acc[nt][mt][4 * g + 1] *= rn * g4.y; acc[nt][mt][4 * g + 2] *= rn * g4.z; acc[nt][mt][4 * g + 3] *= rn * g4.w;
      }
    if (m >= TP) {
      const int pos = (m - TP) & 1023;
      const float prow = (float)(pos >> 6), pcol = (float)(pos & 63);
#pragma unroll
      for (int g = 0; g < 2; ++g)
#pragma unroll
        for (int j = 0; j < 4; ++j) {
          float c, s; rope_cs(4 * h + j, g == 0 ? prow : pcol, c, s);
          const float x1 = acc[2][mt][4 * g + j], x2 = acc[2][mt][8 + 4 * g + j];
          acc[2][mt][4 * g + j] = x1 * c - x2 * s;
          acc[2][mt][8 + 4 * g + j] = x2 * c + x1 * s;
        }
    }
#pragma unroll
    for (int nt = 0; nt < 3; ++nt)
#pragma unroll
      for (int g = 0; g < 4; ++g)
        store_bf4(qmla + (size_t)m * 768 + hd * 96 + nt * 32 + 8 * g + 4 * h, acc[nt][mt][4 * g], acc[nt][mt][4 * g + 1], acc[nt][mt][4 * g + 2], acc[nt][mt][4 * g + 3]);
   }
  }
};

struct EpiKvUp {
  DI void side(int, int, int, unsigned char*) const {}
  const float* ssqkv; const float* gk; const float* kpebuf; const float* cache_kpe; bf16_t* kpm; bf16_t* ksm; bf16_t* vtpm; bf16_t* vtsm; int li; int cache;
  template <int MT> DI void operator()(f32x16 (&acc)[4][MT], int nb, int mb, int lane, unsigned char* wlds, const unsigned char* side, int n0, int m0) const {
   const int r = lane & 31, h = lane >> 5, hd = nb >> 7;
#pragma unroll
   for (int mt = 0; mt < MT; ++mt) {
    __builtin_amdgcn_sched_barrier(0);
    const int m = mb + mt * 32 + r;
    float rs = 1.f;
    const float* kp;
    bf16_t* kdst; bf16_t* vdst; int vst; bool rope = false; int pos = 0;
    if (cache) {
      const int b = m >> 8, p = m & 255;
      kp = cache_kpe + ((size_t)((b * 2 + li) * 256 + p)) * 32;
      kdst = ksm + ((size_t)(b * 8 + hd) * 1280 + p) * 96;
      vdst = vtsm + ((size_t)(b * 8 + hd) * 64) * 1280 + p; vst = 1280;
    } else {
      rs = rstd_parts<2>(ssqkv, m, 1.f / 256.f);
      kp = kpebuf + (size_t)m * 32;
      if (m < TP) {
        const int b = m >> 8, p = m & 255;
        kdst = kpm + ((size_t)(b * 8 + hd) * 256 + p) * 96;
        vdst = vtpm + ((size_t)(b * 8 + hd) * 64) * 256 + p; vst = 256;
      } else {
        const int s = m - TP, b = s >> 10; pos = s & 1023; rope = true;
        kdst = ksm + ((size_t)(b * 8 + hd) * 1280 + 256 + pos) * 96;
        vdst = vtsm + ((size_t)(b * 8 + hd) * 64) * 1280 + 256 + pos; vst = 1280;
      }
    }
    float ss = 0.f;
#pragma unroll
    for (int nt = 0; nt < 4; ++nt)
#pragma unroll
      for (int i = 0; i < 16; ++i) { acc[nt][mt][i] *= rs; if (nt < 2) ss += acc[nt][mt][i] * acc[nt][mt][i]; }
    ss += xor32(ss);
    const f32x4 a0 = gld((const f32x4*)(kp + 8 * h)), a1 = gld((const f32x4*)(kp + 8 * h + 4));
    const f32x4 b0 = gld((const f32x4*)(kp + 16 + 8 * h)), b1 = gld((const f32x4*)(kp + 16 + 8 * h + 4));
    float x1[8] = {a0.x, a0.y, a0.z, a0.w, a1.x, a1.y, a1.z, a1.w};
    float x2[8] = {b0.x, b0.y, b0.z, b0.w, b1.x, b1.y, b1.z, b1.w};
    float sp = 0.f;
#pragma unroll
    for (int j = 0; j < 8; ++j) sp += x1[j] * x1[j] + x2[j] * x2[j];
    sp += xor32(sp);
    const float rn = rsqrtf((ss + sp) * (1.f / 96.f) + EPS);
#pragma unroll
    for (int nt = 0; nt < 2; ++nt)
#pragma unroll
      for (int g = 0; g < 4; ++g) {
        const int d = nt * 32 + 8 * g + 4 * h;
        const f32x4 g4 = gld((const f32x4*)(gk + d));
        store_bf4(kdst + d, acc[nt][mt][4 * g] * rn * g4.x, acc[nt][mt][4 * g + 1] * rn * g4.y, acc[nt][mt][4 * g + 2] * rn * g4.z, acc[nt][mt][4 * g + 3] * rn * g4.w);
      }
    const float prow = (float)(pos >> 6), pcol = (float)(pos & 63);
#pragma unroll
    for (int j = 0; j < 8; ++j) {
      const int jj = 8 * h + j;
      float a = x1[j] * rn * gk[64 + jj], b = x2[j] * rn * gk[80 + jj];
      if (rope) {
        float c, s; rope_cs(j, h == 0 ? prow : pcol, c, s);
        const float na = a * c - b * s, nb2 = b * c + a * s;
        a = na; b = nb2;
      }
      x1[j] = a; x2[j] = b;
    }
    { u32x4 u; u.x = pack2(x1[0], x1[1]); u.y = pack2(x1[2], x1[3]); u.z = pack2(x1[4], x1[5]); u.w = pack2(x1[6], x1[7]); *(GAS u32x4*)(kdst + 64 + 8 * h) = u; }
    { u32x4 u; u.x = pack2(x2[0], x2[1]); u.y = pack2(x2[2], x2[3]); u.z = pack2(x2[4], x2[5]); u.w = pack2(x2[6], x2[7]); *(GAS u32x4*)(kdst + 80 + 8 * h) = u; }
#pragma unroll
    for (int nt = 2; nt < 4; ++nt)
#pragma unroll
      for (int i = 0; i < 16; ++i) {
        const int d = (nt - 2) * 32 + CROW(i, h);
        gst(vdst + (size_t)d * vst, f2bf(acc[nt][mt][i]));
      }
   }
  }
};

struct EpiPool {
  DI void side(int, int, int, unsigned char*) const {}
  const float* scale; bf16_t* cat;
  template <int NT, int MT> DI void operator()(f32x16 (&acc)[NT][MT], int nb, int mb, int lane, unsigned char* wlds, const unsigned char* side, int n0, int m0) const {
    const int r = lane & 31, h = lane >> 5;
#pragma unroll
    for (int mt = 0; mt < MT; ++mt) {
      const int m = mb + mt * 32 + r;
#pragma unroll
      for (int nt = 0; nt < NT; ++nt)
#pragma unroll
        for (int g = 0; g < 4; ++g) {
          const int n = nb + nt * 32 + 8 * g + 4 * h;
          const f32x4 s4 = gld((const f32x4*)(scale + n));
          store_bf4(cat + (size_t)m * 1024 + n, acc[nt][mt][4 * g] * s4.x, acc[nt][mt][4 * g + 1] * s4.y, acc[nt][mt][4 * g + 2] * s4.z, acc[nt][mt][4 * g + 3] * s4.w);
        }
    }
  }
};

template <int DQK>
DI void attn_task(const bf16_t* __restrict__ Q, int qs,
                  const bf16_t* __restrict__ K0, int ks0, const bf16_t* __restrict__ V0, int vs0, int nt0,
                  const bf16_t* __restrict__ K1, int ks1, const bf16_t* __restrict__ V1, int vs1, int nt1,
                  bool na, int qrow0, int krow0, const float* __restrict__ rpb_h,
                  bf16_t* __restrict__ O, int os, float scale, unsigned char* smem) {
  constexpr int KSTR = (DQK + 8) * 2;
  constexpr int CH = DQK / 8;
  constexpr int NKC = (CH * 64 + 511) / 512;
  constexpr int KSTAGE = 64 * 208, VSTAGE = 64 * 144;
  constexpr float LOG2E = 1.4426950408889634f;
  const int tid = otid(), lane = tid & 63, w = tid >> 6, r = lane & 31, h = lane >> 5;
  float* srpb = (float*)(smem + 2 * KSTAGE + 2 * VSTAGE);
  const int NTT = nt0 + nt1;

  __syncthreads();
  if (na) for (int i = tid; i < 465; i += 512) srpb[i] = rpb_h[i] * LOG2E;

  bf16x8 qf[DQK / 16];
  {
    const bf16_t* qp = Q + (size_t)(32 * w + r) * qs + 8 * h;
#pragma unroll
    for (int ks = 0; ks < DQK / 16; ++ks) qf[ks] = gld((const bf16x8*)(qp + ks * 16));
  }
  u32x4 rk[NKC], rv;
  const int vrow = tid >> 3, vkc = tid & 7;
  auto gload = [&](int j) {
    const bf16_t* kp; const bf16_t* vp; int kst, vst;
    if (j < nt0) { kp = K0 + (size_t)j * 64 * ks0; kst = ks0; vp = V0 + j * 64; vst = vs0; }
    else { kp = K1 + (size_t)(j - nt0) * 64 * ks1; kst = ks1; vp = V1 + (j - nt0) * 64; vst = vs1; }
#pragma unroll
    for (int i = 0; i < NKC; ++i) { const int c = tid + 512 * i; if (c < CH * 64) rk[i] = gld((const u32x4*)(kp + (size_t)(c / CH) * kst + (c % CH) * 8)); }
    rv = gld((const u32x4*)(vp + (size_t)vrow * vst + vkc * 8));
  };
  gload(0);

  f32x16 ot[2];
#pragma unroll
  for (int t = 0; t < 2; ++t)
#pragma unroll
    for (int i = 0; i < 16; ++i) ot[t][i] = 0.f;
  float m_run = -3.0e38f, l_run = 0.f;
  const float sc2 = scale * LOG2E;
  const int qrow = qrow0 + (w >> 1), qcol = 32 * (w & 1) + r;
  const int rsw = min(max(qrow - 4, 0), 8);
  const int csq = min(max(qcol - 8, 0), 48);

  for (int j = 0; j < NTT; ++j) {
    unsigned char* sK = smem + (j & 1) * KSTAGE;
    unsigned char* sV = smem + 2 * KSTAGE + (j & 1) * VSTAGE;
#pragma unroll
    for (int i = 0; i < NKC; ++i) { const int c = tid + 512 * i; if (c < CH * 64) *(u32x4*)(sK + (c / CH) * KSTR + (c % CH) * 16) = rk[i]; }
    *(u32x4*)(sV + vrow * 144 + vkc * 16) = rv;
    __syncthreads();
    if (j + 1 < NTT) gload(j + 1);
    __builtin_amdgcn_sched_barrier(0);
    const bool local = na && j < nt0;
    const int keyrow = krow0 + j;
    if (local && (keyrow < rsw || keyrow >= rsw + 8)) continue;
    f32x16 st[2];
#pragma unroll
    for (int t = 0; t < 2; ++t)
#pragma unroll
      for (int i = 0; i < 16; ++i) st[t][i] = 0.f;
    {
      bf16x8 kf[DQK / 16][2];
#pragma unroll
      for (int ks = 0; ks < DQK / 16; ++ks)
#pragma unroll
        for (int t = 0; t < 2; ++t) kf[ks][t] = *(const bf16x8*)(sK + (t * 32 + r) * KSTR + ks * 32 + h * 16);
      __builtin_amdgcn_sched_barrier(0);
#pragma unroll
      for (int ks = 0; ks < DQK / 16; ++ks)
#pragma unroll
        for (int t = 0; t < 2; ++t) st[t] = MFMA(kf[ks][t], qf[ks], st[t]);
    }
    bf16x8 vfr[4][2];
#pragma unroll
    for (int s2 = 0; s2 < 4; ++s2)
#pragma unroll
      for (int dv = 0; dv < 2; ++dv) {
        const unsigned char* vb = sV + (dv * 32 + r) * 144 + (16 * s2 + 4 * h) * 2;
        const u32x2 v0 = *(const u32x2*)(vb), v1 = *(const u32x2*)(vb + 16);
        const u32x4 vu = {v0.x, v0.y, v1.x, v1.y};
        vfr[s2][dv] = __builtin_bit_cast(bf16x8, vu);
      }
    __builtin_amdgcn_sched_barrier(0);
    float mx = -3.0e38f;
    if (local) {
      const int dr = keyrow - qrow + 7;
#pragma unroll
      for (int t = 0; t < 2; ++t)
#pragma unroll
        for (int i = 0; i < 16; ++i) {
          const int kc = t * 32 + CROW(i, h);
          const bool valid = (kc >= csq) && (kc < csq + 16);
          const int dc = min(max(kc - qcol + 15, 0), 30);
          const float bias = srpb[dr * 31 + dc];
          const float s = valid ? __builtin_fmaf(st[t][i], sc2, bias) : -1.0e30f;
          st[t][i] = s; mx = fmaxf(mx, s);
        }
    } else {
#pragma unroll
      for (int t = 0; t < 2; ++t)
#pragma unroll
        for (int i = 0; i < 16; ++i) mx = fmaxf(mx, st[t][i]);
      mx *= sc2;
    }
    mx = fmaxf(mx, xor32(mx));
    const float m_new = fmaxf(m_run, mx);
    if (__builtin_amdgcn_ballot_w64(m_new > m_run) != 0ull) {
      const float alpha = __builtin_amdgcn_exp2f(m_run - m_new);
      l_run *= alpha;
#pragma unroll
      for (int t = 0; t < 2; ++t)
#pragma unroll
        for (int i = 0; i < 16; ++i) ot[t][i] *= alpha;
    }
    m_run = m_new;
    if (local) {
#pragma unroll
      for (int t = 0; t < 2; ++t)
#pragma unroll
        for (int i = 0; i < 16; ++i) { const float p = __builtin_amdgcn_exp2f(st[t][i] - m_new); st[t][i] = p; l_run += p; }
    } else {
#pragma unroll
      for (int t = 0; t < 2; ++t)
#pragma unroll
        for (int i = 0; i < 16; ++i) { const float p = __builtin_amdgcn_exp2f(__builtin_fmaf(st[t][i], sc2, -m_new)); st[t][i] = p; l_run += p; }
    }
#pragma unroll
    for (int s2 = 0; s2 < 4; ++s2) {
      const int t = s2 >> 1, o = (s2 & 1) * 8;
      const u32x4 pu = {pack2(st[t][o + 0], st[t][o + 1]), pack2(st[t][o + 2], st[t][o + 3]), pack2(st[t][o + 4], st[t][o + 5]), pack2(st[t][o + 6], st[t][o + 7])};
      const bf16x8 pfv = __builtin_bit_cast(bf16x8, pu);
#pragma unroll
      for (int dv = 0; dv < 2; ++dv) ot[dv] = MFMA(vfr[s2][dv], pfv, ot[dv]);
    }
  }
  const float lt = l_run + xor32(l_run);
  const float inv = 1.f / lt;
  bf16_t* op = O + (size_t)(32 * w + r) * os;
#pragma unroll
  for (int dv = 0; dv < 2; ++dv)
#pragma unroll
    for (int g = 0; g < 4; ++g)
      store_bf4(op + dv * 32 + 8 * g + 4 * h, ot[dv][4 * g] * inv, ot[dv][4 * g + 1] * inv, ot[dv][4 * g + 2] * inv, ot[dv][4 * g + 3] * inv);
}

DI void job_mods(const Params& p, int j, unsigned char* smem) {
  const int tid = otid(), lane = tid & 63, w = tid >> 6, kq = lane >> 4, c4 = lane & 15;
  const int l = j / 96, n0 = (j % 96) * 64;
  float* s = (float*)smem;
  __syncthreads();
  for (int idx = tid; idx < 9 * 1024; idx += 512) {
    const int mi = idx >> 10, k = idx & 1023;
    const float x = mi == 0 ? p.in[7][k] : p.in[6][(mi - 1) * 1024 + k];
    s[idx] = x / (1.f + expf(-x));
  }
  __syncthreads();
  const float* Wp = p.in[8] + ((size_t)l * 1024 + w * 128 + kq) * 6144 + n0 + 4 * c4;
  float acc[9][4];
#pragma unroll
  for (int mi = 0; mi < 9; ++mi)
#pragma unroll
    for (int q = 0; q < 4; ++q) acc[mi][q] = 0.f;
#pragma unroll 8
  for (int i = 0; i < 32; ++i) {
    const f32x4 wv = gld((const f32x4*)(Wp + (size_t)(4 * i) * 6144));
    const int k = w * 128 + 4 * i + kq;
#pragma unroll
    for (int mi = 0; mi < 9; ++mi) {
      const float sv = s[mi * 1024 + k];
      acc[mi][0] += sv * wv.x; acc[mi][1] += sv * wv.y; acc[mi][2] += sv * wv.z; acc[mi][3] += sv * wv.w;
    }
  }
#pragma unroll
  for (int mi = 0; mi < 9; ++mi)
#pragma unroll
    for (int q = 0; q < 4; ++q) { float v = acc[mi][q]; v += __shfl_xor(v, 16, 64); v += __shfl_xor(v, 32, 64); acc[mi][q] = v; }
  __syncthreads();
  float* red = (float*)smem;
  if (kq == 0) {
#pragma unroll
    for (int mi = 0; mi < 9; ++mi)
#pragma unroll
      for (int q = 0; q < 4; ++q) red[(w * 9 + mi) * 64 + 4 * c4 + q] = acc[mi][q];
  }
  __syncthreads();
  float* mod = (float*)(p.ws + OFF_MOD);
  for (int idx = tid; idx < 9 * 64; idx += 512) {
    const int mi = idx >> 6, ln = idx & 63;
    float v = 0.f;
#pragma unroll
    for (int q = 0; q < 8; ++q) v += red[(q * 9 + mi) * 64 + ln];
    mod[(size_t)(l * 9 + mi) * 6144 + n0 + ln] = v + p.in[9][l * 6144 + n0 + ln];
  }
}

DI void job_wconv(const Params& p, int t) {
  int mi = 0;
#pragma unroll 1
  for (int i = 1; i < NMATS; ++i) if (t >= p.mats[i].tile0) mi = i;
  const MatDesc md = p.mats[mi];
  const int lt = t - md.tile0;
  const int ktiles = md.K >> 7;
  const int k0 = (lt % ktiles) * 128 + (otid() >> 6) * 16, n = (lt / ktiles) * 64 + (otid() & 63);
  const float* sp; bool ok; size_t rs;
  if (md.blockdiag) { ok = (k0 >> 7) == (n >> 7); sp = md.src + (size_t)(k0 >> 7) * 16384 + (size_t)(k0 & 127) * 128 + (n & 127); rs = 128; }
  else if (md.headpad) { const int hd = n >> 7, d = n & 127; ok = d < 96; sp = md.src + (size_t)k0 * md.N + hd * 96 + d; rs = md.N; }
  else { ok = n < md.N; sp = md.src + (size_t)k0 * md.N + n; rs = md.N; }
  float v[16];
#pragma unroll
  for (int q = 0; q < 16; ++q) v[q] = ok ? sp[(size_t)q * rs] : 0.f;
  if (md.rscale) {
#pragma unroll
    for (int q = 0; q < 16; ++q) v[q] *= md.rscale[k0 + q];
  }
  bf16_t* dst = (bf16_t*)(p.ws + md.dst) + (size_t)n * md.K + k0;
  u32x4 u0 = {pack2(v[0], v[1]), pack2(v[2], v[3]), pack2(v[4], v[5]), pack2(v[6], v[7])};
  u32x4 u1 = {pack2(v[8], v[9]), pack2(v[10], v[11]), pack2(v[12], v[13]), pack2(v[14], v[15])};
  *(GAS u32x4*)dst = u0;
  *(GAS u32x4*)(dst + 8) = u1;
}

DI void job_cache(const Params& p, int j) {
  const int tid = otid();
  if (j < 512) {
    const int item = j * 512 + tid;
    const int e = item * 8;
    const int c = e & 511, pos = (e >> 9) & 255, i = (e >> 17) & 1, b = e >> 18;
    const f32x4 a = gld((const f32x4*)(p.in[2] + e)), bq = gld((const f32x4*)(p.in[2] + e + 4));
    u32x4 u; u.x = pack2(a.x, a.y); u.y = pack2(a.z, a.w); u.z = pack2(bq.x, bq.y); u.w = pack2(bq.z, bq.w);
    *(GAS u32x4*)((bf16_t*)(p.ws + OFF_CNK) + ((size_t)(i * 2048 + b * 256 + pos)) * 512 + c) = u;
  } else if (j < 1024) {
    const int item = (j - 512) * 512 + tid;
    const int hd = item & 511, pos8 = (item >> 9) & 31, i = (item >> 14) & 1, b = item >> 15;
    const float* src = p.in[3] + ((size_t)((b * 2 + i) * 256 + pos8 * 8)) * 512 + hd;
    float v[8];
#pragma unroll
    for (int q = 0; q < 8; ++q) v[q] = src[(size_t)q * 512];
    u32x4 u; u.x = pack2(v[0], v[1]); u.y = pack2(v[2], v[3]); u.z = pack2(v[4], v[5]); u.w = pack2(v[6], v[7]);
    *(GAS u32x4*)((bf16_t*)(p.ws + OFF_CNVT) + ((size_t)((i * 8 + b) * 512 + hd)) * 256 + pos8 * 8) = u;
  } else {
    const int item = (j - 1024) * 512 + tid;
    const int e = item * 8;
    const int c = e & 255, pos = (e >> 8) & 255, i = (e >> 16) & 1, b = e >> 17;
    const f32x4 a = gld((const f32x4*)(p.in[4] + e)), bq = gld((const f32x4*)(p.in[4] + e + 4));
    u32x4 u; u.x = pack2(a.x, a.y); u.y = pack2(a.z, a.w); u.z = pack2(bq.x, bq.y); u.w = pack2(bq.z, bq.w);
    *(GAS u32x4*)((bf16_t*)(p.ws + OFF_CCKV) + ((size_t)(i * 2048 + b * 256 + pos)) * 256 + c) = u;
  }
}

DI void job_shw(const Params& p, int j, unsigned char* smem) {
  int l = 0, jj = j;
  if (jj >= 112) { jj -= 112; l = 1; if (jj >= 84) { jj -= 84; l = 2; if (jj >= 112) { jj -= 112; l = 3; } } }
  const int n1 = (l & 1) ? 20 : 48;
  const int which = jj >= n1;
  const int n0 = (which ? jj - n1 : jj) * 64;
  const bf16_t* Wt = which ? (const bf16_t*)(p.ws + OFF_W1T) + (size_t)l * 4096 * 1024
                           : ((l & 1) ? (const bf16_t*)(p.ws + OFF_OWIN) + (size_t)(l >> 1) * 1280 * 1024
                                      : (const bf16_t*)(p.ws + OFF_EWIN) + (size_t)(l >> 1) * 3072 * 1024);
  float* dst = which ? (float*)(p.ws + OFF_SHW2) + (size_t)l * 9 * 4096 : (float*)(p.ws + OFF_SHW1) + (size_t)l * 9 * 3072;
  const int ns = which ? 4096 : 3072;
  const float* mod = (const float*)(p.ws + OFF_MOD) + (size_t)l * 9 * 6144 + (which ? 3072 : 0);
  const int tid = otid(), lane = tid & 63, w = tid >> 6;
  float* s = (float*)smem;
  __syncthreads();
  for (int idx = tid; idx < 9 * 1024; idx += 512) s[idx] = mod[(idx >> 10) * 6144 + (idx & 1023)];
  __syncthreads();
  const bf16_t* wr = Wt + (size_t)(n0 + lane) * 1024 + w * 128;
  float acc[9];
#pragma unroll
  for (int mi = 0; mi < 9; ++mi) acc[mi] = 0.f;
#pragma unroll 2
  for (int c = 0; c < 16; ++c) {
    const u32x4 u = gld((const u32x4*)(wr + c * 8));
    const float wv[8] = {bflo(u.x), bfhi(u.x), bflo(u.y), bfhi(u.y), bflo(u.z), bfhi(u.z), bflo(u.w), bfhi(u.w)};
#pragma unroll
    for (int q = 0; q < 8; ++q)
#pragma unroll
      for (int mi = 0; mi < 9; ++mi) acc[mi] += s[mi * 1024 + w * 128 + c * 8 + q] * wv[q];
  }
  __syncthreads();
  float* red = (float*)smem;
#pragma unroll
  for (int mi = 0; mi < 9; ++mi) red[(w * 9 + mi) * 64 + lane] = acc[mi];
  __syncthreads();
  for (int idx = tid; idx < 9 * 64; idx += 512) {
    const int mi = idx >> 6, ln = idx & 63;
    float v = 0.f;
#pragma unroll
    for (int q = 0; q < 8; ++q) v += red[(q * 9 + mi) * 64 + ln];
    dst[(size_t)mi * ns + n0 + ln] = v;
  }
}

DI void job_xpass(const Params& p, int j) {
  const int tid = otid(), lane = tid & 63, w = tid >> 6;
  const int m = j * 8 + w, mi = mi_of(m);
  const float* x = m < TP ? p.in[0] + (size_t)m * 1024 : p.in[1] + (size_t)(m - TP) * 1024;
  const float* g1 = p.in[10];
  const float* sc = (const float*)(p.ws + OFF_MOD) + (size_t)mi * 6144 + 1024;
  float* y = p.out + OUT_Y + (size_t)m * 1024;
  bf16_t* ab = (bf16_t*)(p.ws + OFF_ABUF) + (size_t)m * 1024;
  float ss = 0.f;
#pragma unroll
  for (int i = 0; i < 4; ++i) {
    const int k = lane * 4 + 256 * i;
    const f32x4 v = gld((const f32x4*)(x + k));
    const f32x4 g = gld((const f32x4*)(g1 + k));
    const f32x4 s4 = gld((const f32x4*)(sc + k));
    ss += v.x * v.x + v.y * v.y + v.z * v.z + v.w * v.w;
    *(GAS f32x4*)(y + k) = v;
    store_bf4(ab + k, v.x * g.x * (1.f + s4.x), v.y * g.y * (1.f + s4.y), v.z * g.z * (1.f + s4.z), v.w * g.w * (1.f + s4.w));
  }
#pragma unroll
  for (int o = 32; o >= 1; o >>= 1) ss += __shfl_xor(ss, o, 64);
  float* ssq = (float*)(p.ws + OFF_SSQ1);
  if (lane < 16) ssq[(size_t)lane * T + m] = lane == 0 ? ss : 0.f;
}

DI void job_conv(const Params& p, int j, int li) {
  const int item = j * 512 + otid();
  const int m = item >> 6, c = (item & 63) * 8;
  const bf16_t* bc = (const bf16_t*)(p.ws + OFF_BCONV);
  int pos, L;
  if (m < TP) { pos = m & 255; L = 256; } else { pos = (m - TP) & 1023; L = 1024; }
  const float* cw = p.in[15] + (size_t)li * 3 * 512 + c;
  float accv[8];
#pragma unroll
  for (int q = 0; q < 8; ++q) accv[q] = 0.f;
#pragma unroll
  for (int d = -1; d <= 1; ++d) {
    const int pp = pos + d;
    if (pp < 0 || pp >= L) continue;
    const u32x4 cg = gld((const u32x4*)(bc + (size_t)(m + d) * 1536 + 512 + c));
    const u32x4 xa = gld((const u32x4*)(bc + (size_t)(m + d) * 1536 + 1024 + c));
    const f32x4 w0 = gld((const f32x4*)(cw + (d + 1) * 512)), w1 = gld((const f32x4*)(cw + (d + 1) * 512 + 4));
    accv[0] += bflo(cg.x) * bflo(xa.x) * w0.x; accv[1] += bfhi(cg.x) * bfhi(xa.x) * w0.y;
    accv[2] += bflo(cg.y) * bflo(xa.y) * w0.z; accv[3] += bfhi(cg.y) * bfhi(xa.y) * w0.w;
    accv[4] += bflo(cg.z) * bflo(xa.z) * w1.x; accv[5] += bfhi(cg.z) * bfhi(xa.z) * w1.y;
    accv[6] += bflo(cg.w) * bflo(xa.w) * w1.z; accv[7] += bfhi(cg.w) * bfhi(xa.w) * w1.w;
  }
  const u32x4 bg = gld((const u32x4*)(bc + (size_t)m * 1536 + c));
  u32x4 u;
  u.x = pack2(bflo(bg.x) * accv[0], bfhi(bg.x) * accv[1]); u.y = pack2(bflo(bg.y) * accv[2], bfhi(bg.y) * accv[3]);
  u.z = pack2(bflo(bg.z) * accv[4], bfhi(bg.z) * accv[5]); u.w = pack2(bflo(bg.w) * accv[6], bfhi(bg.w) * accv[7]);
  *(GAS u32x4*)((bf16_t*)(p.ws + OFF_CAT) + (size_t)m * 1024 + c) = u;
}

DI void job_poolx(const Params& p, int j) {
  const int item = j * 512 + otid();
  const int m = item >> 6, c = (item & 63) * 8;
  const bf16_t* ub = (const bf16_t*)(p.ws + OFF_UBUF);
  int pos, L;
  if (m < TP) { pos = m & 255; L = 256; } else { pos = (m - TP) & 1023; L = 1024; }
  const int wsz = 2 << (c >> 7);
  const int lo = min(max(pos - wsz / 2, 0), L), hi = min(max(pos - wsz / 2 + wsz, 0), L);
  float s[8];
#pragma unroll
  for (int q = 0; q < 8; ++q) s[q] = 0.f;
  u32x4 uu[16];
#pragma unroll
  for (int q = 0; q < 16; ++q) {
    const u32x4 z = {0u, 0u, 0u, 0u};
    uu[q] = (lo + q < hi) ? gld((const u32x4*)(ub + (size_t)(m + lo + q - pos) * 512 + c)) : z;
  }
#pragma unroll
  for (int q = 0; q < 16; ++q) {
    const u32x4 u = uu[q];
    s[0] += bflo(u.x); s[1] += bfhi(u.x); s[2] += bflo(u.y); s[3] += bfhi(u.y); s[4] += bflo(u.z); s[5] += bfhi(u.z); s[6] += bflo(u.w); s[7] += bfhi(u.w);
  }
  const float inv = 1.f / (float)(hi - lo);
  const u32x4 u = gld((const u32x4*)(ub + (size_t)m * 512 + c));
  u32x4 o;
  o.x = pack2(s[0] * inv - bflo(u.x), s[1] * inv - bfhi(u.x)); o.y = pack2(s[2] * inv - bflo(u.y), s[3] * inv - bfhi(u.y));
  o.z = pack2(s[4] * inv - bflo(u.z), s[5] * inv - bfhi(u.z)); o.w = pack2(s[6] * inv - bflo(u.w), s[7] * inv - bfhi(u.w));
  *(GAS u32x4*)((bf16_t*)(p.ws + OFF_XP) + (size_t)m * 512 + c) = o;
}

DI void job_ckvstate(const Params& p, int j, int li) {
  const int item = j * 512 + otid();
  const int m = item >> 6, c = (item & 63) * 4;
  const float rs = rstd_parts<2>((const float*)(p.ws + OFF_SSQKV), m, 1.f / 256.f);
  float* o = p.out + OUT_CKV + ((size_t)(((m >> 8) * 2 + li) * 256 + (m & 255))) * 256 + c;
  const f32x4 g = gld((const f32x4*)(p.in[25] + li * 256 + c));
  f32x4 v = gld((const f32x4*)((const float*)(p.ws + OFF_KVRAW) + (size_t)m * 256 + c));
  v.x *= rs * g.x; v.y *= rs * g.y; v.z *= rs * g.z; v.w *= rs * g.w;
  *(GAS f32x4*)o = v;
}

__global__ void __launch_bounds__(NTHREADS, 2) fwd_megakernel(Params p) {
  __shared__ __attribute__((aligned(16))) unsigned char smem[SMEM_BYTES];
  __shared__ u32x4 xb_words;
  cg::grid_group grid = cg::this_grid();
  if (p.pad_ == 0x7fffffff) grid.sync();
  if (threadIdx.x == 0) { const u32x4 z = {0u, 0u, 0u, 0u}; xb_words = z; }
  __syncthreads();
  const XcdBarrier xb = xcd_barrier_post((unsigned*)(p.ws + OFF_BAR), (volatile LAS unsigned*)&xb_words);
  const int nb = gridDim.x, bid = blockIdx.x;
  unsigned char* const ws_ = p.ws;
  float* const out_ = p.out;

#ifndef SKIP_PH0
  for (int rep_ = 0; rep_ < REP_PH0; ++rep_) {
    const int n_mod = 384, n_conv = p.conv_tiles, n_cache = 1280;
    for (int j = bid; j < n_mod + n_conv + n_cache; j += nb) {
      if (j < n_mod) { for (int q_ = 0; q_ < REP_MODS; ++q_) job_mods(p, j, smem); }
      else if (j < n_mod + n_conv) { for (int q_ = 0; q_ < REP_WCONV; ++q_) job_wconv(p, j - n_mod); }
      else { for (int q_ = 0; q_ < REP_CACHE; ++q_) job_cache(p, j - n_mod - n_conv); }
    }
  }
#endif
  xcd_barrier(xb);
#ifndef SKIP_PH1
  for (int rep_ = 0; rep_ < REP_PH1; ++rep_) {
    for (int j = bid; j < 392 + 1536; j += nb) {
      if (j < 392) job_shw(p, j, smem); else job_xpass(p, j - 392);
    }
  }
#endif
  xcd_barrier(xb);

#pragma unroll 1
  for (int l = 0; l < 4; ++l) {
    const int li = l >> 1;
    if ((l & 1) == 0) {
#ifndef SKIP_E2
      for (int rep_ = 0; rep_ < REP_E2; ++rep_) {
        unsigned char* ws = uniform_ptr(ws_); float* ybuf = (float*)uniform_ptr(out_); asm volatile("" : "+s"(ws), "+s"(ybuf));
        float* mod = (float*)(ws + OFF_MOD); bf16_t* abuf = (bf16_t*)(ws + OFF_ABUF); bf16_t* cat = (bf16_t*)(ws + OFF_CAT); bf16_t* act = (bf16_t*)(ws + OFF_ACT);
        float* ssq1 = (float*)(ws + OFF_SSQ1); float* ssq2 = (float*)(ws + OFF_SSQ2); const float* modl = mod + (size_t)l * 9 * 6144;
        (void)mod; (void)abuf; (void)cat; (void)act; (void)ssq1; (void)ssq2; (void)modl; (void)ybuf;
        EpiEvenIn e;
        e.ssq = ssq1; e.shw = (const float*)(ws + OFF_SHW1) + (size_t)l * 9 * 3072; e.gq = p.in[16] + li * 64; e.gk = p.in[17] + li * 64;
        e.bconv = (bf16_t*)(ws + OFF_BCONV); e.qbuf = (bf16_t*)(ws + OFF_QBUF); e.kbuf = (bf16_t*)(ws + OFF_KBUF);
        e.vtp = (bf16_t*)(ws + OFF_VTP); e.vts = (bf16_t*)(ws + OFF_VTS); e.out_k = ybuf + OUT_NAK; e.out_v = ybuf + OUT_NAV; e.li = li;
        const bf16_t* W = (const bf16_t*)(ws + OFF_EWIN) + (size_t)li * 3072 * 1024;
        for (int t = bid; t < 64 * 12; t += nb) gemm_tile<192, 4>(abuf, 1024, W, 1024, (t % 64) * 192, (t / 64) * 256, e, smem);
      }
#endif
      xcd_barrier(xb);
#ifndef SKIP_E3
      for (int rep_ = 0; rep_ < REP_E3; ++rep_) {
        unsigned char* ws = uniform_ptr(ws_); float* ybuf = (float*)uniform_ptr(out_); asm volatile("" : "+s"(ws), "+s"(ybuf));
        float* mod = (float*)(ws + OFF_MOD); bf16_t* abuf = (bf16_t*)(ws + OFF_ABUF); bf16_t* cat = (bf16_t*)(ws + OFF_CAT); bf16_t* act = (bf16_t*)(ws + OFF_ACT);
        float* ssq1 = (float*)(ws + OFF_SSQ1); float* ssq2 = (float*)(ws + OFF_SSQ2); const float* modl = mod + (size_t)l * 9 * 6144;
        (void)mod; (void)abuf; (void)cat; (void)act; (void)ssq1; (void)ssq2; (void)modl; (void)ybuf;
        const bf16_t* qb = (const bf16_t*)(ws + OFF_QBUF); const bf16_t* kb = (const bf16_t*)(ws + OFF_KBUF);
        const bf16_t* vtp = (const bf16_t*)(ws + OFF_VTP); const bf16_t* vts = (const bf16_t*)(ws + OFF_VTS);
        const bf16_t* cnk = (const bf16_t*)(ws + OFF_CNK) + (size_t)li * 2048 * 512;
        const bf16_t* cnvt = (const bf16_t*)(ws + OFF_CNVT) + (size_t)li * 2048 * 512;
        for (int j = bid; j < 256 + 128 + 1536; j += nb) {
          if (j < 256) {
            const int rq = j & 3, hd = (j >> 2) & 7, b = j >> 5;
            const int tok0 = TP + b * 1024 + rq * 256;
            const int kr0 = min(max(4 * rq - 4, 0), 8), kr1 = min(max(4 * rq + 3 - 4, 0), 8) + 8;
            attn_task<64>(qb + (size_t)tok0 * 512 + hd * 64, 512,
                          kb + (size_t)(TP + b * 1024 + kr0 * 64) * 512 + hd * 64, 512, vts + ((size_t)(b * 8 + hd) * 64) * 1024 + kr0 * 64, 1024, kr1 - kr0,
                          cnk + (size_t)(b * 256) * 512 + hd * 64, 512, cnvt + ((size_t)(b * 8 + hd) * 64) * 256, 256, 4,
                          true, 4 * rq, kr0, p.in[18] + (size_t)(li * 8 + hd) * 465,
                          cat + (size_t)tok0 * 1024 + 512 + hd * 64, 1024, 0.125f, smem);
          } else if (j < 384) {
            const int jj = j - 256, hd = jj & 7, b = jj >> 3;
            const int tok0 = b * 256;
            attn_task<64>(qb + (size_t)tok0 * 512 + hd * 64, 512,
                          kb + (size_t)(b * 256) * 512 + hd * 64, 512, vtp + ((size_t)(b * 8 + hd) * 64) * 256, 256, 4,
                          kb, 512, vtp, 256, 0,
                          false, 0, 0, p.in[18],
                          cat + (size_t)tok0 * 1024 + 512 + hd * 64, 1024, 0.125f, smem);
          } else job_conv(p, j - 384, li);
        }
      }
#endif
      xcd_barrier(xb);
#ifndef SKIP_E4
      {
        unsigned char* ws = uniform_ptr(ws_); float* ybuf = (float*)uniform_ptr(out_); asm volatile("" : "+s"(ws), "+s"(ybuf));
        float* mod = (float*)(ws + OFF_MOD); bf16_t* abuf = (bf16_t*)(ws + OFF_ABUF); bf16_t* cat = (bf16_t*)(ws + OFF_CAT); bf16_t* act = (bf16_t*)(ws + OFF_ACT);
        float* ssq1 = (float*)(ws + OFF_SSQ1); float* ssq2 = (float*)(ws + OFF_SSQ2); const float* modl = mod + (size_t)l * 9 * 6144;
        (void)mod; (void)abuf; (void)cat; (void)act; (void)ssq1; (void)ssq2; (void)modl; (void)ybuf;
        EpiResid e; e.gscale = 1.f; e.y = ybuf; e.gate = modl + 2048; e.ng = p.in[11] + l * 1024; e.nsc = modl + 4096; e.abuf = abuf; e.ssq_out = ssq2;
        const bf16_t* W = (const bf16_t*)(ws + OFF_EWOUT) + (size_t)li * 1024 * 1024;
#if PROBE_RESID
        e.gscale = 0.f;
        for (int t = bid; t < 64 * 4; t += nb) gemm_tile<192, 4>(cat, 1024, W, 1024, (t % 64) * 192, (t / 64) * 256, e, smem);
        e.gscale = 1.f; __syncthreads();
#endif
        for (int t = bid; t < 64 * 4; t += nb) gemm_tile<192, 4>(cat, 1024, W, 1024, (t % 64) * 192, (t / 64) * 256, e, smem);
      }
#endif
      xcd_barrier(xb);
    } else {
#ifndef SKIP_O2
      for (int rep_ = 0; rep_ < REP_O2; ++rep_) {
        unsigned char* ws = uniform_ptr(ws_); float* ybuf = (float*)uniform_ptr(out_); asm volatile("" : "+s"(ws), "+s"(ybuf));
        float* mod = (float*)(ws + OFF_MOD); bf16_t* abuf = (bf16_t*)(ws + OFF_ABUF); bf16_t* cat = (bf16_t*)(ws + OFF_CAT); bf16_t* act = (bf16_t*)(ws + OFF_ACT);
        float* ssq1 = (float*)(ws + OFF_SSQ1); float* ssq2 = (float*)(ws + OFF_SSQ2); const float* modl = mod + (size_t)l * 9 * 6144;
        (void)mod; (void)abuf; (void)cat; (void)act; (void)ssq1; (void)ssq2; (void)modl; (void)ybuf;
        EpiOddIn e;
        e.ssq = ssq1; e.shw = (const float*)(ws + OFF_SHW1) + (size_t)l * 9 * 3072; e.ubuf = (bf16_t*)(ws + OFF_UBUF); e.qlat = (bf16_t*)(ws + OFF_QLAT);
        e.kvlat = (bf16_t*)(ws + OFF_KVLAT); e.kpebuf = (float*)(ws + OFF_KPE); e.ssqq = (float*)(ws + OFF_SSQQ); e.ssqkv = (float*)(ws + OFF_SSQKV);
        e.out_ckv = (float*)(ws + OFF_KVRAW); e.out_kpe = ybuf + OUT_KPE; e.li = li;
        const bf16_t* W = (const bf16_t*)(ws + OFF_OWIN) + (size_t)li * 1280 * 1024;
        for (int t = bid; t < 48 * 5; t += nb) gemm_tile<256, 2>(abuf, 1024, W, 1024, (t % 48) * 256, (t / 48) * 256, e, smem);
      }
#endif
      xcd_barrier(xb);
#ifndef SKIP_O3
      for (int rep_ = 0; rep_ < REP_O3; ++rep_) {
        unsigned char* ws = uniform_ptr(ws_); float* ybuf = (float*)uniform_ptr(out_); asm volatile("" : "+s"(ws), "+s"(ybuf));
        float* mod = (float*)(ws + OFF_MOD); bf16_t* abuf = (bf16_t*)(ws + OFF_ABUF); bf16_t* cat = (bf16_t*)(ws + OFF_CAT); bf16_t* act = (bf16_t*)(ws + OFF_ACT);
        float* ssq1 = (float*)(ws + OFF_SSQ1); float* ssq2 = (float*)(ws + OFF_SSQ2); const float* modl = mod + (size_t)l * 9 * 6144;
        (void)mod; (void)abuf; (void)cat; (void)act; (void)ssq1; (void)ssq2; (void)modl; (void)ybuf;
        EpiKvUp ek; ek.ssqkv = (const float*)(ws + OFF_SSQKV); ek.gk = p.in[28] + li * 96; ek.kpebuf = (const float*)(ws + OFF_KPE); ek.cache_kpe = p.in[5];
        ek.kpm = (bf16_t*)(ws + OFF_KPM); ek.ksm = (bf16_t*)(ws + OFF_KSM); ek.vtpm = (bf16_t*)(ws + OFF_VTPM); ek.vtsm = (bf16_t*)(ws + OFF_VTSM); ek.li = li; ek.cache = 0;
        EpiQUp eq; eq.ssqq = (const float*)(ws + OFF_SSQQ); eq.gq = p.in[27] + li * 96; eq.qmla = (bf16_t*)(ws + OFF_QMLA);
        const bf16_t* Wkv = (const bf16_t*)(ws + OFF_WKVB) + (size_t)li * 1024 * 256;
        const bf16_t* Wq = (const bf16_t*)(ws + OFF_WQB) + (size_t)li * 1024 * 384;
        const bf16_t* cckv = (const bf16_t*)(ws + OFF_CCKV) + (size_t)li * 2048 * 256;
        for (int j = bid; j < 448 + 384 + 1536 + 512; j += nb) {
          if (j < 448) {
            const int mt = j % 112, nt = j / 112;
            const bool cch = mt >= 96;
            ek.cache = cch ? 1 : 0;
            gemm_tile<128, 2>(cch ? cckv : (const bf16_t*)(ws + OFF_KVLAT), 256, Wkv, 256, (cch ? mt - 96 : mt) * 128, nt * 256, ek, smem);
          } else if (j < 448 + 384) {
            const int jj = j - 448;
            gemm_tile<128, 2>((const bf16_t*)(ws + OFF_QLAT), 384, Wq, 384, (jj % 96) * 128, (jj / 96) * 256, eq, smem);
          } else if (j < 448 + 384 + 1536) job_poolx(p, j - 448 - 384);
          else job_ckvstate(p, j - 448 - 384 - 1536, li);
        }
      }
#endif
      xcd_barrier(xb);
#ifndef SKIP_O4
      for (int rep_ = 0; rep_ < REP_O4; ++rep_) {
        unsigned char* ws = uniform_ptr(ws_); float* ybuf = (float*)uniform_ptr(out_); asm volatile("" : "+s"(ws), "+s"(ybuf));
        float* mod = (float*)(ws + OFF_MOD); bf16_t* abuf = (bf16_t*)(ws + OFF_ABUF); bf16_t* cat = (bf16_t*)(ws + OFF_CAT); bf16_t* act = (bf16_t*)(ws + OFF_ACT);
        float* ssq1 = (float*)(ws + OFF_SSQ1); float* ssq2 = (float*)(ws + OFF_SSQ2); const float* modl = mod + (size_t)l * 9 * 6144;
        (void)mod; (void)abuf; (void)cat; (void)act; (void)ssq1; (void)ssq2; (void)modl; (void)ybuf;
        const bf16_t* qm = (const bf16_t*)(ws + OFF_QMLA);
        const bf16_t* kpm = (const bf16_t*)(ws + OFF_KPM); const bf16_t* ksm = (const bf16_t*)(ws + OFF_KSM);
        const bf16_t* vtpm = (const bf16_t*)(ws + OFF_VTPM); const bf16_t* vtsm = (const bf16_t*)(ws + OFF_VTSM);
        const float sc = 0.10206207261596575f;
        for (int j = bid; j < 256 + 128 + 96; j += nb) {
          if (j < 256) {
            const int qb2 = j & 3, hd = (j >> 2) & 7, b = j >> 5;
            const int tok0 = TP + b * 1024 + qb2 * 256;
            attn_task<96>(qm + (size_t)tok0 * 768 + hd * 96, 768,
                          ksm + ((size_t)(b * 8 + hd) * 1280) * 96, 96, vtsm + ((size_t)(b * 8 + hd) * 64) * 1280, 1280, 20,
                          ksm, 96, vtsm, 1280, 0, false, 0, 0, p.in[18],
                          cat + (size_t)tok0 * 1024 + 512 + hd * 64, 1024, sc, smem);
          } else if (j < 384) {
            const int jj = j - 256, hd = jj & 7, b = jj >> 3;
            const int tok0 = b * 256;
            attn_task<96>(qm + (size_t)tok0 * 768 + hd * 96, 768,
                          kpm + ((size_t)(b * 8 + hd) * 256) * 96, 96, vtpm + ((size_t)(b * 8 + hd) * 64) * 256, 256, 4,
                          kpm, 96, vtpm, 256, 0, false, 0, 0, p.in[18],
                          cat + (size_t)tok0 * 1024 + 512 + hd * 64, 1024, sc, smem);
          } else {
            const int jj = j - 384;
            EpiPool e; e.scale = p.in[22] + li * 512; e.cat = cat;
            gemm_tile<256, 2>((const bf16_t*)(ws + OFF_XP), 512, (const bf16_t*)(ws + OFF_POOLW) + (size_t)li * 512 * 512, 512, (jj % 48) * 256, (jj / 48) * 256, e, smem);
          }
        }
      }
#endif
      xcd_barrier(xb);
#ifndef SKIP_O5
      {
        unsigned char* ws = uniform_ptr(ws_); float* ybuf = (float*)uniform_ptr(out_); asm volatile("" : "+s"(ws), "+s"(ybuf));
        float* mod = (float*)(ws + OFF_MOD); bf16_t* abuf = (bf16_t*)(ws + OFF_ABUF); bf16_t* cat = (bf16_t*)(ws + OFF_CAT); bf16_t* act = (bf16_t*)(ws + OFF_ACT);
        float* ssq1 = (float*)(ws + OFF_SSQ1); float* ssq2 = (float*)(ws + OFF_SSQ2); const float* modl = mod + (size_t)l * 9 * 6144;
        (void)mod; (void)abuf; (void)cat; (void)act; (void)ssq1; (void)ssq2; (void)modl; (void)ybuf;
        EpiResid e; e.gscale = 1.f; e.y = ybuf; e.gate = modl + 2048; e.ng = p.in[11] + l * 1024; e.nsc = modl + 4096; e.abuf = abuf; e.ssq_out = ssq2;
        const bf16_t* W = (const bf16_t*)(ws + OFF_OWOUT) + (size_t)li * 1024 * 1024;
#if PROBE_RESID
        e.gscale = 0.f;
        for (int t = bid; t < 64 * 4; t += nb) gemm_tile<192, 4>(cat, 1024, W, 1024, (t % 64) * 192, (t / 64) * 256, e, smem);
        e.gscale = 1.f; __syncthreads();
#endif
        for (int t = bid; t < 64 * 4; t += nb) gemm_tile<192, 4>(cat, 1024, W, 1024, (t % 64) * 192, (t / 64) * 256, e, smem);
      }
#endif
      xcd_barrier(xb);
    }
#ifndef SKIP_M1
    {
        unsigned char* ws = uniform_ptr(ws_); float* ybuf = (float*)uniform_ptr(out_); asm volatile("" : "+s"(ws), "+s"(ybuf));
        float* mod = (float*)(ws + OFF_MOD); bf16_t* abuf = (bf16_t*)(ws + OFF_ABUF); bf16_t* cat = (bf16_t*)(ws + OFF_CAT); bf16_t* act = (bf16_t*)(ws + OFF_ACT);
        float* ssq1 = (float*)(ws + OFF_SSQ1); float* ssq2 = (float*)(ws + OFF_SSQ2); const float* modl = mod + (size_t)l * 9 * 6144;
        (void)mod; (void)abuf; (void)cat; (void)act; (void)ssq1; (void)ssq2; (void)modl; (void)ybuf;
      EpiMlp1 e; e.ssq = ssq2; e.shw = (const float*)(ws + OFF_SHW2) + (size_t)l * 9 * 4096; e.act = act;
      const bf16_t* W = (const bf16_t*)(ws + OFF_W1T) + (size_t)l * 4096 * 1024;
#if PROBE_M1 == 1
      for (int t = bid; t < 48 * 16; t += nb) gemm_tile<256, 2>(abuf, 1024, W, 1024, (t % 48) * 256, (t / 48) * 256, e, smem);
#elif PROBE_M1 == 2
      for (int t = bid; t < 48 * 16; t += nb) gemm_tile<256, 2, true>(abuf, 1024, W, 1024, (t % 48) * 256, (t / 48) * 256, e, smem);
#endif
      for (int t = bid; t < 48 * 16; t += nb) gemm_tile<256, 2>(abuf, 1024, W, 1024, (t % 48) * 256, (t / 48) * 256, e, smem);
    }
#endif
    xcd_barrier(xb);
#ifndef SKIP_M2
    {
        unsigned char* ws = uniform_ptr(ws_); float* ybuf = (float*)uniform_ptr(out_); asm volatile("" : "+s"(ws), "+s"(ybuf));
        float* mod = (float*)(ws + OFF_MOD); bf16_t* abuf = (bf16_t*)(ws + OFF_ABUF); bf16_t* cat = (bf16_t*)(ws + OFF_CAT); bf16_t* act = (bf16_t*)(ws + OFF_ACT);
        float* ssq1 = (float*)(ws + OFF_SSQ1); float* ssq2 = (float*)(ws + OFF_SSQ2); const float* modl = mod + (size_t)l * 9 * 6144;
        (void)mod; (void)abuf; (void)cat; (void)act; (void)ssq1; (void)ssq2; (void)modl; (void)ybuf;
      EpiResid e; e.gscale = 1.f; e.y = ybuf; e.gate = modl + 5120;
      if (l < 3) { e.ng = p.in[10] + (l + 1) * 1024; e.nsc = mod + (size_t)(l + 1) * 9 * 6144 + 1024; } else { e.ng = nullptr; e.nsc = nullptr; }
      e.abuf = abuf; e.ssq_out = ssq1;
      const bf16_t* W = (const bf16_t*)(ws + OFF_W2T) + (size_t)l * 1024 * 4096;
#if PROBE_M2
      e.gscale = 0.f;
      for (int t = bid; t < 64 * 4; t += nb) gemm_tile<192, 4>(act, 4096, W, 4096, (t % 64) * 192, (t / 64) * 256, e, smem);
      e.gscale = 1.f; __syncthreads();
#endif
      for (int t = bid; t < 64 * 4; t += nb) gemm_tile<192, 4>(act, 4096, W, 4096, (t % 64) * 192, (t / 64) * 256, e, smem);
    }
#endif
    if (l < 3) xcd_barrier(xb);
  }
}

static void add_mat(Params& p, int& idx, int& tiles, const float* src, const float* rscale, size_t dst, int K, int N, int Npad, int headpad, int blockdiag) {
  MatDesc& m = p.mats[idx++];
  m.src = src; m.rscale = rscale; m.dst = dst; m.K = K; m.N = N; m.Npad = Npad; m.headpad = headpad; m.tile0 = tiles; m.blockdiag = blockdiag;
  tiles += (K / 128) * (Npad / 64);
}

extern "C" void kernel_launch(void* const* d_in, const int* in_sizes, int n_in, void* d_out, int out_size, void* d_ws, size_t ws_size, hipStream_t stream) {
  if (ws_size < WS_NEED) { fprintf(stderr, "kernel_launch: workspace too small (%zu < %zu)\n", ws_size, (size_t)WS_NEED); return; }
  static int grid_blocks = 0;
  if (!grid_blocks) {
    int dev = 0, cus = 0, per_cu = 0;
    (void)hipGetDevice(&dev);
    (void)hipDeviceGetAttribute(&cus, hipDeviceAttributeMultiprocessorCount, dev);
    (void)hipOccupancyMaxActiveBlocksPerMultiprocessor(&per_cu, fwd_megakernel, NTHREADS, 0);
    if (per_cu < 1) fprintf(stderr, "kernel_launch: occupancy query reports %d blocks per CU\n", per_cu);
    grid_blocks = cus;
  }
  Params p;
  memset(&p, 0, sizeof(p));
  for (int i = 0; i < 30; ++i) p.in[i] = (const float*)d_in[i];
  p.out = (float*)d_out; p.ws = (unsigned char*)d_ws;
  int idx = 0, tiles = 0;
  for (int l = 0; l < 4; ++l) add_mat(p, idx, tiles, p.in[12] + (size_t)l * 1024 * 4096, nullptr, OFF_W1T + (size_t)l * 4096 * 1024 * 2, 1024, 4096, 4096, 0, 0);
  for (int l = 0; l < 4; ++l) add_mat(p, idx, tiles, p.in[13] + (size_t)l * 4096 * 1024, nullptr, OFF_W2T + (size_t)l * 4096 * 1024 * 2, 4096, 1024, 1024, 0, 0);
  for (int i = 0; i < 2; ++i) add_mat(p, idx, tiles, p.in[14] + (size_t)i * 1024 * 3072, nullptr, OFF_EWIN + (size_t)i * 3072 * 1024 * 2, 1024, 3072, 3072, 0, 0);
  for (int i = 0; i < 2; ++i) add_mat(p, idx, tiles, p.in[19] + (size_t)i * 1024 * 1024, nullptr, OFF_EWOUT + (size_t)i * 1024 * 1024 * 2, 1024, 1024, 1024, 0, 0);
  for (int i = 0; i < 2; ++i) add_mat(p, idx, tiles, p.in[20] + (size_t)i * 1024 * 1184, nullptr, OFF_OWIN + (size_t)i * 1280 * 1024 * 2, 1024, 1184, 1280, 0, 0);
  for (int i = 0; i < 2; ++i) add_mat(p, idx, tiles, p.in[24] + (size_t)i * 384 * 768, p.in[23] + i * 384, OFF_WQB + (size_t)i * 1024 * 384 * 2, 384, 768, 1024, 1, 0);
  for (int i = 0; i < 2; ++i) add_mat(p, idx, tiles, p.in[26] + (size_t)i * 256 * 1024, p.in[25] + i * 256, OFF_WKVB + (size_t)i * 1024 * 256 * 2, 256, 1024, 1024, 0, 0);
  for (int i = 0; i < 2; ++i) add_mat(p, idx, tiles, p.in[29] + (size_t)i * 1024 * 1024, nullptr, OFF_OWOUT + (size_t)i * 1024 * 1024 * 2, 1024, 1024, 1024, 0, 0);
  for (int i = 0; i < 2; ++i) add_mat(p, idx, tiles, p.in[21] + (size_t)i * 4 * 128 * 128, nullptr, OFF_POOLW + (size_t)i * 512 * 512 * 2, 512, 512, 512, 0, 1);
  p.conv_tiles = tiles;
  if (hipMemsetAsync((unsigned char*)d_ws + OFF_BAR, 0, 16384, stream) != hipSuccess) { fprintf(stderr, "kernel_launch: memset of barrier words failed\n"); return; }
  void* args[] = {&p};
  hipError_t e = hipLaunchCooperativeKernel((void*)fwd_megakernel, dim3(grid_blocks), dim3(NTHREADS), args, 0, stream);
  if (e != hipSuccess) fprintf(stderr, "cooperative launch failed: %s (grid %d)\n", hipGetErrorString(e), grid_blocks);
}
```

```cpp
#include <hip/hip_runtime.h>
#include <hip/hip_cooperative_groups.h>
#include <cstdio>
#include <cstdint>
#include <cstring>
namespace cg = cooperative_groups;

typedef unsigned short bf16_t;
using bf16x8 = __attribute__((ext_vector_type(8))) short;
using f32x16 = __attribute__((ext_vector_type(16))) float;
typedef __bf16 bf16v2 __attribute__((ext_vector_type(2)));
typedef unsigned u32x4 __attribute__((ext_vector_type(4)));
typedef unsigned u32x2 __attribute__((ext_vector_type(2)));
typedef float f32x4 __attribute__((ext_vector_type(4)));
#define DI __device__ __forceinline__
#define MFMA(a, b, c) __builtin_amdgcn_mfma_f32_32x32x16_bf16((a), (b), (c), 0, 0, 0)
#define CROW(i, h) (((i) & 3) + 8 * ((i) >> 2) + 4 * (h))

#ifndef REP_PH0
#define REP_PH0 1
#endif
#ifndef REP_PH1
#define REP_PH1 1
#endif
#ifndef REP_E2
#define REP_E2 1
#endif
#ifndef REP_E3
#define REP_E3 1
#endif
#ifndef REP_O3
#define REP_O3 1
#endif
#ifndef REP_O4
#define REP_O4 1
#endif
#ifndef REP_M1
#define REP_M1 1
#endif
#ifndef REP_MODS
#define REP_MODS 1
#endif
#ifndef REP_WCONV
#define REP_WCONV 1
#endif
#ifndef REP_CACHE
#define REP_CACHE 1
#endif

#ifndef PROBE_M1
#define PROBE_M1 0
#endif
#ifndef REP_PH0
#define REP_PH0 1
#endif
#ifndef REP_PH1
#define REP_PH1 1
#endif
#ifndef REP_E2
#define REP_E2 1
#endif
#ifndef REP_E3
#define REP_E3 1
#endif
#ifndef REP_O2
#define REP_O2 1
#endif
#ifndef REP_O3
#define REP_O3 1
#endif
#ifndef REP_O4
#define REP_O4 1
#endif
#ifndef PROBE_RESID
#define PROBE_RESID 0
#endif
#ifndef PROBE_M2
#define PROBE_M2 0
#endif
constexpr int T = 12288, TP = 4096;
constexpr float EPS = 1e-6f;
constexpr int NTHREADS = 512;
constexpr int NWAVES = 8;
constexpr int SMEM_BYTES = 147456 + 8192;
constexpr int SIDE_OFF = 147456;

constexpr size_t al(size_t x) { return (x + 255) & ~size_t(255); }
constexpr size_t OFF_BAR   = 0;
constexpr size_t OFF_MOD   = 16384;
constexpr size_t OFF_SHW1  = al(OFF_MOD + 4ull * 9 * 6144 * 4);
constexpr size_t OFF_SHW2  = al(OFF_SHW1 + 4ull * 9 * 3072 * 4);
constexpr size_t OFF_SSQ1  = al(OFF_SHW2 + 4ull * 9 * 4096 * 4);
constexpr size_t OFF_SSQ2  = al(OFF_SSQ1 + 16ull * T * 4);
constexpr size_t OFF_SSQQ  = al(OFF_SSQ2 + 16ull * T * 4);
constexpr size_t OFF_SSQKV = al(OFF_SSQQ + 3ull * T * 4);
constexpr size_t OFF_KPE   = al(OFF_SSQKV + 2ull * T * 4);
constexpr size_t OFF_KVRAW = al(OFF_KPE + (size_t)T * 32 * 4);
constexpr size_t OFF_CNK   = al(OFF_KVRAW + 4096ull * 256 * 4);
constexpr size_t OFF_CNVT  = al(OFF_CNK + 2ull * 2048 * 512 * 2);
constexpr size_t OFF_CCKV  = al(OFF_CNVT + 2ull * 2048 * 512 * 2);
constexpr size_t OFF_W1T   = al(OFF_CCKV + 2ull * 2048 * 256 * 2);
constexpr size_t OFF_W2T   = al(OFF_W1T + 4ull * 4096 * 1024 * 2);
constexpr size_t OFF_EWIN  = al(OFF_W2T + 4ull * 4096 * 1024 * 2);
constexpr size_t OFF_EWOUT = al(OFF_EWIN + 2ull * 3072 * 1024 * 2);
constexpr size_t OFF_OWIN  = al(OFF_EWOUT + 2ull * 1024 * 1024 * 2);
constexpr size_t OFF_WQB   = al(OFF_OWIN + 2ull * 1280 * 1024 * 2);
constexpr size_t OFF_WKVB  = al(OFF_WQB + 2ull * 1024 * 384 * 2);
constexpr size_t OFF_OWOUT = al(OFF_WKVB + 2ull * 1024 * 256 * 2);
constexpr size_t OFF_POOLW = al(OFF_OWOUT + 2ull * 1024 * 1024 * 2);
constexpr size_t OFF_ABUF  = al(OFF_POOLW + 2ull * 512 * 512 * 2);
constexpr size_t OFF_CAT   = al(OFF_ABUF + (size_t)T * 1024 * 2);
constexpr size_t OFF_ACT   = al(OFF_CAT + (size_t)T * 1024 * 2);
constexpr size_t WS_NEED   = al(OFF_ACT + (size_t)T * 4096 * 2);
constexpr size_t OFF_BCONV = OFF_ACT;
constexpr size_t OFF_QBUF  = al(OFF_BCONV + (size_t)T * 1536 * 2);
constexpr size_t OFF_KBUF  = al(OFF_QBUF + (size_t)T * 512 * 2);
constexpr size_t OFF_VTP   = al(OFF_KBUF + (size_t)T * 512 * 2);
constexpr size_t OFF_VTS   = al(OFF_VTP + 16ull * 8 * 64 * 256 * 2);
constexpr size_t OFF_UBUF  = OFF_ACT;
constexpr size_t OFF_QLAT  = al(OFF_UBUF + (size_t)T * 512 * 2);
constexpr size_t OFF_KVLAT = al(OFF_QLAT + (size_t)T * 384 * 2);
constexpr size_t OFF_XP    = al(OFF_KVLAT + (size_t)T * 256 * 2);
constexpr size_t OFF_QMLA  = al(OFF_XP + (size_t)T * 512 * 2);
constexpr size_t OFF_KPM   = al(OFF_QMLA + (size_t)T * 768 * 2);
constexpr size_t OFF_KSM   = al(OFF_KPM + 16ull * 8 * 256 * 96 * 2);
constexpr size_t OFF_VTPM  = al(OFF_KSM + 8ull * 8 * 1280 * 96 * 2);
constexpr size_t OFF_VTSM  = al(OFF_VTPM + 16ull * 8 * 64 * 256 * 2);
static_assert(OFF_VTSM + 8ull * 8 * 64 * 1280 * 2 <= WS_NEED, "odd buffers overflow");
static_assert(OFF_VTS + 8ull * 8 * 64 * 1024 * 2 <= WS_NEED, "even buffers overflow");

constexpr size_t OUT_Y   = 0;
constexpr size_t OUT_NAK = (size_t)T * 1024;
constexpr size_t OUT_NAV = OUT_NAK + 16ull * 2 * 256 * 512;
constexpr size_t OUT_CKV = OUT_NAV + 16ull * 2 * 256 * 512;
constexpr size_t OUT_KPE = OUT_CKV + 16ull * 2 * 256 * 256;

struct MatDesc { const float* src; const float* rscale; unsigned long long dst; int K, N, Npad, headpad, tile0, blockdiag; };
constexpr int NMATS = 20;
struct Params {
  const float* in[30];
  float* out;
  unsigned char* ws;
  MatDesc mats[NMATS];
  int conv_tiles;
  int pad_;
};

__device__ __forceinline__ f32x4 make_f32x4(float a, float b, float c, float d) { f32x4 v = {a, b, c, d}; return v; }
#define GAS __attribute__((address_space(1)))
template <class T> DI void gst(T* p, const T& v) { *(GAS T*)p = v; }
template <class T> DI T gld(const T* p) { return *(const GAS T*)p; }
DI unsigned char* uniform_ptr(const void* p) { const unsigned long long v = (unsigned long long)p; const unsigned lo = __builtin_amdgcn_readfirstlane((unsigned)v), hi = __builtin_amdgcn_readfirstlane((unsigned)(v >> 32)); return (unsigned char*)(((unsigned long long)hi << 32) | lo); }
DI int otid() { int t = threadIdx.x; asm volatile("" : "+v"(t)); return t; }
DI unsigned pack2(float a, float b) { bf16v2 v = {(__bf16)a, (__bf16)b}; return __builtin_bit_cast(unsigned, v); }
DI bf16_t f2bf(float a) { return __builtin_bit_cast(unsigned short, (__bf16)a); }
DI float bf2f(unsigned v16) { return __uint_as_float(v16 << 16); }
DI float bflo(unsigned u) { return __uint_as_float(u << 16); }
DI float bfhi(unsigned u) { return __uint_as_float(u & 0xffff0000u); }
DI int mi_of(int m) { return m < TP ? 0 : 1 + ((m - TP) >> 10); }
DI float xor32(float v) { return __shfl_xor(v, 32, 64); }
DI void store_bf4(bf16_t* p, float a, float b, float c, float d) { u32x2 u; u.x = pack2(a, b); u.y = pack2(c, d); *(GAS u32x2*)p = u; }
template <int NP> DI float rstd_parts(const float* ssq, int m, float invn) {
  float v[NP];
#pragma unroll
  for (int p = 0; p < NP; ++p) v[p] = gld(ssq + (size_t)p * T + m);
  float s = 0.f;
#pragma unroll
  for (int p = 0; p < NP; ++p) s += v[p];
  return rsqrtf(s * invn + EPS);
}

#define XB_TMO      128
#define XB_XCNT(j)  (256  + 64 * (j))
#define XB_XSUB(j)  (1280 + 64 * (j))
#define XB_XGEN(j)  (2304 + 64 * (j))
#define XB_TOP      3328
#define XB_TOPGEN   3392
#define XCD_BAR_WORDS 3456
#define XB_SPIN_CAP (1u << 20)
#define LAS __attribute__((address_space(3)))
DI unsigned xb_ld(unsigned* p)              { return __hip_atomic_load(p, __ATOMIC_RELAXED, __HIP_MEMORY_SCOPE_AGENT); }
DI unsigned xb_add(unsigned* p, unsigned v) { return __hip_atomic_fetch_add(p, v, __ATOMIC_RELAXED, __HIP_MEMORY_SCOPE_AGENT); }
DI unsigned xb_xcc_id() { return (unsigned)__builtin_amdgcn_s_getreg((3 << 11) | 20) & 0xFu; }
#define XB_SPIN(cond, bar) do { unsigned _sp = 0; while (cond) { __builtin_amdgcn_s_sleep(1); \
    if ((++_sp & 255u) == 0u) { if (xb_ld(&(bar)[XB_TMO])) break; if (_sp > XB_SPIN_CAP) { atomicAdd(&(bar)[XB_TMO], 1u); break; } } } } while (0)
struct XcdBarrier { unsigned* bar; unsigned x; volatile LAS unsigned* st; };
DI XcdBarrier xcd_barrier_post(unsigned* bar, volatile LAS unsigned* st) {
  XcdBarrier b; b.bar = bar; b.x = xb_xcc_id(); b.st = st;
  if (threadIdx.x == 0) (void)xb_add(&bar[XB_XCNT(b.x)], 1u);
  return b;
}
DI void xcd_barrier_complete(unsigned* bar, unsigned x, unsigned& nloc, unsigned& nx) {
  const unsigned G = gridDim.x * gridDim.y * gridDim.z;
  unsigned sum, cnt, mine, sp = 0u;
  for (;;) {
    sum = 0u; cnt = 0u; mine = 0u;
#pragma unroll
    for (unsigned j = 0; j < 16; ++j) { const unsigned c = xb_ld(&bar[XB_XCNT(j)]); sum += c; cnt += (c > 0u) ? 1u : 0u; mine = (j == x) ? c : mine; }
    if (sum == G) break;
    __builtin_amdgcn_s_sleep(1);
    if ((++sp & 255u) == 0u) { if (xb_ld(&bar[XB_TMO])) break; if (sp > XB_SPIN_CAP) { atomicAdd(&bar[XB_TMO], 1u); break; } }
  }
  nloc = mine > 0u ? mine : 1u; nx = cnt > 0u ? cnt : 1u;
}
DI void xcd_barrier(const XcdBarrier& b) {
  asm volatile("s_waitcnt vmcnt(0)" ::: "memory");
  __syncthreads();
  if (threadIdx.x == 0) {
    unsigned* bar = b.bar;
    __builtin_amdgcn_s_waitcnt(0);
    unsigned nloc = b.st[0], nx = b.st[1];
    if (nloc == 0u) { xcd_barrier_complete(bar, b.x, nloc, nx); b.st[0] = nloc; b.st[1] = nx; }
    const unsigned old = xb_add(&bar[XB_XSUB(b.x)], 1u);
    const unsigned gen = old / nloc;
    if (old + 1u == (gen + 1u) * nloc) {
      __builtin_amdgcn_fence(__ATOMIC_RELEASE, "agent");
      asm volatile("s_waitcnt vmcnt(0)" ::: "memory");
      const unsigned og = xb_add(&bar[XB_TOP], 1u);
      const unsigned tg = og / nx;
      if (og + 1u == (tg + 1u) * nx) xb_add(&bar[XB_TOPGEN], 1u);
      else XB_SPIN(xb_ld(&bar[XB_TOPGEN]) == tg, bar);
      __builtin_amdgcn_fence(__ATOMIC_ACQUIRE, "agent");
      xb_add(&bar[XB_XGEN(b.x)], 1u);
      asm volatile("s_waitcnt vmcnt(0)" ::: "memory");
    } else {
      XB_SPIN(xb_ld(&bar[XB_XGEN(b.x)]) == gen, bar);
      __builtin_amdgcn_fence(__ATOMIC_ACQUIRE, "agent");
      asm volatile("s_waitcnt vmcnt(0)" ::: "memory");
    }
  }
  __syncthreads();
}

typedef __attribute__((address_space(3))) unsigned lds_u32_t;
template <int OFF> DI bf16x8 lds_rd128(unsigned addr) { bf16x8 v; asm volatile("ds_read_b128 %0, %1 offset:%2" : "=v"(v) : "v"(addr), "n"(OFF) : "memory"); return v; }
template <int N, int NW, int NA> DI void lgkm_wait(bf16x8 (&wf)[NW], bf16x8 (&af)[NA]) {
  if constexpr (NW == 4 && NA == 2) asm volatile("s_waitcnt lgkmcnt(%6)" : "+v"(wf[0]), "+v"(wf[1]), "+v"(wf[2]), "+v"(wf[3]), "+v"(af[0]), "+v"(af[1]) : "n"(N) : "memory");
  else if constexpr (NW == 2 && NA == 3) asm volatile("s_waitcnt lgkmcnt(%5)" : "+v"(wf[0]), "+v"(wf[1]), "+v"(af[0]), "+v"(af[1]), "+v"(af[2]) : "n"(N) : "memory");
  else asm volatile("s_waitcnt lgkmcnt(%5)" : "+v"(wf[0]), "+v"(wf[1]), "+v"(wf[2]), "+v"(wf[3]), "+v"(af[0]) : "n"(N) : "memory");
}
template <int TM, int WNW, bool DRY = false, class Epi>
DI void gemm_tile(const bf16_t* __restrict__ A, int lda, const bf16_t* __restrict__ W, int K, int m0, int n0, const Epi& epi, unsigned char* smem) {
  constexpr int WMW = 8 / WNW, NT = 256 / WNW / 32, MT = TM / WMW / 32, NLA = TM / 64, WAVE_N = 256 / WNW, WAVE_M = TM / WMW;
  constexpr int STAGE = (TM + 256) * 128;
  static_assert((NT == 4 && MT == 2) || (NT == 2 && MT == 3) || (NT == 4 && MT == 1), "fragment wait helper covers these shapes");
  const int tid = otid(), lane = tid & 63, w = tid >> 6, r = lane & 31, h = lane >> 5;
  const int wn = w % WNW, wm = w / WNW;
  f32x16 acc[NT][MT];
#pragma unroll
  for (int a = 0; a < NT; ++a)
#pragma unroll
    for (int b = 0; b < MT; ++b)
#pragma unroll
      for (int i = 0; i < 16; ++i) acc[a][b][i] = 0.f;
  const int KT = K >> 6;
  const int lrow = tid >> 3, lkc = (tid & 7) ^ ((tid >> 4) & 7);
  typedef const __attribute__((address_space(1))) unsigned* gsrc_t;
  const bf16_t* ga = A + (size_t)(m0 + lrow) * lda + lkc * 8;
  const bf16_t* gw = W + (size_t)(n0 + lrow) * K + lkc * 8;
#define DMA_TILE(KT_, ST_) do { \
    unsigned char* sa_ = smem + (ST_) * STAGE + tid * 16; \
    _Pragma("unroll") for (int i = 0; i < NLA; ++i) \
      __builtin_amdgcn_global_load_lds((gsrc_t)(ga + (size_t)(64 * i) * lda + (KT_) * 64), (lds_u32_t*)(sa_ + i * 8192), 16, 0, 0); \
    _Pragma("unroll") for (int i = 0; i < 4; ++i) \
      __builtin_amdgcn_global_load_lds((gsrc_t)(gw + (size_t)(64 * i) * K + (KT_) * 64), (lds_u32_t*)(sa_ + TM * 128 + i * 8192), 16, 0, 0); } while (0)
  __syncthreads();
  epi.side(n0, m0, tid, smem + SIDE_OFF);
  DMA_TILE(0, 0);
  const int swz = (r >> 1) & 7;
  const unsigned lbase = (unsigned)(size_t)smem;
  const unsigned offw = lbase + TM * 128 + (wn * WAVE_N + r) * 128, offa = lbase + (wm * WAVE_M + r) * 128;
  unsigned cx[4];
#pragma unroll
  for (int ks = 0; ks < 4; ++ks) cx[ks] = ((2 * ks + h) ^ swz) << 4;
#define FRAGS(BUF, KS_) do { \
    wf[BUF][0] = lds_rd128<0>(pw + cx[KS_]); wf[BUF][1] = lds_rd128<4096>(pw + cx[KS_]); \
    if constexpr (NT == 4) { wf[BUF][2] = lds_rd128<8192>(pw + cx[KS_]); wf[BUF][3] = lds_rd128<12288>(pw + cx[KS_]); } \
    af[BUF][0] = lds_rd128<0>(pa + cx[KS_]); \
    if constexpr (MT >= 2) af[BUF][1] = lds_rd128<4096>(pa + cx[KS_]); \
    if constexpr (MT >= 3) af[BUF][2] = lds_rd128<8192>(pa + cx[KS_]); } while (0)
#define MMAS(BUF) do { _Pragma("unroll") for (int a = 0; a < NT; ++a) _Pragma("unroll") for (int b = 0; b < MT; ++b) acc[a][b] = MFMA(wf[BUF][a], af[BUF][b], acc[a][b]); } while (0)
  for (int kt = 0; kt < KT; ++kt) {
    asm volatile("s_waitcnt vmcnt(0)" ::: "memory");
    __syncthreads();
    if (kt + 1 < KT) DMA_TILE(kt + 1, (kt + 1) & 1);
    __builtin_amdgcn_sched_barrier(0);
    const unsigned pw = offw + (kt & 1) * STAGE, pa = offa + (kt & 1) * STAGE;
    bf16x8 wf[2][NT], af[2][MT];
    FRAGS(0, 0);
    FRAGS(1, 1);
    lgkm_wait<NT + MT>(wf[0], af[0]);
    MMAS(0);
    __builtin_amdgcn_sched_barrier(0);
    FRAGS(0, 2);
    lgkm_wait<NT + MT>(wf[1], af[1]);
    MMAS(1);
    __builtin_amdgcn_sched_barrier(0);
    FRAGS(1, 3);
    lgkm_wait<NT + MT>(wf[0], af[0]);
    MMAS(0);
    __builtin_amdgcn_sched_barrier(0);
    lgkm_wait<0>(wf[1], af[1]);
    MMAS(1);
    __builtin_amdgcn_sched_barrier(0);
  }
#undef DMA_TILE
#undef FRAGS
#undef MMAS
  if (DRY) {
    float sdry = 0.f;
#pragma unroll
    for (int a = 0; a < NT; ++a)
#pragma unroll
      for (int b = 0; b < MT; ++b)
#pragma unroll
        for (int i = 0; i < 16; ++i) sdry += acc[a][b][i];
    if (sdry != 12345.678f) return;
  }
  __syncthreads();
  epi(acc, n0 + wn * WAVE_N, m0 + wm * WAVE_M, lane, smem + w * 9216, smem + SIDE_OFF, n0, m0);
}

struct EpiEvenIn {
  const float* ssq; const float* shw; const float* gq; const float* gk;
  bf16_t* bconv; bf16_t* qbuf; bf16_t* kbuf; bf16_t* vtp; bf16_t* vts; float* out_k; float* out_v; int li;
  DI void side(int n0, int m0, int tid, unsigned char* sd) const {
    float* f = (float*)sd;
    if (tid < 192) f[tid] = rstd_parts<16>(ssq, m0 + tid, 1.f / 1024.f);
    const int mi = mi_of(tid < 256 ? m0 : m0 + 191);
    f[192 + tid] = gld(shw + mi * 3072 + n0 + (tid & 255));
  }
  template <int MT> DI void operator()(f32x16 (&acc)[2][MT], int nb, int mb, int lane, unsigned char* wlds, const unsigned char* side, int n0, int m0) const {
    const int r = lane & 31, h = lane >> 5;
    const int region = nb >> 9;
#pragma unroll
    for (int mt = 0; mt < MT; ++mt) {
      const int m = mb + mt * 32 + r;
      const float* sf = (const float*)side;
      const float rs = sf[m - m0];
      const float* sw = sf + 192 + (mi_of(m) != mi_of(m0) ? 256 : 0) + (nb - n0);
      float ss = 0.f;
#pragma unroll
      for (int nt = 0; nt < 2; ++nt)
#pragma unroll
        for (int g = 0; g < 4; ++g) {
          const f32x4 s4 = *(const f32x4*)(sw + nt * 32 + 8 * g + 4 * h);
          acc[nt][mt][4 * g + 0] = rs * acc[nt][mt][4 * g + 0] + s4.x;
          acc[nt][mt][4 * g + 1] = rs * acc[nt][mt][4 * g + 1] + s4.y;
          acc[nt][mt][4 * g + 2] = rs * acc[nt][mt][4 * g + 2] + s4.z;
          acc[nt][mt][4 * g + 3] = rs * acc[nt][mt][4 * g + 3] + s4.w;
#pragma unroll
          for (int j = 0; j < 4; ++j) ss += acc[nt][mt][4 * g + j] * acc[nt][mt][4 * g + j];
        }
      if (region < 3) {
#pragma unroll
        for (int nt = 0; nt < 2; ++nt)
#pragma unroll
          for (int g = 0; g < 4; ++g)
            store_bf4(bconv + (size_t)m * 1536 + nb + nt * 32 + 8 * g + 4 * h, acc[nt][mt][4 * g], acc[nt][mt][4 * g + 1], acc[nt][mt][4 * g + 2], acc[nt][mt][4 * g + 3]);
      } else if (region < 5) {
        const bool isk = region == 4;
        const float* gain = isk ? gk : gq;
        bf16_t* dst = (isk ? kbuf : qbuf) + (size_t)m * 512 + (nb - (isk ? 2048 : 1536));
        float* od = nullptr;
        if (isk && m < TP) od = out_k + ((size_t)(((m >> 8) * 2 + li) * 256 + (m & 255))) * 512 + (nb - 2048);
        ss += xor32(ss);
        const float rn = rsqrtf(ss * (1.f / 64.f) + EPS);
#pragma unroll
        for (int nt = 0; nt < 2; ++nt)
#pragma unroll
          for (int g = 0; g < 4; ++g) {
            const int d = nt * 32 + 8 * g + 4 * h;
            const f32x4 g4 = gld((const f32x4*)(gain + d));
            const float o0 = acc[nt][mt][4 * g] * rn * g4.x, o1 = acc[nt][mt][4 * g + 1] * rn * g4.y, o2 = acc[nt][mt][4 * g + 2] * rn * g4.z, o3 = acc[nt][mt][4 * g + 3] * rn * g4.w;
            store_bf4(dst + d, o0, o1, o2, o3);
            if (od) *(GAS f32x4*)(od + d) = make_f32x4(o0, o1, o2, o3);
          }
      } else {
        const bool pr = m < TP;
        const int s = m - TP;
        const int hd = (nb - 2560) >> 6;
        float* od = pr ? out_v + ((size_t)(((m >> 8) * 2 + li) * 256 + (m & 255))) * 512 + (nb - 2560) : nullptr;
        bf16_t* vt0 = pr ? vtp + ((size_t)((m >> 8) * 8 + hd) * 64) * 256 + (m & 255) : vts + ((size_t)((s >> 10) * 8 + hd) * 64) * 1024 + (s & 1023);
        const int st = pr ? 256 : 1024;
#pragma unroll
        for (int nt = 0; nt < 2; ++nt)
#pragma unroll
          for (int g = 0; g < 4; ++g) {
            const int d = nt * 32 + 8 * g + 4 * h;
#pragma unroll
            for (int j = 0; j < 4; ++j) gst(vt0 + (size_t)(d + j) * st, f2bf(acc[nt][mt][4 * g + j]));
            if (pr) *(GAS f32x4*)(od + d) = make_f32x4(acc[nt][mt][4 * g], acc[nt][mt][4 * g + 1], acc[nt][mt][4 * g + 2], acc[nt][mt][4 * g + 3]);
          }
      }
    }
  }
};

struct EpiResid {
  float* y; const float* gate; const float* ng; const float* nsc; bf16_t* abuf; float* ssq_out; float gscale;
  DI void side(int n0, int m0, int tid, unsigned char* sd) const {
    float* f = (float*)sd;
    const int mi = mi_of(tid < 256 ? m0 : m0 + 191), n = n0 + (tid & 255);
    f[tid] = gld(gate + mi * 6144 + n) * gscale;
    f[512 + tid] = ng ? gld(ng + n) * (1.f + gld(nsc + mi * 6144 + n)) : 0.f;
  }
  template <int MT> DI void operator()(f32x16 (&acc)[2][MT], int nb, int mb, int lane, unsigned char* wlds, const unsigned char* side, int n0, int m0) const {
    const int r = lane & 31, h = lane >> 5, cc = lane & 15, rq = lane >> 4;
    const int mi0 = mi_of(m0);
#pragma unroll
    for (int mt = 0; mt < MT; ++mt) {
#pragma unroll
      for (int nt = 0; nt < 2; ++nt)
#pragma unroll
        for (int g = 0; g < 4; ++g)
          *(f32x4*)(wlds + r * 272 + (nt * 32 + 8 * g + 4 * h) * 4) = make_f32x4(acc[nt][mt][4 * g], acc[nt][mt][4 * g + 1], acc[nt][mt][4 * g + 2], acc[nt][mt][4 * g + 3]);
#pragma unroll
      for (int i = 0; i < 8; ++i) {
        const int row = rq + 4 * i;
        const int m = mb + mt * 32 + row, n = nb + cc * 4;
        const float* sf = (const float*)side + (mi_of(m) != mi0 ? 256 : 0) + (n - n0);
        const f32x4 a = *(const f32x4*)(wlds + row * 272 + cc * 16);
        f32x4 yo = gld((const f32x4*)(y + (size_t)m * 1024 + n));
        const f32x4 gt = *(const f32x4*)sf;
        yo.x += gt.x * a.x; yo.y += gt.y * a.y; yo.z += gt.z * a.z; yo.w += gt.w * a.w;
        *(GAS f32x4*)(y + (size_t)m * 1024 + n) = yo;
        if (ng) {
          const f32x4 gg = *(const f32x4*)(sf + 512);
          store_bf4(abuf + (size_t)m * 1024 + n, yo.x * gg.x, yo.y * gg.y, yo.z * gg.z, yo.w * gg.w);
          float ss = yo.x * yo.x + yo.y * yo.y + yo.z * yo.z + yo.w * yo.w;
          ss += __shfl_xor(ss, 1, 64); ss += __shfl_xor(ss, 2, 64); ss += __shfl_xor(ss, 4, 64); ss += __shfl_xor(ss, 8, 64);
          if (cc == 0) gst(ssq_out + (size_t)(nb >> 6) * T + m, ss);
        }
      }
    }
  }
};

struct EpiMlp1 {
  const float* ssq; const float* shw; bf16_t* act;
  DI void side(int n0, int m0, int tid, unsigned char* sd) const {
    float* f = (float*)sd;
    if (tid < 256) f[tid] = rstd_parts<16>(ssq, m0 + tid, 1.f / 1024.f);
    else f[tid] = gld(shw + mi_of(m0) * 4096 + n0 + (tid - 256));
  }
  template <int NT, int MT> DI void operator()(f32x16 (&acc)[NT][MT], int nb, int mb, int lane, unsigned char* wlds, const unsigned char* side, int n0, int m0) const {
    const int r = lane & 31, h = lane >> 5;
    constexpr int RS = NT * 64 + 16;
    constexpr int CPR = NT * 4;
#pragma unroll
    for (int mt = 0; mt < MT; ++mt) {
      const float* sf = (const float*)side;
      const float rs = sf[mb - m0 + mt * 32 + r];
#pragma unroll
      for (int nt = 0; nt < NT; ++nt)
#pragma unroll
        for (int g = 0; g < 4; ++g) {
          const int nl = nt * 32 + 8 * g + 4 * h;
          const f32x4 s4 = *(const f32x4*)(sf + 256 + (nb - n0) + nl);
          float v0 = fmaxf(rs * acc[nt][mt][4 * g] + s4.x, 0.f), v1 = fmaxf(rs * acc[nt][mt][4 * g + 1] + s4.y, 0.f);
          float v2 = fmaxf(rs * acc[nt][mt][4 * g + 2] + s4.z, 0.f), v3 = fmaxf(rs * acc[nt][mt][4 * g + 3] + s4.w, 0.f);
          u32x2 u; u.x = pack2(v0 * v0, v1 * v1); u.y = pack2(v2 * v2, v3 * v3);
          *(u32x2*)(wlds + r * RS + nl * 2) = u;
        }
#pragma unroll
      for (int i = 0; i < 32 * CPR / 64; ++i) {
        const int c = lane + 64 * i, row = c / CPR, cc = c % CPR;
        const u32x4 v = *(const u32x4*)(wlds + row * RS + cc * 16);
        *(GAS u32x4*)(act + (size_t)(mb + mt * 32 + row) * 4096 + nb + cc * 8) = v;
      }
    }
  }
};

struct EpiOddIn {
  const float* ssq; const float* shw; bf16_t* ubuf; bf16_t* qlat; bf16_t* kvlat; float* kpebuf; float* ssqq; float* ssqkv; float* out_ckv; float* out_kpe; int li;
  DI void side(int n0, int m0, int tid, unsigned char* sd) const {
    float* f = (float*)sd;
    if (tid < 256) f[tid] = rstd_parts<16>(ssq, m0 + tid, 1.f / 1024.f);
    else f[tid] = gld(shw + mi_of(m0) * 3072 + n0 + (tid - 256));
  }
  template <int MT> DI void operator()(f32x16 (&acc)[4][MT], int nb, int mb, int lane, unsigned char* wlds, const unsigned char* side, int n0, int m0) const {
    const int r = lane & 31, h = lane >> 5;
#pragma unroll
    for (int mt = 0; mt < MT; ++mt) {
      __builtin_amdgcn_sched_barrier(0);
      const int m = mb + mt * 32 + r;
      const float* sf = (const float*)side;
      const float rs = sf[m - m0];
      const float* sw = sf + 256 + (nb - n0);
      float ss = 0.f;
#pragma unroll
      for (int nt = 0; nt < 4; ++nt)
#pragma unroll
        for (int g = 0; g < 4; ++g) {
          const f32x4 s4 = *(const f32x4*)(sw + nt * 32 + 8 * g + 4 * h);
          acc[nt][mt][4 * g + 0] = rs * acc[nt][mt][4 * g + 0] + s4.x;
          acc[nt][mt][4 * g + 1] = rs * acc[nt][mt][4 * g + 1] + s4.y;
          acc[nt][mt][4 * g + 2] = rs * acc[nt][mt][4 * g + 2] + s4.z;
          acc[nt][mt][4 * g + 3] = rs * acc[nt][mt][4 * g + 3] + s4.w;
#pragma unroll
          for (int j = 0; j < 4; ++j) ss += acc[nt][mt][4 * g + j] * acc[nt][mt][4 * g + j];
        }
      ss += xor32(ss);
      const size_t prow = (size_t)(((m >> 8) * 2 + li) * 256 + (m & 255));
      if (nb < 512) {
#pragma unroll
        for (int nt = 0; nt < 4; ++nt)
#pragma unroll
          for (int g = 0; g < 4; ++g)
            store_bf4(ubuf + (size_t)m * 512 + nb + nt * 32 + 8 * g + 4 * h, acc[nt][mt][4 * g], acc[nt][mt][4 * g + 1], acc[nt][mt][4 * g + 2], acc[nt][mt][4 * g + 3]);
      } else if (nb < 896) {
#pragma unroll
        for (int nt = 0; nt < 4; ++nt)
#pragma unroll
          for (int g = 0; g < 4; ++g)
            store_bf4(qlat + (size_t)m * 384 + (nb - 512) + nt * 32 + 8 * g + 4 * h, acc[nt][mt][4 * g], acc[nt][mt][4 * g + 1], acc[nt][mt][4 * g + 2], acc[nt][mt][4 * g + 3]);
        if (h == 0) gst(ssqq + (size_t)((nb - 512) >> 7) * T + m, ss);
      } else if (nb < 1152) {
#pragma unroll
        for (int nt = 0; nt < 4; ++nt)
#pragma unroll
          for (int g = 0; g < 4; ++g) {
            const int c = (nb - 896) + nt * 32 + 8 * g + 4 * h;
            store_bf4(kvlat + (size_t)m * 256 + c, acc[nt][mt][4 * g], acc[nt][mt][4 * g + 1], acc[nt][mt][4 * g + 2], acc[nt][mt][4 * g + 3]);
            if (m < TP) *(GAS f32x4*)(out_ckv + (size_t)m * 256 + c) = make_f32x4(acc[nt][mt][4 * g], acc[nt][mt][4 * g + 1], acc[nt][mt][4 * g + 2], acc[nt][mt][4 * g + 3]);
          }
        if (h == 0) gst(ssqkv + (size_t)((nb - 896) >> 7) * T + m, ss);
      } else {
#pragma unroll
        for (int g = 0; g < 4; ++g) {
          const int c = 8 * g + 4 * h;
          const f32x4 v = make_f32x4(acc[0][mt][4 * g], acc[0][mt][4 * g + 1], acc[0][mt][4 * g + 2], acc[0][mt][4 * g + 3]);
          *(GAS f32x4*)(kpebuf + (size_t)m * 32 + c) = v;
          if (m < TP) *(GAS f32x4*)(out_kpe + prow * 32 + c) = v;
        }
      }
    }
  }
};

DI void rope_cs(int j8, float posv, float& c, float& s) {
  const float inv = __builtin_amdgcn_exp2f(-1.6609640474436813f * (float)j8);
  const float ang = posv * inv;
  c = __cosf(ang); s = __sinf(ang);
}

struct EpiQUp {
  DI void side(int, int, int, unsigned char*) const {}
  const float* ssqq; const float* gq; bf16_t* qmla;
  template <int MT> DI void operator()(f32x16 (&acc)[4][MT], int nb, int mb, int lane, unsigned char* wlds, const unsigned char* side, int n0, int m0) const {
   const int r = lane & 31, h = lane >> 5, hd = nb >> 7;
#pragma unroll
   for (int mt = 0; mt < MT; ++mt) {
    __builtin_amdgcn_sched_barrier(0);
    const int m = mb + mt * 32 + r;
    const float rq = rstd_parts<3>(ssqq, m, 1.f / 384.f);
    float ss = 0.f;
#pragma unroll
    for (int nt = 0; nt < 3; ++nt)
#pragma unroll
      for (int i = 0; i < 16; ++i) { acc[nt][mt][i] *= rq; ss += acc[nt][mt][i] * acc[nt][mt][i]; }
    ss += xor32(ss);
    const float rn = rsqrtf(ss * (1.f / 96.f) + EPS);
#pragma unroll
    for (int nt = 0; nt < 3; ++nt)
#pragma unroll
      for (int g = 0; g < 4; ++g) {
        const f32x4 g4 = gld((const f32x4*)(gq + nt * 32 + 8 * g + 4 * h));
        acc[nt][mt][4 * g] *= rn * g4.x; acc[nt][mt][4 * g + 1] *= rn * g4.y; acc[nt][mt][4 * g + 2] *= rn * g4.z; acc[nt][mt][4 * g + 3] *= rn * g4.w;
      }
    if (m >= TP) {
      const int pos = (m - TP) & 1023;
      const float prow = (float)(pos >> 6), pcol = (float)(pos & 63);
#pragma unroll
      for (int g = 0; g < 2; ++g)
#pragma unroll
        for (int j = 0; j < 4; ++j) {
          float c, s; rope_cs(4 * h + j, g == 0 ? prow : pcol, c, s);
          const float x1 = acc[2][mt][4 * g + j], x2 = acc[2][mt][8 + 4 * g + j];
          acc[2][mt][4 * g + j] = x1 * c - x2 * s;
          acc[2][mt][8 + 4 * g + j] = x2 * c + x1 * s;
        }
    }
#pragma unroll
    for (int nt = 0; nt < 3; ++nt)
#pragma unroll
      for (int g = 0; g < 4; ++g)
        store_bf4(qmla + (size_t)m * 768 + hd * 96 + nt * 32 + 8 * g + 4 * h, acc[nt][mt][4 * g], acc[nt][mt][4 * g + 1], acc[nt][mt][4 * g + 2], acc[nt][mt][4 * g + 3]);
   }
  }
};

struct EpiKvUp {
  DI void side(int, int, int, unsigned char*) const {}
  const float* ssqkv; const float* gk; const float* kpebuf; const float* cache_kpe; bf16_t* kpm; bf16_t* ksm; bf16_t* vtpm; bf16_t* vtsm; int li; int cache;
  template <int MT> DI void operator()(f32x16 (&acc)[4][MT], int nb, int mb, int lane, unsigned char* wlds, const unsigned char* side, int n0, int m0) const {
   const int r = lane & 31, h = lane >> 5, hd = nb >> 7;
#pragma unroll
   for (int mt = 0; mt < MT; ++mt) {
    __builtin_amdgcn_sched_barrier(0);
    const int m = mb + mt * 32 + r;
    float rs = 1.f;
    const float* kp;
    bf16_t* kdst; bf16_t* vdst; int vst; bool rope = false; int pos = 0;
    if (cache) {
      const int b = m >> 8, p = m & 255;
      kp = cache_kpe + ((size_t)((b * 2 + li) * 256 + p)) * 32;
      kdst = ksm + ((size_t)(b * 8 + hd) * 1280 + p) * 96;
      vdst = vtsm + ((size_t)(b * 8 + hd) * 64) * 1280 + p; vst = 1280;
    } else {
      rs = rstd_parts<2>(ssqkv, m, 1.f / 256.f);
      kp = kpebuf + (size_t)m * 32;
      if (m < TP) {
        const int b = m >> 8, p = m & 255;
        kdst = kpm + ((size_t)(b * 8 + hd) * 256 + p) * 96;
        vdst = vtpm + ((size_t)(b * 8 + hd) * 64) * 256 + p; vst = 256;
      } else {
        const int s = m - TP, b = s >> 10; pos = s & 1023; rope = true;
        kdst = ksm + ((size_t)(b * 8 + hd) * 1280 + 256 + pos) * 96;
        vdst = vtsm + ((size_t)(b * 8 + hd) * 64) * 1280 + 256 + pos; vst = 1280;
      }
    }
    float ss = 0.f;
#pragma unroll
    for (int nt = 0; nt < 4; ++nt)
#pragma unroll
      for (int i = 0; i < 16; ++i) { acc[nt][mt][i] *= rs; if (nt < 2) ss += acc[nt][mt][i] * acc[nt][mt][i]; }
    ss += xor32(ss);
    const f32x4 a0 = gld((const f32x4*)(kp + 8 * h)), a1 = gld((const f32x4*)(kp + 8 * h + 4));
    const f32x4 b0 = gld((const f32x4*)(kp + 16 + 8 * h)), b1 = gld((const f32x4*)(kp + 16 + 8 * h + 4));
    float x1[8] = {a0.x, a0.y, a0.z, a0.w, a1.x, a1.y, a1.z, a1.w};
    float x2[8] = {b0.x, b0.y, b0.z, b0.w, b1.x, b1.y, b1.z, b1.w};
    float sp = 0.f;
#pragma unroll
    for (int j = 0; j < 8; ++j) sp += x1[j] * x1[j] + x2[j] * x2[j];
    sp += xor32(sp);
    const float rn = rsqrtf((ss + sp) * (1.f / 96.f) + EPS);
#pragma unroll
    for (int nt = 0; nt < 2; ++nt)
#pragma unroll
      for (int g = 0; g < 4; ++g) {
        const int d = nt * 32 + 8 * g + 4 * h;
        const f32x4 g4 = gld((const f32x4*)(gk + d));
        store_bf4(kdst + d, acc[nt][mt][4 * g] * rn * g4.x, acc[nt][mt][4 * g + 1] * rn * g4.y, acc[nt][mt][4 * g + 2] * rn * g4.z, acc[nt][mt][4 * g + 3] * rn * g4.w);
      }
    const float prow = (float)(pos >> 6), pcol = (float)(pos & 63);
#pragma unroll
    for (int j = 0; j < 8; ++j) {
      const int jj = 8 * h + j;
      float a = x1[j] * rn * gk[64 + jj], b = x2[j] * rn * gk[80 + jj];
      if (rope) {
        float c, s; rope_cs(j, h == 0 ? prow : pcol, c, s);
        const float na = a * c - b * s, nb2 = b * c + a * s;
        a = na; b = nb2;
      }
      x1[j] = a; x2[j] = b;
    }
    { u32x4 u; u.x = pack2(x1[0], x1[1]); u.y = pack2(x1[2], x1[3]); u.z = pack2(x1[4], x1[5]); u.w = pack2(x1[6], x1[7]); *(GAS u32x4*)(kdst + 64 + 8 * h) = u; }
    { u32x4 u; u.x = pack2(x2[0], x2[1]); u.y = pack2(x2[2], x2[3]); u.z = pack2(x2[4], x2[5]); u.w = pack2(x2[6], x2[7]); *(GAS u32x4*)(kdst + 80 + 8 * h) = u; }
#pragma unroll
    for (int nt = 2; nt < 4; ++nt)
#pragma unroll
      for (int i = 0; i < 16; ++i) {
        const int d = (nt - 2) * 32 + CROW(i, h);
        gst(vdst + (size_t)d * vst, f2bf(acc[nt][mt][i]));
      }
   }
  }
};

struct EpiPool {
  DI void side(int, int, int, unsigned char*) const {}
  const float* scale; bf16_t* cat;
  template <int NT, int MT> DI void operator()(f32x16 (&acc)[NT][MT], int nb, int mb, int lane, unsigned char* wlds, const unsigned char* side, int n0, int m0) const {
    const int r = lane & 31, h = lane >> 5;
#pragma unroll
    for (int mt = 0; mt < MT; ++mt) {
      const int m = mb + mt * 32 + r;
#pragma unroll
      for (int nt = 0; nt < NT; ++nt)
#pragma unroll
        for (int g = 0; g < 4; ++g) {
          const int n = nb + nt * 32 + 8 * g + 4 * h;
          const f32x4 s4 = gld((const f32x4*)(scale + n));
          store_bf4(cat + (size_t)m * 1024 + n, acc[nt][mt][4 * g] * s4.x, acc[nt][mt][4 * g + 1] * s4.y, acc[nt][mt][4 * g + 2] * s4.z, acc[nt][mt][4 * g + 3] * s4.w);
        }
    }
  }
};

template <int DQK>
DI void attn_task(const bf16_t* __restrict__ Q, int qs,
                  const bf16_t* __restrict__ K0, int ks0, const bf16_t* __restrict__ V0, int vs0, int nt0,
                  const bf16_t* __restrict__ K1, int ks1, const bf16_t* __restrict__ V1, int vs1, int nt1,
                  bool na, int qrow0, int krow0, const float* __restrict__ rpb_h,
                  bf16_t* __restrict__ O, int os, float scale, unsigned char* smem) {
  constexpr int KSTR = (DQK + 8) * 2;
  constexpr int CH = DQK / 8;
  constexpr int NKC = (CH * 64 + 511) / 512;
  constexpr int KSTAGE = 64 * 208, VSTAGE = 64 * 144;
  constexpr float LOG2E = 1.4426950408889634f;
  const int tid = otid(), lane = tid & 63, w = tid >> 6, r = lane & 31, h = lane >> 5;
  float* srpb = (float*)(smem + 2 * KSTAGE + 2 * VSTAGE);
  const int NTT = nt0 + nt1;

  __syncthreads();
  if (na) for (int i = tid; i < 465; i += 512) srpb[i] = rpb_h[i] * LOG2E;

  bf16x8 qf[DQK / 16];
  {
    const bf16_t* qp = Q + (size_t)(32 * w + r) * qs + 8 * h;
#pragma unroll
    for (int ks = 0; ks < DQK / 16; ++ks) qf[ks] = gld((const bf16x8*)(qp + ks * 16));
  }
  u32x4 rk[NKC], rv;
  const int vrow = tid >> 3, vkc = tid & 7;
  auto gload = [&](int j) {
    const bf16_t* kp; const bf16_t* vp; int kst, vst;
    if (j < nt0) { kp = K0 + (size_t)j * 64 * ks0; kst = ks0; vp = V0 + j * 64; vst = vs0; }
    else { kp = K1 + (size_t)(j - nt0) * 64 * ks1; kst = ks1; vp = V1 + (j - nt0) * 64; vst = vs1; }
#pragma unroll
    for (int i = 0; i < NKC; ++i) { const int c = tid + 512 * i; if (c < CH * 64) rk[i] = gld((const u32x4*)(kp + (size_t)(c / CH) * kst + (c % CH) * 8)); }
    rv = gld((const u32x4*)(vp + (size_t)vrow * vst + vkc * 8));
  };
  gload(0);

  f32x16 ot[2];
#pragma unroll
  for (int t = 0; t < 2; ++t)
#pragma unroll
    for (int i = 0; i < 16; ++i) ot[t][i] = 0.f;
  float m_run = -3.0e38f, l_run = 0.f;
  const float sc2 = scale * LOG2E;
  const int qrow = qrow0 + (w >> 1), qcol = 32 * (w & 1) + r;
  const int rsw = min(max(qrow - 4, 0), 8);
  const int csq = min(max(qcol - 8, 0), 48);

  for (int j = 0; j < NTT; ++j) {
    unsigned char* sK = smem + (j & 1) * KSTAGE;
    unsigned char* sV = smem + 2 * KSTAGE + (j & 1) * VSTAGE;
#pragma unroll
    for (int i = 0; i < NKC; ++i) { const int c = tid + 512 * i; if (c < CH * 64) *(u32x4*)(sK + (c / CH) * KSTR + (c % CH) * 16) = rk[i]; }
    *(u32x4*)(sV + vrow * 144 + vkc * 16) = rv;
    __syncthreads();
    if (j + 1 < NTT) gload(j + 1);
    __builtin_amdgcn_sched_barrier(0);
    const bool local = na && j < nt0;
    const int keyrow = krow0 + j;
    if (local && (keyrow < rsw || keyrow >= rsw + 8)) continue;
    f32x16 st[2];
#pragma unroll
    for (int t = 0; t < 2; ++t)
#pragma unroll
      for (int i = 0; i < 16; ++i) st[t][i] = 0.f;
    {
      bf16x8 kf[DQK / 16][2];
#pragma unroll
      for (int ks = 0; ks < DQK / 16; ++ks)
#pragma unroll
        for (int t = 0; t < 2; ++t) kf[ks][t] = *(const bf16x8*)(sK + (t * 32 + r) * KSTR + ks * 32 + h * 16);
      __builtin_amdgcn_sched_barrier(0);
#pragma unroll
      for (int ks = 0; ks < DQK / 16; ++ks)
#pragma unroll
        for (int t = 0; t < 2; ++t) st[t] = MFMA(kf[ks][t], qf[ks], st[t]);
    }
    bf16x8 vfr[4][2];
#pragma unroll
    for (int s2 = 0; s2 < 4; ++s2)
#pragma unroll
      for (int dv = 0; dv < 2; ++dv) {
        const unsigned char* vb = sV + (dv * 32 + r) * 144 + (16 * s2 + 4 * h) * 2;
        const u32x2 v0 = *(const u32x2*)(vb), v1 = *(const u32x2*)(vb + 16);
        const u32x4 vu = {v0.x, v0.y, v1.x, v1.y};
        vfr[s2][dv] = __builtin_bit_cast(bf16x8, vu);
      }
    __builtin_amdgcn_sched_barrier(0);
    float mx = -3.0e38f;
    if (local) {
      const int dr = keyrow - qrow + 7;
#pragma unroll
      for (int t = 0; t < 2; ++t)
#pragma unroll
        for (int i = 0; i < 16; ++i) {
          const int kc = t * 32 + CROW(i, h);
          const bool valid = (kc >= csq) && (kc < csq + 16);
          const int dc = min(max(kc - qcol + 15, 0), 30);
          const float bias = srpb[dr * 31 + dc];
          const float s = valid ? __builtin_fmaf(st[t][i], sc2, bias) : -1.0e30f;
          st[t][i] = s; mx = fmaxf(mx, s);
        }
    } else {
#pragma unroll
      for (int t = 0; t < 2; ++t)
#pragma unroll
        for (int i = 0; i < 16; ++i) mx = fmaxf(mx, st[t][i]);
      mx *= sc2;
    }
    mx = fmaxf(mx, xor32(mx));
    const float m_new = fmaxf(m_run, mx);
    if (__builtin_amdgcn_ballot_w64(m_new > m_run) != 0ull) {
      const float alpha = __builtin_amdgcn_exp2f(m_run - m_new);
      l_run *= alpha;
#pragma unroll
      for (int t = 0; t < 2; ++t)
#pragma unroll
        for (int i = 0; i < 16; ++i) ot[t][i] *= alpha;
    }
    m_run = m_new;
    if (local) {
#pragma unroll
      for (int t = 0; t < 2; ++t)
#pragma unroll
        for (int i = 0; i < 16; ++i) { const float p = __builtin_amdgcn_exp2f(st[t][i] - m_new); st[t][i] = p; l_run += p; }
    } else {
#pragma unroll
      for (int t = 0; t < 2; ++t)
#pragma unroll
        for (int i = 0; i < 16; ++i) { const float p = __builtin_amdgcn_exp2f(__builtin_fmaf(st[t][i], sc2, -m_new)); st[t][i] = p; l_run += p; }
    }
#pragma unroll
    for (int s2 = 0; s2 < 4; ++s2) {
      const int t = s2 >> 1, o = (s2 & 1) * 8;
      const u32x4 pu = {pack2(st[t][o + 0], st[t][o + 1]), pack2(st[t][o + 2], st[t][o + 3]), pack2(st[t][o + 4], st[t][o + 5]), pack2(st[t][o + 6], st[t][o + 7])};
      const bf16x8 pfv = __builtin_bit_cast(bf16x8, pu);
#pragma unroll
      for (int dv = 0; dv < 2; ++dv) ot[dv] = MFMA(vfr[s2][dv], pfv, ot[dv]);
    }
  }
  const float lt = l_run + xor32(l_run);
  const float inv = 1.f / lt;
  bf16_t* op = O + (size_t)(32 * w + r) * os;
#pragma unroll
  for (int dv = 0; dv < 2; ++dv)
#pragma unroll
    for (int g = 0; g < 4; ++g)
      store_bf4(op + dv * 32 + 8 * g + 4 * h, ot[dv][4 * g] * inv, ot[dv][4 * g + 1] * inv, ot[dv][4 * g + 2] * inv, ot[dv][4 * g + 3] * inv);
}

DI void job_mods(const Params& p, int j, unsigned char* smem) {
  const int tid = otid(), lane = tid & 63, w = tid >> 6, kq = lane >> 4, c4 = lane & 15;
  const int l = j / 96, n0 = (j % 96) * 64;
  float* s = (float*)smem;
  __syncthreads();
  for (int idx = tid; idx < 9 * 1024; idx += 512) {
    const int mi = idx >> 10, k = idx & 1023;
    const float x = mi == 0 ? p.in[7][k] : p.in[6][(mi - 1) * 1024 + k];
    s[idx] = x / (1.f + expf(-x));
  }
  __syncthreads();
  const float* Wp = p.in[8] + ((size_t)l * 1024 + w * 128 + kq) * 6144 + n0 + 4 * c4;
  float acc[9][4];
#pragma unroll
  for (int mi = 0; mi < 9; ++mi)
#pragma unroll
    for (int q = 0; q < 4; ++q) acc[mi][q] = 0.f;
#pragma unroll 8
  for (int i = 0; i < 32; ++i) {
    const f32x4 wv = gld((const f32x4*)(Wp + (size_t)(4 * i) * 6144));
    const int k = w * 128 + 4 * i + kq;
#pragma unroll
    for (int mi = 0; mi < 9; ++mi) {
      const float sv = s[mi * 1024 + k];
      acc[mi][0] += sv * wv.x; acc[mi][1] += sv * wv.y; acc[mi][2] += sv * wv.z; acc[mi][3] += sv * wv.w;
    }
  }
#pragma unroll
  for (int mi = 0; mi < 9; ++mi)
#pragma unroll
    for (int q = 0; q < 4; ++q) { float v = acc[mi][q]; v += __shfl_xor(v, 16, 64); v += __shfl_xor(v, 32, 64); acc[mi][q] = v; }
  __syncthreads();
  float* red = (float*)smem;
  if (kq == 0) {
#pragma unroll
    for (int mi = 0; mi < 9; ++mi)
#pragma unroll
      for (int q = 0; q < 4; ++q) red[(w * 9 + mi) * 64 + 4 * c4 + q] = acc[mi][q];
  }
  __syncthreads();
  float* mod = (float*)(p.ws + OFF_MOD);
  for (int idx = tid; idx < 9 * 64; idx += 512) {
    const int mi = idx >> 6, ln = idx & 63;
    float v = 0.f;
#pragma unroll
    for (int q = 0; q < 8; ++q) v += red[(q * 9 + mi) * 64 + ln];
    mod[(size_t)(l * 9 + mi) * 6144 + n0 + ln] = v + p.in[9][l * 6144 + n0 + ln];
  }
}

DI void job_wconv(const Params& p, int t) {
  int mi = 0;
#pragma unroll 1
  for (int i = 1; i < NMATS; ++i) if (t >= p.mats[i].tile0) mi = i;
  const MatDesc md = p.mats[mi];
  const int lt = t - md.tile0;
  const int ktiles = md.K >> 7;
  const int k0 = (lt % ktiles) * 128 + (otid() >> 6) * 16, n = (lt / ktiles) * 64 + (otid() & 63);
  const float* sp; bool ok; size_t rs;
  if (md.blockdiag == 1) { ok = (k0 >> 7) == (n >> 7); sp = md.src + (size_t)(k0 >> 7) * 16384 + (size_t)(k0 & 127) * 128 + (n & 127); rs = 128; }
  else if (md.headpad) { const int hd = n >> 7, d = n & 127; ok = d < 96; sp = md.src + (size_t)k0 * md.N + hd * 96 + d; rs = md.N; }
  else { ok = n < md.N; sp = md.src + (size_t)k0 * md.N + n; rs = md.N; }
  float v[16];
  if (md.blockdiag >= 2 && k0 < 512) {
    const int li = md.blockdiag - 2, g = k0 >> 7;
    const int krow = __builtin_amdgcn_readfirstlane(k0 & 127);
    const float* pw = p.in[21] + ((size_t)(li * 4 + g) * 128 + krow) * 128;
    const float* scp = p.in[22] + li * 512 + g * 128;
    const float* wo = md.src + (size_t)(g * 128) * md.N + n;
#pragma unroll
    for (int q = 0; q < 16; ++q) v[q] = 0.f;
#pragma unroll 8
    for (int d = 0; d < 128; ++d) {
      const float x = scp[d] * wo[(size_t)d * md.N];
#pragma unroll
      for (int q = 0; q < 16; ++q) v[q] += pw[q * 128 + d] * x;
    }
  } else {
#pragma unroll
  for (int q = 0; q < 16; ++q) v[q] = ok ? sp[(size_t)q * rs] : 0.f;
  }
  if (md.rscale) {
#pragma unroll
    for (int q = 0; q < 16; ++q) v[q] *= md.rscale[k0 + q];
  }
  bf16_t* dst = (bf16_t*)(p.ws + md.dst) + (size_t)n * md.K + k0;
  u32x4 u0 = {pack2(v[0], v[1]), pack2(v[2], v[3]), pack2(v[4], v[5]), pack2(v[6], v[7])};
  u32x4 u1 = {pack2(v[8], v[9]), pack2(v[10], v[11]), pack2(v[12], v[13]), pack2(v[14], v[15])};
  *(GAS u32x4*)dst = u0;
  *(GAS u32x4*)(dst + 8) = u1;
}

DI void job_cache(const Params& p, int j) {
  const int tid = otid();
  if (j < 512) {
    const int item = j * 512 + tid;
    const int e = item * 8;
    const int c = e & 511, pos = (e >> 9) & 255, i = (e >> 17) & 1, b = e >> 18;
    const f32x4 a = gld((const f32x4*)(p.in[2] + e)), bq = gld((const f32x4*)(p.in[2] + e + 4));
    u32x4 u; u.x = pack2(a.x, a.y); u.y = pack2(a.z, a.w); u.z = pack2(bq.x, bq.y); u.w = pack2(bq.z, bq.w);
    *(GAS u32x4*)((bf16_t*)(p.ws + OFF_CNK) + ((size_t)(i * 2048 + b * 256 + pos)) * 512 + c) = u;
  } else if (j < 1024) {
    const int item = (j - 512) * 512 + tid;
    const int hd = item & 511, pos8 = (item >> 9) & 31, i = (item >> 14) & 1, b = item >> 15;
    const float* src = p.in[3] + ((size_t)((b * 2 + i) * 256 + pos8 * 8)) * 512 + hd;
    float v[8];
#pragma unroll
    for (int q = 0; q < 8; ++q) v[q] = src[(size_t)q * 512];
    u32x4 u; u.x = pack2(v[0], v[1]); u.y = pack2(v[2], v[3]); u.z = pack2(v[4], v[5]); u.w = pack2(v[6], v[7]);
    *(GAS u32x4*)((bf16_t*)(p.ws + OFF_CNVT) + ((size_t)((i * 8 + b) * 512 + hd)) * 256 + pos8 * 8) = u;
  } else {
    const int item = (j - 1024) * 512 + tid;
    const int e = item * 8;
    const int c = e & 255, pos = (e >> 8) & 255, i = (e >> 16) & 1, b = e >> 17;
    const f32x4 a = gld((const f32x4*)(p.in[4] + e)), bq = gld((const f32x4*)(p.in[4] + e + 4));
    u32x4 u; u.x = pack2(a.x, a.y); u.y = pack2(a.z, a.w); u.z = pack2(bq.x, bq.y); u.w = pack2(bq.z, bq.w);
    *(GAS u32x4*)((bf16_t*)(p.ws + OFF_CCKV) + ((size_t)(i * 2048 + b * 256 + pos)) * 256 + c) = u;
  }
}

DI void job_shw(const Params& p, int j, unsigned char* smem) {
  int l = 0, jj = j;
  if (jj >= 112) { jj -= 112; l = 1; if (jj >= 84) { jj -= 84; l = 2; if (jj >= 112) { jj -= 112; l = 3; } } }
  const int n1 = (l & 1) ? 20 : 48;
  const int which = jj >= n1;
  const int n0 = (which ? jj - n1 : jj) * 64;
  const bf16_t* Wt = which ? (const bf16_t*)(p.ws + OFF_W1T) + (size_t)l * 4096 * 1024
                           : ((l & 1) ? (const bf16_t*)(p.ws + OFF_OWIN) + (size_t)(l >> 1) * 1280 * 1024
                                      : (const bf16_t*)(p.ws + OFF_EWIN) + (size_t)(l >> 1) * 3072 * 1024);
  float* dst = which ? (float*)(p.ws + OFF_SHW2) + (size_t)l * 9 * 4096 : (float*)(p.ws + OFF_SHW1) + (size_t)l * 9 * 3072;
  const int ns = which ? 4096 : 3072;
  const float* mod = (const float*)(p.ws + OFF_MOD) + (size_t)l * 9 * 6144 + (which ? 3072 : 0);
  const int tid = otid(), lane = tid & 63, w = tid >> 6;
  float* s = (float*)smem;
  __syncthreads();
  for (int idx = tid; idx < 9 * 1024; idx += 512) s[idx] = mod[(idx >> 10) * 6144 + (idx & 1023)];
  __syncthreads();
  const bf16_t* wr = Wt + (size_t)(n0 + lane) * 1024 + w * 128;
  float acc[9];
#pragma unroll
  for (int mi = 0; mi < 9; ++mi) acc[mi] = 0.f;
#pragma unroll 2
  for (int c = 0; c < 16; ++c) {
    const u32x4 u = gld((const u32x4*)(wr + c * 8));
    const float wv[8] = {bflo(u.x), bfhi(u.x), bflo(u.y), bfhi(u.y), bflo(u.z), bfhi(u.z), bflo(u.w), bfhi(u.w)};
#pragma unroll
    for (int q = 0; q < 8; ++q)
#pragma unroll
      for (int mi = 0; mi < 9; ++mi) acc[mi] += s[mi * 1024 + w * 128 + c * 8 + q] * wv[q];
  }
  __syncthreads();
  float* red = (float*)smem;
#pragma unroll
  for (int mi = 0; mi < 9; ++mi) red[(w * 9 + mi) * 64 + lane] = acc[mi];
  __syncthreads();
  for (int idx = tid; idx < 9 * 64; idx += 512) {
    const int mi = idx >> 6, ln = idx & 63;
    float v = 0.f;
#pragma unroll
    for (int q = 0; q < 8; ++q) v += red[(q * 9 + mi) * 64 + ln];
    dst[(size_t)mi * ns + n0 + ln] = v;
  }
}

DI void job_xpass(const Params& p, int j) {
  const int tid = otid(), lane = tid & 63, w = tid >> 6;
  const int m = j * 8 + w, mi = mi_of(m);
  const float* x = m < TP ? p.in[0] + (size_t)m * 1024 : p.in[1] + (size_t)(m - TP) * 1024;
  const float* g1 = p.in[10];
  const float* sc = (const float*)(p.ws + OFF_MOD) + (size_t)mi * 6144 + 1024;
  float* y = p.out + OUT_Y + (size_t)m * 1024;
  bf16_t* ab = (bf16_t*)(p.ws + OFF_ABUF) + (size_t)m * 1024;
  float ss = 0.f;
#pragma unroll
  for (int i = 0; i < 4; ++i) {
    const int k = lane * 4 + 256 * i;
    const f32x4 v = gld((const f32x4*)(x + k));
    const f32x4 g = gld((const f32x4*)(g1 + k));
    const f32x4 s4 = gld((const f32x4*)(sc + k));
    ss += v.x * v.x + v.y * v.y + v.z * v.z + v.w * v.w;
    *(GAS f32x4*)(y + k) = v;
    store_bf4(ab + k, v.x * g.x * (1.f + s4.x), v.y * g.y * (1.f + s4.y), v.z * g.z * (1.f + s4.z), v.w * g.w * (1.f + s4.w));
  }
#pragma unroll
  for (int o = 32; o >= 1; o >>= 1) ss += __shfl_xor(ss, o, 64);
  float* ssq = (float*)(p.ws + OFF_SSQ1);
  if (lane < 16) ssq[(size_t)lane * T + m] = lane == 0 ? ss : 0.f;
}

DI void job_conv(const Params& p, int j, int li) {
  const int item = j * 512 + otid();
  const int m = item >> 6, c = (item & 63) * 8;
  const bf16_t* bc = (const bf16_t*)(p.ws + OFF_BCONV);
  int pos, L;
  if (m < TP) { pos = m & 255; L = 256; } else { pos = (m - TP) & 1023; L = 1024; }
  const float* cw = p.in[15] + (size_t)li * 3 * 512 + c;
  float accv[8];
#pragma unroll
  for (int q = 0; q < 8; ++q) accv[q] = 0.f;
#pragma unroll
  for (int d = -1; d <= 1; ++d) {
    const int pp = pos + d;
    if (pp < 0 || pp >= L) continue;
    const u32x4 cg = gld((const u32x4*)(bc + (size_t)(m + d) * 1536 + 512 + c));
    const u32x4 xa = gld((const u32x4*)(bc + (size_t)(m + d) * 1536 + 1024 + c));
    const f32x4 w0 = gld((const f32x4*)(cw + (d + 1) * 512)), w1 = gld((const f32x4*)(cw + (d + 1) * 512 + 4));
    accv[0] += bflo(cg.x) * bflo(xa.x) * w0.x; accv[1] += bfhi(cg.x) * bfhi(xa.x) * w0.y;
    accv[2] += bflo(cg.y) * bflo(xa.y) * w0.z; accv[3] += bfhi(cg.y) * bfhi(xa.y) * w0.w;
    accv[4] += bflo(cg.z) * bflo(xa.z) * w1.x; accv[5] += bfhi(cg.z) * bfhi(xa.z) * w1.y;
    accv[6] += bflo(cg.w) * bflo(xa.w) * w1.z; accv[7] += bfhi(cg.w) * bfhi(xa.w) * w1.w;
  }
  const u32x4 bg = gld((const u32x4*)(bc + (size_t)m * 1536 + c));
  u32x4 u;
  u.x = pack2(bflo(bg.x) * accv[0], bfhi(bg.x) * accv[1]); u.y = pack2(bflo(bg.y) * accv[2], bfhi(bg.y) * accv[3]);
  u.z = pack2(bflo(bg.z) * accv[4], bfhi(bg.z) * accv[5]); u.w = pack2(bflo(bg.w) * accv[6], bfhi(bg.w) * accv[7]);
  *(GAS u32x4*)((bf16_t*)(p.ws + OFF_CAT) + (size_t)m * 1024 + c) = u;
}

DI void job_poolx(const Params& p, int j) {
  const int item = j * 512 + otid();
  const int m = item >> 6, c = (item & 63) * 8;
  const bf16_t* ub = (const bf16_t*)(p.ws + OFF_UBUF);
  int pos, L;
  if (m < TP) { pos = m & 255; L = 256; } else { pos = (m - TP) & 1023; L = 1024; }
  const int wsz = 2 << (c >> 7);
  const int lo = min(max(pos - wsz / 2, 0), L), hi = min(max(pos - wsz / 2 + wsz, 0), L);
  float s[8];
#pragma unroll
  for (int q = 0; q < 8; ++q) s[q] = 0.f;
  u32x4 uu[16];
#pragma unroll
  for (int q = 0; q < 16; ++q) {
    const u32x4 z = {0u, 0u, 0u, 0u};
    uu[q] = (lo + q < hi) ? gld((const u32x4*)(ub + (size_t)(m + lo + q - pos) * 512 + c)) : z;
  }
#pragma unroll
  for (int q = 0; q < 16; ++q) {
    const u32x4 u = uu[q];
    s[0] += bflo(u.x); s[1] += bfhi(u.x); s[2] += bflo(u.y); s[3] += bfhi(u.y); s[4] += bflo(u.z); s[5] += bfhi(u.z); s[6] += bflo(u.w); s[7] += bfhi(u.w);
  }
  const float inv = 1.f / (float)(hi - lo);
  const u32x4 u = gld((const u32x4*)(ub + (size_t)m * 512 + c));
  u32x4 o;
  o.x = pack2(s[0] * inv - bflo(u.x), s[1] * inv - bfhi(u.x)); o.y = pack2(s[2] * inv - bflo(u.y), s[3] * inv - bfhi(u.y));
  o.z = pack2(s[4] * inv - bflo(u.z), s[5] * inv - bfhi(u.z)); o.w = pack2(s[6] * inv - bflo(u.w), s[7] * inv - bfhi(u.w));
  *(GAS u32x4*)((bf16_t*)(p.ws + OFF_CAT) + (size_t)m * 1024 + c) = o;
}

DI void job_ckvstate(const Params& p, int j, int li) {
  const int item = j * 512 + otid();
  const int m = item >> 6, c = (item & 63) * 4;
  const float rs = rstd_parts<2>((const float*)(p.ws + OFF_SSQKV), m, 1.f / 256.f);
  float* o = p.out + OUT_CKV + ((size_t)(((m >> 8) * 2 + li) * 256 + (m & 255))) * 256 + c;
  const f32x4 g = gld((const f32x4*)(p.in[25] + li * 256 + c));
  f32x4 v = gld((const f32x4*)((const float*)(p.ws + OFF_KVRAW) + (size_t)m * 256 + c));
  v.x *= rs * g.x; v.y *= rs * g.y; v.z *= rs * g.z; v.w *= rs * g.w;
  *(GAS f32x4*)o = v;
}

__global__ void __launch_bounds__(NTHREADS, 2) fwd_megakernel(Params p) {
  __shared__ __attribute__((aligned(16))) unsigned char smem[SMEM_BYTES];
  __shared__ u32x4 xb_words;
  cg::grid_group grid = cg::this_grid();
  if (p.pad_ == 0x7fffffff) grid.sync();
  if (threadIdx.x == 0) { const u32x4 z = {0u, 0u, 0u, 0u}; xb_words = z; }
  __syncthreads();
  const XcdBarrier xb = xcd_barrier_post((unsigned*)(p.ws + OFF_BAR), (volatile LAS unsigned*)&xb_words);
  const int nb = gridDim.x, bid = blockIdx.x;
  unsigned char* const ws_ = p.ws;
  float* const out_ = p.out;

#ifndef SKIP_PH0
  for (int rep_ = 0; rep_ < REP_PH0; ++rep_) {
    const int n_mod = 384, n_conv = p.conv_tiles, n_cache = 1280;
    for (int j = bid; j < n_mod + n_conv + n_cache; j += nb) {
      if (j < n_mod) { for (int q_ = 0; q_ < REP_MODS; ++q_) job_mods(p, j, smem); }
      else if (j < n_mod + n_conv) { for (int q_ = 0; q_ < REP_WCONV; ++q_) job_wconv(p, j - n_mod); }
      else { for (int q_ = 0; q_ < REP_CACHE; ++q_) job_cache(p, j - n_mod - n_conv); }
    }
  }
#endif
  xcd_barrier(xb);
#ifndef SKIP_PH1
  for (int rep_ = 0; rep_ < REP_PH1; ++rep_) {
    for (int j = bid; j < 392 + 1536; j += nb) {
      if (j < 392) job_shw(p, j, smem); else job_xpass(p, j - 392);
    }
  }
#endif
  xcd_barrier(xb);

#pragma unroll 1
  for (int l = 0; l < 4; ++l) {
    const int li = l >> 1;
    if ((l & 1) == 0) {
#ifndef SKIP_E2
      for (int rep_ = 0; rep_ < REP_E2; ++rep_) {
        unsigned char* ws = uniform_ptr(ws_); float* ybuf = (float*)uniform_ptr(out_); asm volatile("" : "+s"(ws), "+s"(ybuf));
        float* mod = (float*)(ws + OFF_MOD); bf16_t* abuf = (bf16_t*)(ws + OFF_ABUF); bf16_t* cat = (bf16_t*)(ws + OFF_CAT); bf16_t* act = (bf16_t*)(ws + OFF_ACT);
        float* ssq1 = (float*)(ws + OFF_SSQ1); float* ssq2 = (float*)(ws + OFF_SSQ2); const float* modl = mod + (size_t)l * 9 * 6144;
        (void)mod; (void)abuf; (void)cat; (void)act; (void)ssq1; (void)ssq2; (void)modl; (void)ybuf;
        EpiEvenIn e;
        e.ssq = ssq1; e.shw = (const float*)(ws + OFF_SHW1) + (size_t)l * 9 * 3072; e.gq = p.in[16] + li * 64; e.gk = p.in[17] + li * 64;
        e.bconv = (bf16_t*)(ws + OFF_BCONV); e.qbuf = (bf16_t*)(ws + OFF_QBUF); e.kbuf = (bf16_t*)(ws + OFF_KBUF);
        e.vtp = (bf16_t*)(ws + OFF_VTP); e.vts = (bf16_t*)(ws + OFF_VTS); e.out_k = ybuf + OUT_NAK; e.out_v = ybuf + OUT_NAV; e.li = li;
        const bf16_t* W = (const bf16_t*)(ws + OFF_EWIN) + (size_t)li * 3072 * 1024;
        for (int t = bid; t < 64 * 12; t += nb) gemm_tile<192, 4>(abuf, 1024, W, 1024, (t % 64) * 192, (t / 64) * 256, e, smem);
      }
#endif
      xcd_barrier(xb);
#ifndef SKIP_E3
      for (int rep_ = 0; rep_ < REP_E3; ++rep_) {
        unsigned char* ws = uniform_ptr(ws_); float* ybuf = (float*)uniform_ptr(out_); asm volatile("" : "+s"(ws), "+s"(ybuf));
        float* mod = (float*)(ws + OFF_MOD); bf16_t* abuf = (bf16_t*)(ws + OFF_ABUF); bf16_t* cat = (bf16_t*)(ws + OFF_CAT); bf16_t* act = (bf16_t*)(ws + OFF_ACT);
        float* ssq1 = (float*)(ws + OFF_SSQ1); float* ssq2 = (float*)(ws + OFF_SSQ2); const float* modl = mod + (size_t)l * 9 * 6144;
        (void)mod; (void)abuf; (void)cat; (void)act; (void)ssq1; (void)ssq2; (void)modl; (void)ybuf;
        const bf16_t* qb = (const bf16_t*)(ws + OFF_QBUF); const bf16_t* kb = (const bf16_t*)(ws + OFF_KBUF);
        const bf16_t* vtp = (const bf16_t*)(ws + OFF_VTP); const bf16_t* vts = (const bf16_t*)(ws + OFF_VTS);
        const bf16_t* cnk = (const bf16_t*)(ws + OFF_CNK) + (size_t)li * 2048 * 512;
        const bf16_t* cnvt = (const bf16_t*)(ws + OFF_CNVT) + (size_t)li * 2048 * 512;
        for (int j = bid; j < 256 + 128 + 1536; j += nb) {
          if (j < 256) {
            const int rq = j & 3, hd = (j >> 2) & 7, b = j >> 5;
            const int tok0 = TP + b * 1024 + rq * 256;
            const int kr0 = min(max(4 * rq - 4, 0), 8), kr1 = min(max(4 * rq + 3 - 4, 0), 8) + 8;
            attn_task<64>(qb + (size_t)tok0 * 512 + hd * 64, 512,
                          kb + (size_t)(TP + b * 1024 + kr0 * 64) * 512 + hd * 64, 512, vts + ((size_t)(b * 8 + hd) * 64) * 1024 + kr0 * 64, 1024, kr1 - kr0,
                          cnk + (size_t)(b * 256) * 512 + hd * 64, 512, cnvt + ((size_t)(b * 8 + hd) * 64) * 256, 256, 4,
                          true, 4 * rq, kr0, p.in[18] + (size_t)(li * 8 + hd) * 465,
                          cat + (size_t)tok0 * 1024 + 512 + hd * 64, 1024, 0.125f, smem);
          } else if (j < 384) {
            const int jj = j - 256, hd = jj & 7, b = jj >> 3;
            const int tok0 = b * 256;
            attn_task<64>(qb + (size_t)tok0 * 512 + hd * 64, 512,
                          kb + (size_t)(b * 256) * 512 + hd * 64, 512, vtp + ((size_t)(b * 8 + hd) * 64) * 256, 256, 4,
                          kb, 512, vtp, 256, 0,
                          false, 0, 0, p.in[18],
                          cat + (size_t)tok0 * 1024 + 512 + hd * 64, 1024, 0.125f, smem);
          } else job_conv(p, j - 384, li);
        }
      }
#endif
      xcd_barrier(xb);
#ifndef SKIP_E4
      {
        unsigned char* ws = uniform_ptr(ws_); float* ybuf = (float*)uniform_ptr(out_); asm volatile("" : "+s"(ws), "+s"(ybuf));
        float* mod = (float*)(ws + OFF_MOD); bf16_t* abuf = (bf16_t*)(ws + OFF_ABUF); bf16_t* cat = (bf16_t*)(ws + OFF_CAT); bf16_t* act = (bf16_t*)(ws + OFF_ACT);
        float* ssq1 = (float*)(ws + OFF_SSQ1); float* ssq2 = (float*)(ws + OFF_SSQ2); const float* modl = mod + (size_t)l * 9 * 6144;
        (void)mod; (void)abuf; (void)cat; (void)act; (void)ssq1; (void)ssq2; (void)modl; (void)ybuf;
        EpiResid e; e.gscale = 1.f; e.y = ybuf; e.gate = modl + 2048; e.ng = p.in[11] + l * 1024; e.nsc = modl + 4096; e.abuf = abuf; e.ssq_out = ssq2;
        const bf16_t* W = (const bf16_t*)(ws + OFF_EWOUT) + (size_t)li * 1024 * 1024;
#if PROBE_RESID
        e.gscale = 0.f;
        for (int t = bid; t < 64 * 4; t += nb) gemm_tile<192, 4>(cat, 1024, W, 1024, (t % 64) * 192, (t / 64) * 256, e, smem);
        e.gscale = 1.f; __syncthreads();
#endif
        for (int t = bid; t < 64 * 4; t += nb) gemm_tile<192, 4>(cat, 1024, W, 1024, (t % 64) * 192, (t / 64) * 256, e, smem);
      }
#endif
      xcd_barrier(xb);
    } else {
#ifndef SKIP_O2
      for (int rep_ = 0; rep_ < REP_O2; ++rep_) {
        unsigned char* ws = uniform_ptr(ws_); float* ybuf = (float*)uniform_ptr(out_); asm volatile("" : "+s"(ws), "+s"(ybuf));
        float* mod = (float*)(ws + OFF_MOD); bf16_t* abuf = (bf16_t*)(ws + OFF_ABUF); bf16_t* cat = (bf16_t*)(ws + OFF_CAT); bf16_t* act = (bf16_t*)(ws + OFF_ACT);
        float* ssq1 = (float*)(ws + OFF_SSQ1); float* ssq2 = (float*)(ws + OFF_SSQ2); const float* modl = mod + (size_t)l * 9 * 6144;
        (void)mod; (void)abuf; (void)cat; (void)act; (void)ssq1; (void)ssq2; (void)modl; (void)ybuf;
        EpiOddIn e;
        e.ssq = ssq1; e.shw = (const float*)(ws + OFF_SHW1) + (size_t)l * 9 * 3072; e.ubuf = (bf16_t*)(ws + OFF_UBUF); e.qlat = (bf16_t*)(ws + OFF_QLAT);
        e.kvlat = (bf16_t*)(ws + OFF_KVLAT); e.kpebuf = (float*)(ws + OFF_KPE); e.ssqq = (float*)(ws + OFF_SSQQ); e.ssqkv = (float*)(ws + OFF_SSQKV);
        e.out_ckv = (float*)(ws + OFF_KVRAW); e.out_kpe = ybuf + OUT_KPE; e.li = li;
        const bf16_t* W = (const bf16_t*)(ws + OFF_OWIN) + (size_t)li * 1280 * 1024;
        for (int t = bid; t < 48 * 5; t += nb) gemm_tile<256, 2>(abuf, 1024, W, 1024, (t % 48) * 256, (t / 48) * 256, e, smem);
      }
#endif
      xcd_barrier(xb);
#ifndef SKIP_O3
      for (int rep_ = 0; rep_ < REP_O3; ++rep_) {
        unsigned char* ws = uniform_ptr(ws_); float* ybuf = (float*)uniform_ptr(out_); asm volatile("" : "+s"(ws), "+s"(ybuf));
        float* mod = (float*)(ws + OFF_MOD); bf16_t* abuf = (bf16_t*)(ws + OFF_ABUF); bf16_t* cat = (bf16_t*)(ws + OFF_CAT); bf16_t* act = (bf16_t*)(ws + OFF_ACT);
        float* ssq1 = (float*)(ws + OFF_SSQ1); float* ssq2 = (float*)(ws + OFF_SSQ2); const float* modl = mod + (size_t)l * 9 * 6144;
        (void)mod; (void)abuf; (void)cat; (void)act; (void)ssq1; (void)ssq2; (void)modl; (void)ybuf;
        EpiKvUp ek; ek.ssqkv = (const float*)(ws + OFF_SSQKV); ek.gk = p.in[28] + li * 96; ek.kpebuf = (const float*)(ws + OFF_KPE); ek.cache_kpe = p.in[5];
        ek.kpm = (bf16_t*)(ws + OFF_KPM); ek.ksm = (bf16_t*)(ws + OFF_KSM); ek.vtpm = (bf16_t*)(ws + OFF_VTPM); ek.vtsm = (bf16_t*)(ws + OFF_VTSM); ek.li = li; ek.cache = 0;
        EpiQUp eq; eq.ssqq = (const float*)(ws + OFF_SSQQ); eq.gq = p.in[27] + li * 96; eq.qmla = (bf16_t*)(ws + OFF_QMLA);
        const bf16_t* Wkv = (const bf16_t*)(ws + OFF_WKVB) + (size_t)li * 1024 * 256;
        const bf16_t* Wq = (const bf16_t*)(ws + OFF_WQB) + (size_t)li * 1024 * 384;
        const bf16_t* cckv = (const bf16_t*)(ws + OFF_CCKV) + (size_t)li * 2048 * 256;
        for (int j = bid; j < 448 + 384 + 1536 + 512; j += nb) {
          if (j < 448) {
            const int mt = j % 112, nt = j / 112;
            const bool cch = mt >= 96;
            ek.cache = cch ? 1 : 0;
            gemm_tile<128, 2>(cch ? cckv : (const bf16_t*)(ws + OFF_KVLAT), 256, Wkv, 256, (cch ? mt - 96 : mt) * 128, nt * 256, ek, smem);
          } else if (j < 448 + 384) {
            const int jj = j - 448;
            gemm_tile<128, 2>((const bf16_t*)(ws + OFF_QLAT), 384, Wq, 384, (jj % 96) * 128, (jj / 96) * 256, eq, smem);
          } else if (j < 448 + 384 + 1536) job_poolx(p, j - 448 - 384);
          else job_ckvstate(p, j - 448 - 384 - 1536, li);
        }
      }
#endif
      xcd_barrier(xb);
#ifndef SKIP_O4
      for (int rep_ = 0; rep_ < REP_O4; ++rep_) {
        unsigned char* ws = uniform_ptr(ws_); float* ybuf = (float*)uniform_ptr(out_); asm volatile("" : "+s"(ws), "+s"(ybuf));
        float* mod = (float*)(ws + OFF_MOD); bf16_t* abuf = (bf16_t*)(ws + OFF_ABUF); bf16_t* cat = (bf16_t*)(ws + OFF_CAT); bf16_t* act = (bf16_t*)(ws + OFF_ACT);
        float* ssq1 = (float*)(ws + OFF_SSQ1); float* ssq2 = (float*)(ws + OFF_SSQ2); const float* modl = mod + (size_t)l * 9 * 6144;
        (void)mod; (void)abuf; (void)cat; (void)act; (void)ssq1; (void)ssq2; (void)modl; (void)ybuf;
        const bf16_t* qm = (const bf16_t*)(ws + OFF_QMLA);
        const bf16_t* kpm = (const bf16_t*)(ws + OFF_KPM); const bf16_t* ksm = (const bf16_t*)(ws + OFF_KSM);
        const bf16_t* vtpm = (const bf16_t*)(ws + OFF_VTPM); const bf16_t* vtsm = (const bf16_t*)(ws + OFF_VTSM);
        const float sc = 0.10206207261596575f;
        for (int j = bid; j < 256 + 128; j += nb) {
          if (j < 256) {
            const int qb2 = j & 3, hd = (j >> 2) & 7, b = j >> 5;
            const int tok0 = TP + b * 1024 + qb2 * 256;
            attn_task<96>(qm + (size_t)tok0 * 768 + hd * 96, 768,
                          ksm + ((size_t)(b * 8 + hd) * 1280) * 96, 96, vtsm + ((size_t)(b * 8 + hd) * 64) * 1280, 1280, 20,
                          ksm, 96, vtsm, 1280, 0, false, 0, 0, p.in[18],
                          cat + (size_t)tok0 * 1024 + 512 + hd * 64, 1024, sc, smem);
          } else if (j < 384) {
            const int jj = j - 256, hd = jj & 7, b = jj >> 3;
            const int tok0 = b * 256;
            attn_task<96>(qm + (size_t)tok0 * 768 + hd * 96, 768,
                          kpm + ((size_t)(b * 8 + hd) * 256) * 96, 96, vtpm + ((size_t)(b * 8 + hd) * 64) * 256, 256, 4,
                          kpm, 96, vtpm, 256, 0, false, 0, 0, p.in[18],
                          cat + (size_t)tok0 * 1024 + 512 + hd * 64, 1024, sc, smem);
          }
        }
      }
#endif
      xcd_barrier(xb);
#ifndef SKIP_O5
      {
        unsigned char* ws = uniform_ptr(ws_); float* ybuf = (float*)uniform_ptr(out_); asm volatile("" : "+s"(ws), "+s"(ybuf));
        float* mod = (float*)(ws + OFF_MOD); bf16_t* abuf = (bf16_t*)(ws + OFF_ABUF); bf16_t* cat = (bf16_t*)(ws + OFF_CAT); bf16_t* act = (bf16_t*)(ws + OFF_ACT);
        float* ssq1 = (float*)(ws + OFF_SSQ1); float* ssq2 = (float*)(ws + OFF_SSQ2); const float* modl = mod + (size_t)l * 9 * 6144;
        (void)mod; (void)abuf; (void)cat; (void)act; (void)ssq1; (void)ssq2; (void)modl; (void)ybuf;
        EpiResid e; e.gscale = 1.f; e.y = ybuf; e.gate = modl + 2048; e.ng = p.in[11] + l * 1024; e.nsc = modl + 4096; e.abuf = abuf; e.ssq_out = ssq2;
        const bf16_t* W = (const bf16_t*)(ws + OFF_OWOUT) + (size_t)li * 1024 * 1024;
#if PROBE_RESID
        e.gscale = 0.f;
        for (int t = bid; t < 64 * 4; t += nb) gemm_tile<192, 4>(cat, 1024, W, 1024, (t % 64) * 192, (t / 64) * 256, e, smem);
        e.gscale = 1.f; __syncthreads();
#endif
        for (int t = bid; t < 64 * 4; t += nb) gemm_tile<192, 4>(cat, 1024, W, 1024, (t % 64) * 192, (t / 64) * 256, e, smem);
      }
#endif
      xcd_barrier(xb);
    }
#ifndef SKIP_M1
    {
        unsigned char* ws = uniform_ptr(ws_); float* ybuf = (float*)uniform_ptr(out_); asm volatile("" : "+s"(ws), "+s"(ybuf));
        float* mod = (float*)(ws + OFF_MOD); bf16_t* abuf = (bf16_t*)(ws + OFF_ABUF); bf16_t* cat = (bf16_t*)(ws + OFF_CAT); bf16_t* act = (bf16_t*)(ws + OFF_ACT);
        float* ssq1 = (float*)(ws + OFF_SSQ1); float* ssq2 = (float*)(ws + OFF_SSQ2); const float* modl = mod + (size_t)l * 9 * 6144;
        (void)mod; (void)abuf; (void)cat; (void)act; (void)ssq1; (void)ssq2; (void)modl; (void)ybuf;
      EpiMlp1 e; e.ssq = ssq2; e.shw = (const float*)(ws + OFF_SHW2) + (size_t)l * 9 * 4096; e.act = act;
      const bf16_t* W = (const bf16_t*)(ws + OFF_W1T) + (size_t)l * 4096 * 1024;
#if PROBE_M1 == 1
      for (int t = bid; t < 48 * 16; t += nb) gemm_tile<256, 2>(abuf, 1024, W, 1024, (t % 48) * 256, (t / 48) * 256, e, smem);
#elif PROBE_M1 == 2
      for (int t = bid; t < 48 * 16; t += nb) gemm_tile<256, 2, true>(abuf, 1024, W, 1024, (t % 48) * 256, (t / 48) * 256, e, smem);
#endif
      for (int t = bid; t < 48 * 16; t += nb) gemm_tile<256, 2>(abuf, 1024, W, 1024, (t % 48) * 256, (t / 48) * 256, e, smem);
    }
#endif
    xcd_barrier(xb);
#ifndef SKIP_M2
    {
        unsigned char* ws = uniform_ptr(ws_); float* ybuf = (float*)uniform_ptr(out_); asm volatile("" : "+s"(ws), "+s"(ybuf));
        float* mod = (float*)(ws + OFF_MOD); bf16_t* abuf = (bf16_t*)(ws + OFF_ABUF); bf16_t* cat = (bf16_t*)(ws + OFF_CAT); bf16_t* act = (bf16_t*)(ws + OFF_ACT);
        float* ssq1 = (float*)(ws + OFF_SSQ1); float* ssq2 = (float*)(ws + OFF_SSQ2); const float* modl = mod + (size_t)l * 9 * 6144;
        (void)mod; (void)abuf; (void)cat; (void)act; (void)ssq1; (void)ssq2; (void)modl; (void)ybuf;
      EpiResid e; e.gscale = 1.f; e.y = ybuf; e.gate = modl + 5120;
      if (l < 3) { e.ng = p.in[10] + (l + 1) * 1024; e.nsc = mod + (size_t)(l + 1) * 9 * 6144 + 1024; } else { e.ng = nullptr; e.nsc = nullptr; }
      e.abuf = abuf; e.ssq_out = ssq1;
      const bf16_t* W = (const bf16_t*)(ws + OFF_W2T) + (size_t)l * 1024 * 4096;
#if PROBE_M2
      e.gscale = 0.f;
      for (int t = bid; t < 64 * 4; t += nb) gemm_tile<192, 4>(act, 4096, W, 4096, (t % 64) * 192, (t / 64) * 256, e, smem);
      e.gscale = 1.f; __syncthreads();
#endif
      for (int t = bid; t < 64 * 4; t += nb) gemm_tile<192, 4>(act, 4096, W, 4096, (t % 64) * 192, (t / 64) * 256, e, smem);
    }
#endif
    if (l < 3) xcd_barrier(xb);
  }
}

static void add_mat(Params& p, int& idx, int& tiles, const float* src, const float* rscale, size_t dst, int K, int N, int Npad, int headpad, int blockdiag) {
  MatDesc& m = p.mats[idx++];
  m.src = src; m.rscale = rscale; m.dst = dst; m.K = K; m.N = N; m.Npad = Npad; m.headpad = headpad; m.tile0 = tiles; m.blockdiag = blockdiag;
  tiles += (K / 128) * (Npad / 64);
}

extern "C" void kernel_launch(void* const* d_in, const int* in_sizes, int n_in, void* d_out, int out_size, void* d_ws, size_t ws_size, hipStream_t stream) {
  if (ws_size < WS_NEED) { fprintf(stderr, "kernel_launch: workspace too small (%zu < %zu)\n", ws_size, (size_t)WS_NEED); return; }
  static int grid_blocks = 0;
  if (!grid_blocks) {
    int dev = 0, cus = 0, per_cu = 0;
    (void)hipGetDevice(&dev);
    (void)hipDeviceGetAttribute(&cus, hipDeviceAttributeMultiprocessorCount, dev);
    (void)hipOccupancyMaxActiveBlocksPerMultiprocessor(&per_cu, fwd_megakernel, NTHREADS, 0);
    if (per_cu < 1) fprintf(stderr, "kernel_launch: occupancy query reports %d blocks per CU\n", per_cu);
    grid_blocks = cus;
  }
  Params p;
  memset(&p, 0, sizeof(p));
  for (int i = 0; i < 30; ++i) p.in[i] = (const float*)d_in[i];
  p.out = (float*)d_out; p.ws = (unsigned char*)d_ws;
  int idx = 0, tiles = 0;
  for (int i = 0; i < 2; ++i) add_mat(p, idx, tiles, p.in[29] + (size_t)i * 1024 * 1024, nullptr, OFF_OWOUT + (size_t)i * 1024 * 1024 * 2, 1024, 1024, 1024, 0, 2 + i);
  for (int l = 0; l < 4; ++l) add_mat(p, idx, tiles, p.in[12] + (size_t)l * 1024 * 4096, nullptr, OFF_W1T + (size_t)l * 4096 * 1024 * 2, 1024, 4096, 4096, 0, 0);
  for (int l = 0; l < 4; ++l) add_mat(p, idx, tiles, p.in[13] + (size_t)l * 4096 * 1024, nullptr, OFF_W2T + (size_t)l * 4096 * 1024 * 2, 4096, 1024, 1024, 0, 0);
  for (int i = 0; i < 2; ++i) add_mat(p, idx, tiles, p.in[14] + (size_t)i * 1024 * 3072, nullptr, OFF_EWIN + (size_t)i * 3072 * 1024 * 2, 1024, 3072, 3072, 0, 0);
  for (int i = 0; i < 2; ++i) add_mat(p, idx, tiles, p.in[19] + (size_t)i * 1024 * 1024, nullptr, OFF_EWOUT + (size_t)i * 1024 * 1024 * 2, 1024, 1024, 1024, 0, 0);
  for (int i = 0; i < 2; ++i) add_mat(p, idx, tiles, p.in[20] + (size_t)i * 1024 * 1184, nullptr, OFF_OWIN + (size_t)i * 1280 * 1024 * 2, 1024, 1184, 1280, 0, 0);
  for (int i = 0; i < 2; ++i) add_mat(p, idx, tiles, p.in[24] + (size_t)i * 384 * 768, p.in[23] + i * 384, OFF_WQB + (size_t)i * 1024 * 384 * 2, 384, 768, 1024, 1, 0);
  for (int i = 0; i < 2; ++i) add_mat(p, idx, tiles, p.in[26] + (size_t)i * 256 * 1024, p.in[25] + i * 256, OFF_WKVB + (size_t)i * 1024 * 256 * 2, 256, 1024, 1024, 0, 0);
  p.conv_tiles = tiles;
  if (hipMemsetAsync((unsigned char*)d_ws + OFF_BAR, 0, 16384, stream) != hipSuccess) { fprintf(stderr, "kernel_launch: memset of barrier words failed\n"); return; }
  void* args[] = {&p};
  hipError_t e = hipLaunchCooperativeKernel((void*)fwd_megakernel, dim3(grid_blocks), dim3(NTHREADS), args, 0, stream);
  if (e != hipSuccess) fprintf(stderr, "cooperative launch failed: %s (grid %d)\n", hipGetErrorString(e), grid_blocks);
}
```

```cpp
#include <hip/hip_runtime.h>
#include <hip/hip_cooperative_groups.h>
#include <cstdio>
#include <cstdint>
#include <cstring>
namespace cg = cooperative_groups;

typedef unsigned short bf16_t;
using bf16x8 = __attribute__((ext_vector_type(8))) short;
using f32x16 = __attribute__((ext_vector_type(16))) float;
typedef __bf16 bf16v2 __attribute__((ext_vector_type(2)));
typedef unsigned u32x4 __attribute__((ext_vector_type(4)));
typedef unsigned u32x2 __attribute__((ext_vector_type(2)));
typedef float f32x4 __attribute__((ext_vector_type(4)));
#define DI __device__ __forceinline__
#define MFMA(a, b, c) __builtin_amdgcn_mfma_f32_32x32x16_bf16((a), (b), (c), 0, 0, 0)
#define CROW(i, h) (((i) & 3) + 8 * ((i) >> 2) + 4 * (h))

#ifndef REP_PH0
#define REP_PH0 1
#endif
#ifndef REP_PH1
#define REP_PH1 1
#endif
#ifndef REP_E2
#define REP_E2 1
#endif
#ifndef REP_E3
#define REP_E3 1
#endif
#ifndef REP_O3
#define REP_O3 1
#endif
#ifndef REP_O4
#define REP_O4 1
#endif
#ifndef REP_M1
#define REP_M1 1
#endif
#ifndef REP_MODS
#define REP_MODS 1
#endif
#ifndef REP_WCONV
#define REP_WCONV 1
#endif
#ifndef REP_CACHE
#define REP_CACHE 1
#endif

#ifndef PROBE_M1
#define PROBE_M1 0
#endif
#ifndef REP_PH0
#define REP_PH0 1
#endif
#ifndef REP_PH1
#define REP_PH1 1
#endif
#ifndef REP_E2
#define REP_E2 1
#endif
#ifndef REP_E3
#define REP_E3 1
#endif
#ifndef REP_O2
#define REP_O2 1
#endif
#ifndef REP_O3
#define REP_O3 1
#endif
#ifndef REP_O4
#define REP_O4 1
#endif
#ifndef PROBE_RESID
#define PROBE_RESID 0
#endif
#ifndef PROBE_M2
#define PROBE_M2 0
#endif
constexpr int T = 12288, TP = 4096;
constexpr float EPS = 1e-6f;
constexpr int NTHREADS = 512;
constexpr int NWAVES = 8;
constexpr int SMEM_BYTES = 147456 + 8192;
constexpr int SIDE_OFF = 147456;

constexpr size_t al(size_t x) { return (x + 255) & ~size_t(255); }
constexpr size_t OFF_BAR   = 0;
constexpr size_t OFF_MOD   = 16384;
constexpr size_t OFF_SHW1  = al(OFF_MOD + 4ull * 9 * 6144 * 4);
constexpr size_t OFF_SHW2  = al(OFF_SHW1 + 4ull * 9 * 3072 * 4);
constexpr size_t OFF_SSQ1  = al(OFF_SHW2 + 4ull * 9 * 4096 * 4);
constexpr size_t OFF_SSQ2  = al(OFF_SSQ1 + 16ull * T * 4);
constexpr size_t OFF_SSQQ  = al(OFF_SSQ2 + 16ull * T * 4);
constexpr size_t OFF_SSQKV = al(OFF_SSQQ + 3ull * T * 4);
constexpr size_t OFF_KPE   = al(OFF_SSQKV + 2ull * T * 4);
constexpr size_t OFF_KVRAW = al(OFF_KPE + (size_t)T * 32 * 4);
constexpr size_t OFF_CNK   = al(OFF_KVRAW + 4096ull * 256 * 4);
constexpr size_t OFF_CNVT  = al(OFF_CNK + 2ull * 2048 * 512 * 2);
constexpr size_t OFF_CCKV  = al(OFF_CNVT + 2ull * 2048 * 512 * 2);
constexpr size_t OFF_W1T   = al(OFF_CCKV + 2ull * 2048 * 256 * 2);
constexpr size_t OFF_W2T   = al(OFF_W1T + 4ull * 4096 * 1024 * 2);
constexpr size_t OFF_EWIN  = al(OFF_W2T + 4ull * 4096 * 1024 * 2);
constexpr size_t OFF_EWOUT = al(OFF_EWIN + 2ull * 3072 * 1024 * 2);
constexpr size_t OFF_OWIN  = al(OFF_EWOUT + 2ull * 1024 * 1024 * 2);
constexpr size_t OFF_WQB   = al(OFF_OWIN + 2ull * 1280 * 1024 * 2);
constexpr size_t OFF_WKVB  = al(OFF_WQB + 2ull * 1024 * 384 * 2);
constexpr size_t OFF_OWOUT = al(OFF_WKVB + 2ull * 1024 * 256 * 2);
constexpr size_t OFF_POOLW = al(OFF_OWOUT + 2ull * 1024 * 1024 * 2);
constexpr size_t OFF_ABUF  = al(OFF_POOLW + 2ull * 512 * 512 * 2);
constexpr size_t OFF_CAT   = al(OFF_ABUF + (size_t)T * 1024 * 2);
constexpr size_t OFF_ACT   = al(OFF_CAT + (size_t)T * 1024 * 2);
constexpr size_t WS_NEED   = al(OFF_ACT + (size_t)T * 4096 * 2);
constexpr size_t OFF_BCONV = OFF_ACT;
constexpr size_t OFF_QBUF  = al(OFF_BCONV + (size_t)T * 1536 * 2);
constexpr size_t OFF_KBUF  = al(OFF_QBUF + (size_t)T * 512 * 2);
constexpr size_t OFF_VTP   = al(OFF_KBUF + (size_t)T * 512 * 2);
constexpr size_t OFF_VTS   = al(OFF_VTP + 16ull * 8 * 64 * 256 * 2);
constexpr size_t OFF_UBUF  = OFF_ACT;
constexpr size_t OFF_QLAT  = al(OFF_UBUF + (size_t)T * 512 * 2);
constexpr size_t OFF_KVLAT = al(OFF_QLAT + (size_t)T * 384 * 2);
constexpr size_t OFF_XP    = al(OFF_KVLAT + (size_t)T * 256 * 2);
constexpr size_t OFF_QMLA  = al(OFF_XP + (size_t)T * 512 * 2);
constexpr size_t OFF_KPM   = al(OFF_QMLA + (size_t)T * 768 * 2);
constexpr size_t OFF_KSM   = al(OFF_KPM + 16ull * 8 * 256 * 96 * 2);
constexpr size_t OFF_VTPM  = al(OFF_KSM + 8ull * 8 * 1280 * 96 * 2);
constexpr size_t OFF_VTSM  = al(OFF_VTPM + 16ull * 8 * 64 * 256 * 2);
static_assert(OFF_VTSM + 8ull * 8 * 64 * 1280 * 2 <= WS_NEED, "odd buffers overflow");
static_assert(OFF_VTS + 8ull * 8 * 64 * 1024 * 2 <= WS_NEED, "even buffers overflow");

constexpr size_t OUT_Y   = 0;
constexpr size_t OUT_NAK = (size_t)T * 1024;
constexpr size_t OUT_NAV = OUT_NAK + 16ull * 2 * 256 * 512;
constexpr size_t OUT_CKV = OUT_NAV + 16ull * 2 * 256 * 512;
constexpr size_t OUT_KPE = OUT_CKV + 16ull * 2 * 256 * 256;

struct MatDesc { const float* src; const float* rscale; unsigned long long dst; int K, N, Npad, headpad, tile0, blockdiag; };
constexpr int NMATS = 20;
struct Params {
  const float* in[30];
  float* out;
  unsigned char* ws;
  MatDesc mats[NMATS];
  int conv_tiles;
  int pad_;
};

__device__ __forceinline__ f32x4 make_f32x4(float a, float b, float c, float d) { f32x4 v = {a, b, c, d}; return v; }
#define GAS __attribute__((address_space(1)))
template <class T> DI void gst(T* p, const T& v) { *(GAS T*)p = v; }
template <class T> DI T gld_nt(const T* p) { return __builtin_nontemporal_load((const GAS T*)p); }
template <class T> DI T gld(const T* p) { return *(const GAS T*)p; }
DI unsigned char* uniform_ptr(const void* p) { const unsigned long long v = (unsigned long long)p; const unsigned lo = __builtin_amdgcn_readfirstlane((unsigned)v), hi = __builtin_amdgcn_readfirstlane((unsigned)(v >> 32)); return (unsigned char*)(((unsigned long long)hi << 32) | lo); }
DI int otid() { int t = threadIdx.x; asm volatile("" : "+v"(t)); return t; }
DI unsigned pack2(float a, float b) { bf16v2 v = {(__bf16)a, (__bf16)b}; return __builtin_bit_cast(unsigned, v); }
DI bf16_t f2bf(float a) { return __builtin_bit_cast(unsigned short, (__bf16)a); }
DI float bf2f(unsigned v16) { return __uint_as_float(v16 << 16); }
DI float bflo(unsigned u) { return __uint_as_float(u << 16); }
DI float bfhi(unsigned u) { return __uint_as_float(u & 0xffff0000u); }
DI int mi_of(int m) { return m < TP ? 0 : 1 + ((m - TP) >> 10); }
DI float xor32(float v) { return __shfl_xor(v, 32, 64); }
DI void store_bf4(bf16_t* p, float a, float b, float c, float d) { u32x2 u; u.x = pack2(a, b); u.y = pack2(c, d); *(GAS u32x2*)p = u; }
template <int NP> DI float rstd_parts(const float* ssq, int m, float invn) {
  float v[NP];
#pragma unroll
  for (int p = 0; p < NP; ++p) v[p] = gld(ssq + (size_t)p * T + m);
  float s = 0.f;
#pragma unroll
  for (int p = 0; p < NP; ++p) s += v[p];
  return rsqrtf(s * invn + EPS);
}

#define XB_TMO      128
#define XB_XCNT(j)  (256  + 64 * (j))
#define XB_XSUB(j)  (1280 + 64 * (j))
#define XB_XGEN(j)  (2304 + 64 * (j))
#define XB_TOP      3328
#define XB_TOPGEN   3392
#define XCD_BAR_WORDS 3456
#define XB_SPIN_CAP (1u << 20)
#define LAS __attribute__((address_space(3)))
DI unsigned xb_ld(unsigned* p)              { return __hip_atomic_load(p, __ATOMIC_RELAXED, __HIP_MEMORY_SCOPE_AGENT); }
DI unsigned xb_add(unsigned* p, unsigned v) { return __hip_atomic_fetch_add(p, v, __ATOMIC_RELAXED, __HIP_MEMORY_SCOPE_AGENT); }
DI unsigned xb_xcc_id() { return (unsigned)__builtin_amdgcn_s_getreg((3 << 11) | 20) & 0xFu; }
#define XB_SPIN(cond, bar) do { unsigned _sp = 0; while (cond) { __builtin_amdgcn_s_sleep(1); \
    if ((++_sp & 255u) == 0u) { if (xb_ld(&(bar)[XB_TMO])) break; if (_sp > XB_SPIN_CAP) { atomicAdd(&(bar)[XB_TMO], 1u); break; } } } } while (0)
struct XcdBarrier { unsigned* bar; unsigned x; volatile LAS unsigned* st; };
DI XcdBarrier xcd_barrier_post(unsigned* bar, volatile LAS unsigned* st) {
  XcdBarrier b; b.bar = bar; b.x = xb_xcc_id(); b.st = st;
  if (threadIdx.x == 0) (void)xb_add(&bar[XB_XCNT(b.x)], 1u);
  return b;
}
DI void xcd_barrier_complete(unsigned* bar, unsigned x, unsigned& nloc, unsigned& nx) {
  const unsigned G = gridDim.x * gridDim.y * gridDim.z;
  unsigned sum, cnt, mine, sp = 0u;
  for (;;) {
    sum = 0u; cnt = 0u; mine = 0u;
#pragma unroll
    for (unsigned j = 0; j < 16; ++j) { const unsigned c = xb_ld(&bar[XB_XCNT(j)]); sum += c; cnt += (c > 0u) ? 1u : 0u; mine = (j == x) ? c : mine; }
    if (sum == G) break;
    __builtin_amdgcn_s_sleep(1);
    if ((++sp & 255u) == 0u) { if (xb_ld(&bar[XB_TMO])) break; if (sp > XB_SPIN_CAP) { atomicAdd(&bar[XB_TMO], 1u); break; } }
  }
  nloc = mine > 0u ? mine : 1u; nx = cnt > 0u ? cnt : 1u;
}
DI void xcd_barrier(const XcdBarrier& b) {
  asm volatile("s_waitcnt vmcnt(0)" ::: "memory");
  __syncthreads();
  if (threadIdx.x == 0) {
    unsigned* bar = b.bar;
    __builtin_amdgcn_s_waitcnt(0);
    unsigned nloc = b.st[0], nx = b.st[1];
    if (nloc == 0u) { xcd_barrier_complete(bar, b.x, nloc, nx); b.st[0] = nloc; b.st[1] = nx; }
    const unsigned old = xb_add(&bar[XB_XSUB(b.x)], 1u);
    const unsigned gen = old / nloc;
    if (old + 1u == (gen + 1u) * nloc) {
      __builtin_amdgcn_fence(__ATOMIC_RELEASE, "agent");
      asm volatile("s_waitcnt vmcnt(0)" ::: "memory");
      const unsigned og = xb_add(&bar[XB_TOP], 1u);
      const unsigned tg = og / nx;
      if (og + 1u == (tg + 1u) * nx) xb_add(&bar[XB_TOPGEN], 1u);
      else XB_SPIN(xb_ld(&bar[XB_TOPGEN]) == tg, bar);
      __builtin_amdgcn_fence(__ATOMIC_ACQUIRE, "agent");
      xb_add(&bar[XB_XGEN(b.x)], 1u);
      asm volatile("s_waitcnt vmcnt(0)" ::: "memory");
    } else {
      XB_SPIN(xb_ld(&bar[XB_XGEN(b.x)]) == gen, bar);
      __builtin_amdgcn_fence(__ATOMIC_ACQUIRE, "agent");
      asm volatile("s_waitcnt vmcnt(0)" ::: "memory");
    }
  }
  __syncthreads();
}

typedef __attribute__((address_space(3))) unsigned lds_u32_t;
template <int OFF> DI bf16x8 lds_rd128(unsigned addr) { bf16x8 v; asm volatile("ds_read_b128 %0, %1 offset:%2" : "=v"(v) : "v"(addr), "n"(OFF) : "memory"); return v; }
template <int N, int NW, int NA> DI void lgkm_wait(bf16x8 (&wf)[NW], bf16x8 (&af)[NA]) {
  if constexpr (NW == 4 && NA == 2) asm volatile("s_waitcnt lgkmcnt(%6)" : "+v"(wf[0]), "+v"(wf[1]), "+v"(wf[2]), "+v"(wf[3]), "+v"(af[0]), "+v"(af[1]) : "n"(N) : "memory");
  else if constexpr (NW == 2 && NA == 3) asm volatile("s_waitcnt lgkmcnt(%5)" : "+v"(wf[0]), "+v"(wf[1]), "+v"(af[0]), "+v"(af[1]), "+v"(af[2]) : "n"(N) : "memory");
  else asm volatile("s_waitcnt lgkmcnt(%5)" : "+v"(wf[0]), "+v"(wf[1]), "+v"(wf[2]), "+v"(wf[3]), "+v"(af[0]) : "n"(N) : "memory");
}
template <int TM, int WNW, bool DRY = false, class Epi>
DI void gemm_tile(const bf16_t* __restrict__ A, int lda, const bf16_t* __restrict__ W, int K, int m0, int n0, const Epi& epi, unsigned char* smem) {
  constexpr int WMW = 8 / WNW, NT = 256 / WNW / 32, MT = TM / WMW / 32, NLA = TM / 64, WAVE_N = 256 / WNW, WAVE_M = TM / WMW;
  constexpr int STAGE = (TM + 256) * 128;
  static_assert((NT == 4 && MT == 2) || (NT == 2 && MT == 3) || (NT == 4 && MT == 1), "fragment wait helper covers these shapes");
  const int tid = otid(), lane = tid & 63, w = tid >> 6, r = lane & 31, h = lane >> 5;
  const int wn = w % WNW, wm = w / WNW;
  f32x16 acc[NT][MT];
#pragma unroll
  for (int a = 0; a < NT; ++a)
#pragma unroll
    for (int b = 0; b < MT; ++b)
#pragma unroll
      for (int i = 0; i < 16; ++i) acc[a][b][i] = 0.f;
  const int KT = K >> 6;
  const int lrow = tid >> 3, lkc = (tid & 7) ^ ((tid >> 4) & 7);
  typedef const __attribute__((address_space(1))) unsigned* gsrc_t;
  const bf16_t* ga = A + (size_t)(m0 + lrow) * lda + lkc * 8;
  const bf16_t* gw = W + (size_t)(n0 + lrow) * K + lkc * 8;
#define DMA_TILE(KT_, ST_) do { \
    unsigned char* sa_ = smem + (ST_) * STAGE + tid * 16; \
    _Pragma("unroll") for (int i = 0; i < NLA; ++i) \
      __builtin_amdgcn_global_load_lds((gsrc_t)(ga + (size_t)(64 * i) * lda + (KT_) * 64), (lds_u32_t*)(sa_ + i * 8192), 16, 0, 0); \
    _Pragma("unroll") for (int i = 0; i < 4; ++i) \
      __builtin_amdgcn_global_load_lds((gsrc_t)(gw + (size_t)(64 * i) * K + (KT_) * 64), (lds_u32_t*)(sa_ + TM * 128 + i * 8192), 16, 0, 0); } while (0)
  __syncthreads();
  epi.side(n0, m0, tid, smem + SIDE_OFF);
  DMA_TILE(0, 0);
  const int swz = (r >> 1) & 7;
  const unsigned lbase = (unsigned)(size_t)smem;
  const unsigned offw = lbase + TM * 128 + (wn * WAVE_N + r) * 128, offa = lbase + (wm * WAVE_M + r) * 128;
  unsigned cx[4];
#pragma unroll
  for (int ks = 0; ks < 4; ++ks) cx[ks] = ((2 * ks + h) ^ swz) << 4;
#define FRAGS(BUF, KS_) do { \
    wf[BUF][0] = lds_rd128<0>(pw + cx[KS_]); wf[BUF][1] = lds_rd128<4096>(pw + cx[KS_]); \
    if constexpr (NT == 4) { wf[BUF][2] = lds_rd128<8192>(pw + cx[KS_]); wf[BUF][3] = lds_rd128<12288>(pw + cx[KS_]); } \
    af[BUF][0] = lds_rd128<0>(pa + cx[KS_]); \
    if constexpr (MT >= 2) af[BUF][1] = lds_rd128<4096>(pa + cx[KS_]); \
    if constexpr (MT >= 3) af[BUF][2] = lds_rd128<8192>(pa + cx[KS_]); } while (0)
#define MMAS(BUF) do { _Pragma("unroll") for (int a = 0; a < NT; ++a) _Pragma("unroll") for (int b = 0; b < MT; ++b) acc[a][b] = MFMA(wf[BUF][a], af[BUF][b], acc[a][b]); } while (0)
  for (int kt = 0; kt < KT; ++kt) {
    asm volatile("s_waitcnt vmcnt(0)" ::: "memory");
    __syncthreads();
    if (kt + 1 < KT) DMA_TILE(kt + 1, (kt + 1) & 1);
    __builtin_amdgcn_sched_barrier(0);
    const unsigned pw = offw + (kt & 1) * STAGE, pa = offa + (kt & 1) * STAGE;
    bf16x8 wf[2][NT], af[2][MT];
    FRAGS(0, 0);
    FRAGS(1, 1);
    lgkm_wait<NT + MT>(wf[0], af[0]);
    MMAS(0);
    __builtin_amdgcn_sched_barrier(0);
    FRAGS(0, 2);
    lgkm_wait<NT + MT>(wf[1], af[1]);
    MMAS(1);
    __builtin_amdgcn_sched_barrier(0);
    FRAGS(1, 3);
    lgkm_wait<NT + MT>(wf[0], af[0]);
    MMAS(0);
    __builtin_amdgcn_sched_barrier(0);
    lgkm_wait<0>(wf[1], af[1]);
    MMAS(1);
    __builtin_amdgcn_sched_barrier(0);
  }
#undef DMA_TILE
#undef FRAGS
#undef MMAS
  if (DRY) {
    float sdry = 0.f;
#pragma unroll
    for (int a = 0; a < NT; ++a)
#pragma unroll
      for (int b = 0; b < MT; ++b)
#pragma unroll
        for (int i = 0; i < 16; ++i) sdry += acc[a][b][i];
    if (sdry != 12345.678f) return;
  }
  __syncthreads();
  epi(acc, n0 + wn * WAVE_N, m0 + wm * WAVE_M, lane, smem + w * 9216, smem + SIDE_OFF, n0, m0);
}

struct EpiEvenIn {
  const float* ssq; const float* shw; const float* gq; const float* gk;
  bf16_t* bconv; bf16_t* qbuf; bf16_t* kbuf; bf16_t* vtp; bf16_t* vts; float* out_k; float* out_v; int li;
  DI void side(int n0, int m0, int tid, unsigned char* sd) const {
    float* f = (float*)sd;
    if (tid < 192) f[tid] = rstd_parts<16>(ssq, m0 + tid, 1.f / 1024.f);
    const int mi = mi_of(tid < 256 ? m0 : m0 + 191);
    f[192 + tid] = gld(shw + mi * 3072 + n0 + (tid & 255));
  }
  template <int MT> DI void operator()(f32x16 (&acc)[2][MT], int nb, int mb, int lane, unsigned char* wlds, const unsigned char* side, int n0, int m0) const {
    const int r = lane & 31, h = lane >> 5;
    const int region = nb >> 9;
#pragma unroll
    for (int mt = 0; mt < MT; ++mt) {
      const int m = mb + mt * 32 + r;
      const float* sf = (const float*)side;
      const float rs = sf[m - m0];
      const float* sw = sf + 192 + (mi_of(m) != mi_of(m0) ? 256 : 0) + (nb - n0);
      float ss = 0.f;
#pragma unroll
      for (int nt = 0; nt < 2; ++nt)
#pragma unroll
        for (int g = 0; g < 4; ++g) {
          const f32x4 s4 = *(const f32x4*)(sw + nt * 32 + 8 * g + 4 * h);
          acc[nt][mt][4 * g + 0] = rs * acc[nt][mt][4 * g + 0] + s4.x;
          acc[nt][mt][4 * g + 1] = rs * acc[nt][mt][4 * g + 1] + s4.y;
          acc[nt][mt][4 * g + 2] = rs * acc[nt][mt][4 * g + 2] + s4.z;
          acc[nt][mt][4 * g + 3] = rs * acc[nt][mt][4 * g + 3] + s4.w;
#pragma unroll
          for (int j = 0; j < 4; ++j) ss += acc[nt][mt][4 * g + j] * acc[nt][mt][4 * g + j];
        }
      if (region < 3) {
#pragma unroll
        for (int nt = 0; nt < 2; ++nt)
#pragma unroll
          for (int g = 0; g < 4; ++g)
            store_bf4(bconv + (size_t)m * 1536 + nb + nt * 32 + 8 * g + 4 * h, acc[nt][mt][4 * g], acc[nt][mt][4 * g + 1], acc[nt][mt][4 * g + 2], acc[nt][mt][4 * g + 3]);
      } else if (region < 5) {
        const bool isk = region == 4;
        const float* gain = isk ? gk : gq;
        bf16_t* dst = (isk ? kbuf : qbuf) + (size_t)m * 512 + (nb - (isk ? 2048 : 1536));
        float* od = nullptr;
        if (isk && m < TP) od = out_k + ((size_t)(((m >> 8) * 2 + li) * 256 + (m & 255))) * 512 + (nb - 2048);
        ss += xor32(ss);
        const float rn = rsqrtf(ss * (1.f / 64.f) + EPS);
#pragma unroll
        for (int nt = 0; nt < 2; ++nt)
#pragma unroll
          for (int g = 0; g < 4; ++g) {
            const int d = nt * 32 + 8 * g + 4 * h;
            const f32x4 g4 = gld((const f32x4*)(gain + d));
            const float o0 = acc[nt][mt][4 * g] * rn * g4.x, o1 = acc[nt][mt][4 * g + 1] * rn * g4.y, o2 = acc[nt][mt][4 * g + 2] * rn * g4.z, o3 = acc[nt][mt][4 * g + 3] * rn * g4.w;
            store_bf4(dst + d, o0, o1, o2, o3);
            if (od) *(GAS f32x4*)(od + d) = make_f32x4(o0, o1, o2, o3);
          }
      } else {
        const bool pr = m < TP;
        const int s = m - TP;
        const int hd = (nb - 2560) >> 6;
        float* od = pr ? out_v + ((size_t)(((m >> 8) * 2 + li) * 256 + (m & 255))) * 512 + (nb - 2560) : nullptr;
        bf16_t* vt0 = pr ? vtp + ((size_t)((m >> 8) * 8 + hd) * 64) * 256 + (m & 255) : vts + ((size_t)((s >> 10) * 8 + hd) * 64) * 1024 + (s & 1023);
        const int st = pr ? 256 : 1024;
#pragma unroll
        for (int nt = 0; nt < 2; ++nt)
#pragma unroll
          for (int g = 0; g < 4; ++g) {
            const int d = nt * 32 + 8 * g + 4 * h;
#pragma unroll
            for (int j = 0; j < 4; ++j) gst(vt0 + (size_t)(d + j) * st, f2bf(acc[nt][mt][4 * g + j]));
            if (pr) *(GAS f32x4*)(od + d) = make_f32x4(acc[nt][mt][4 * g], acc[nt][mt][4 * g + 1], acc[nt][mt][4 * g + 2], acc[nt][mt][4 * g + 3]);
          }
      }
    }
  }
};

struct EpiResid {
  float* y; const float* gate; const float* ng; const float* nsc; bf16_t* abuf; float* ssq_out; float gscale;
  DI void side(int n0, int m0, int tid, unsigned char* sd) const {
    float* f = (float*)sd;
    const int mi = mi_of(tid < 256 ? m0 : m0 + 191), n = n0 + (tid & 255);
    f[tid] = gld(gate + mi * 6144 + n) * gscale;
    f[512 + tid] = ng ? gld(ng + n) * (1.f + gld(nsc + mi * 6144 + n)) : 0.f;
  }
  template <int MT> DI void operator()(f32x16 (&acc)[2][MT], int nb, int mb, int lane, unsigned char* wlds, const unsigned char* side, int n0, int m0) const {
    const int r = lane & 31, h = lane >> 5, cc = lane & 15, rq = lane >> 4;
    const int mi0 = mi_of(m0);
#pragma unroll
    for (int mt = 0; mt < MT; ++mt) {
#pragma unroll
      for (int nt = 0; nt < 2; ++nt)
#pragma unroll
        for (int g = 0; g < 4; ++g)
          *(f32x4*)(wlds + r * 272 + (nt * 32 + 8 * g + 4 * h) * 4) = make_f32x4(acc[nt][mt][4 * g], acc[nt][mt][4 * g + 1], acc[nt][mt][4 * g + 2], acc[nt][mt][4 * g + 3]);
#pragma unroll
      for (int i = 0; i < 8; ++i) {
        const int row = rq + 4 * i;
        const int m = mb + mt * 32 + row, n = nb + cc * 4;
        const float* sf = (const float*)side + (mi_of(m) != mi0 ? 256 : 0) + (n - n0);
        const f32x4 a = *(const f32x4*)(wlds + row * 272 + cc * 16);
        f32x4 yo = gld((const f32x4*)(y + (size_t)m * 1024 + n));
        const f32x4 gt = *(const f32x4*)sf;
        yo.x += gt.x * a.x; yo.y += gt.y * a.y; yo.z += gt.z * a.z; yo.w += gt.w * a.w;
        *(GAS f32x4*)(y + (size_t)m * 1024 + n) = yo;
        if (ng) {
          const f32x4 gg = *(const f32x4*)(sf + 512);
          store_bf4(abuf + (size_t)m * 1024 + n, yo.x * gg.x, yo.y * gg.y, yo.z * gg.z, yo.w * gg.w);
          float ss = yo.x * yo.x + yo.y * yo.y + yo.z * yo.z + yo.w * yo.w;
          ss += __shfl_xor(ss, 1, 64); ss += __shfl_xor(ss, 2, 64); ss += __shfl_xor(ss, 4, 64); ss += __shfl_xor(ss, 8, 64);
          if (cc == 0) gst(ssq_out + (size_t)(nb >> 6) * T + m, ss);
        }
      }
    }
  }
};

struct EpiMlp1 {
  const float* ssq; const float* shw; bf16_t* act;
  DI void side(int n0, int m0, int tid, unsigned char* sd) const {
    float* f = (float*)sd;
    if (tid < 256) f[tid] = rstd_parts<16>(ssq, m0 + tid, 1.f / 1024.f);
    else f[tid] = gld(shw + mi_of(m0) * 4096 + n0 + (tid - 256));
  }
  template <int NT, int MT> DI void operator()(f32x16 (&acc)[NT][MT], int nb, int mb, int lane, unsigned char* wlds, const unsigned char* side, int n0, int m0) const {
    const int r = lane & 31, h = lane >> 5;
    constexpr int RS = NT * 64 + 16;
    constexpr int CPR = NT * 4;
#pragma unroll
    for (int mt = 0; mt < MT; ++mt) {
      const float* sf = (const float*)side;
      const float rs = sf[mb - m0 + mt * 32 + r];
#pragma unroll
      for (int nt = 0; nt < NT; ++nt)
#pragma unroll
        for (int g = 0; g < 4; ++g) {
          const int nl = nt * 32 + 8 * g + 4 * h;
          const f32x4 s4 = *(const f32x4*)(sf + 256 + (nb - n0) + nl);
          float v0 = fmaxf(rs * acc[nt][mt][4 * g] + s4.x, 0.f), v1 = fmaxf(rs * acc[nt][mt][4 * g + 1] + s4.y, 0.f);
          float v2 = fmaxf(rs * acc[nt][mt][4 * g + 2] + s4.z, 0.f), v3 = fmaxf(rs * acc[nt][mt][4 * g + 3] + s4.w, 0.f);
          u32x2 u; u.x = pack2(v0 * v0, v1 * v1); u.y = pack2(v2 * v2, v3 * v3);
          *(u32x2*)(wlds + r * RS + nl * 2) = u;
        }
#pragma unroll
      for (int i = 0; i < 32 * CPR / 64; ++i) {
        const int c = lane + 64 * i, row = c / CPR, cc = c % CPR;
        const u32x4 v = *(const u32x4*)(wlds + row * RS + cc * 16);
        *(GAS u32x4*)(act + (size_t)(mb + mt * 32 + row) * 4096 + nb + cc * 8) = v;
      }
    }
  }
};

struct EpiOddIn {
  const float* ssq; const float* shw; bf16_t* ubuf; bf16_t* qlat; bf16_t* kvlat; float* kpebuf; float* ssqq; float* ssqkv; float* out_ckv; float* out_kpe; int li;
  DI void side(int n0, int m0, int tid, unsigned char* sd) const {
    float* f = (float*)sd;
    if (tid < 256) f[tid] = rstd_parts<16>(ssq, m0 + tid, 1.f / 1024.f);
    else f[tid] = gld(shw + mi_of(m0) * 3072 + n0 + (tid - 256));
  }
  template <int MT> DI void operator()(f32x16 (&acc)[4][MT], int nb, int mb, int lane, unsigned char* wlds, const unsigned char* side, int n0, int m0) const {
    const int r = lane & 31, h = lane >> 5;
#pragma unroll
    for (int mt = 0; mt < MT; ++mt) {
      __builtin_amdgcn_sched_barrier(0);
      const int m = mb + mt * 32 + r;
      const float* sf = (const float*)side;
      const float rs = sf[m - m0];
      const float* sw = sf + 256 + (nb - n0);
      float ss = 0.f;
#pragma unroll
      for (int nt = 0; nt < 4; ++nt)
#pragma unroll
        for (int g = 0; g < 4; ++g) {
          const f32x4 s4 = *(const f32x4*)(sw + nt * 32 + 8 * g + 4 * h);
          acc[nt][mt][4 * g + 0] = rs * acc[nt][mt][4 * g + 0] + s4.x;
          acc[nt][mt][4 * g + 1] = rs * acc[nt][mt][4 * g + 1] + s4.y;
          acc[nt][mt][4 * g + 2] = rs * acc[nt][mt][4 * g + 2] + s4.z;
          acc[nt][mt][4 * g + 3] = rs * acc[nt][mt][4 * g + 3] + s4.w;
#pragma unroll
          for (int j = 0; j < 4; ++j) ss += acc[nt][mt][4 * g + j] * acc[nt][mt][4 * g + j];
        }
      ss += xor32(ss);
      const size_t prow = (size_t)(((m >> 8) * 2 + li) * 256 + (m & 255));
      if (nb < 512) {
#pragma unroll
        for (int nt = 0; nt < 4; ++nt)
#pragma unroll
          for (int g = 0; g < 4; ++g)
            store_bf4(ubuf + (size_t)m * 512 + nb + nt * 32 + 8 * g + 4 * h, acc[nt][mt][4 * g], acc[nt][mt][4 * g + 1], acc[nt][mt][4 * g + 2], acc[nt][mt][4 * g + 3]);
      } else if (nb < 896) {
#pragma unroll
        for (int nt = 0; nt < 4; ++nt)
#pragma unroll
          for (int g = 0; g < 4; ++g)
            store_bf4(qlat + (size_t)m * 384 + (nb - 512) + nt * 32 + 8 * g + 4 * h, acc[nt][mt][4 * g], acc[nt][mt][4 * g + 1], acc[nt][mt][4 * g + 2], acc[nt][mt][4 * g + 3]);
        if (h == 0) gst(ssqq + (size_t)((nb - 512) >> 7) * T + m, ss);
      } else if (nb < 1152) {
#pragma unroll
        for (int nt = 0; nt < 4; ++nt)
#pragma unroll
          for (int g = 0; g < 4; ++g) {
            const int c = (nb - 896) + nt * 32 + 8 * g + 4 * h;
            store_bf4(kvlat + (size_t)m * 256 + c, acc[nt][mt][4 * g], acc[nt][mt][4 * g + 1], acc[nt][mt][4 * g + 2], acc[nt][mt][4 * g + 3]);
            if (m < TP) *(GAS f32x4*)(out_ckv + (size_t)m * 256 + c) = make_f32x4(acc[nt][mt][4 * g], acc[nt][mt][4 * g + 1], acc[nt][mt][4 * g + 2], acc[nt][mt][4 * g + 3]);
          }
        if (h == 0) gst(ssqkv + (size_t)((nb - 896) >> 7) * T + m, ss);
      } else {
#pragma unroll
        for (int g = 0; g < 4; ++g) {
          const int c = 8 * g + 4 * h;
          const f32x4 v = make_f32x4(acc[0][mt][4 * g], acc[0][mt][4 * g + 1], acc[0][mt][4 * g + 2], acc[0][mt][4 * g + 3]);
          *(GAS f32x4*)(kpebuf + (size_t)m * 32 + c) = v;
          if (m < TP) *(GAS f32x4*)(out_kpe + prow * 32 + c) = v;
        }
      }
    }
  }
};

DI void rope_cs(int j8, float posv, float& c, float& s) {
  const float inv = __builtin_amdgcn_exp2f(-1.6609640474436813f * (float)j8);
  const float ang = posv * inv;
  c = __cosf(ang); s = __sinf(ang);
}

struct EpiQUp {
  DI void side(int, int, int, unsigned char*) const {}
  const float* ssqq; const float* gq; bf16_t* qmla;
  template <int MT> DI void operator()(f32x16 (&acc)[4][MT], int nb, int mb, int lane, unsigned char* wlds, const unsigned char* side, int n0, int m0) const {
   const int r = lane & 31, h = lane >> 5, hd = nb >> 7;
#pragma unroll
   for (int mt = 0; mt < MT; ++mt) {
    __builtin_amdgcn_sched_barrier(0);
    const int m = mb + mt * 32 + r;
    const float rq = rstd_parts<3>(ssqq, m, 1.f / 384.f);
    float ss = 0.f;
#pragma unroll
    for (int nt = 0; nt < 3; ++nt)
#pragma unroll
      for (int i = 0; i < 16; ++i) { acc[nt][mt][i] *= rq; ss += acc[nt][mt][i] * acc[nt][mt][i]; }
    ss += xor32(ss);
    const float rn = rsqrtf(ss * (1.f / 96.f) + EPS);
#pragma unroll
    for (int nt = 0; nt < 3; ++nt)
#pragma unroll
      for (int g = 0; g < 4; ++g) {
        const f32x4 g4 = gld((const f32x4*)(gq + nt * 32 + 8 * g + 4 * h));
        acc[nt][mt][4 * g] *= rn * g4.x; acc[nt][mt][4 * g + 1] *= rn * g4.y; acc[nt][mt][4 * g + 2] *= rn * g4.z; acc[nt][mt][4 * g + 3] *= rn * g4.w;
      }
    if (m >= TP) {
      const int pos = (m - TP) & 1023;
      const float prow = (float)(pos >> 6), pcol = (float)(pos & 63);
#pragma unroll
      for (int g = 0; g < 2; ++g)
#pragma unroll
        for (int j = 0; j < 4; ++j) {
          float c, s; rope_cs(4 * h + j, g == 0 ? prow : pcol, c, s);
          const float x1 = acc[2][mt][4 * g + j], x2 = acc[2][mt][8 + 4 * g + j];
          acc[2][mt][4 * g + j] = x1 * c - x2 * s;
          acc[2][mt][8 + 4 * g + j] = x2 * c + x1 * s;
        }
    }
#pragma unroll
    for (int nt = 0; nt < 3; ++nt)
#pragma unroll
      for (int g = 0; g < 4; ++g)
        store_bf4(qmla + (size_t)m * 768 + hd * 96 + nt * 32 + 8 * g + 4 * h, acc[nt][mt][4 * g], acc[nt][mt][4 * g + 1], acc[nt][mt][4 * g + 2], acc[nt][mt][4 * g + 3]);
   }
  }
};

struct EpiKvUp {
  DI void side(int, int, int, unsigned char*) const {}
  const float* ssqkv; const float* gk; const float* kpebuf; const float* cache_kpe; bf16_t* kpm; bf16_t* ksm; bf16_t* vtpm; bf16_t* vtsm; int li; int cache;
  template <int MT> DI void operator()(f32x16 (&acc)[4][MT], int nb, int mb, int lane, unsigned char* wlds, const unsigned char* side, int n0, int m0) const {
   const int r = lane & 31, h = lane >> 5, hd = nb >> 7;
#pragma unroll
   for (int mt = 0; mt < MT; ++mt) {
    __builtin_amdgcn_sched_barrier(0);
    const int m = mb + mt * 32 + r;
    float rs = 1.f;
    const float* kp;
    bf16_t* kdst; bf16_t* vdst; int vst; bool rope = false; int pos = 0;
    if (cache) {
      const int b = m >> 8, p = m & 255;
      kp = cache_kpe + ((size_t)((b * 2 + li) * 256 + p)) * 32;
      kdst = ksm + ((size_t)(b * 8 + hd) * 1280 + p) * 96;
      vdst = vtsm + ((size_t)(b * 8 + hd) * 64) * 1280 + p; vst = 1280;
    } else {
      rs = rstd_parts<2>(ssqkv, m, 1.f / 256.f);
      kp = kpebuf + (size_t)m * 32;
      if (m < TP) {
        const int b = m >> 8, p = m & 255;
        kdst = kpm + ((size_t)(b * 8 + hd) * 256 + p) * 96;
        vdst = vtpm + ((size_t)(b * 8 + hd) * 64) * 256 + p; vst = 256;
      } else {
        const int s = m - TP, b = s >> 10; pos = s & 1023; rope = true;
        kdst = ksm + ((size_t)(b * 8 + hd) * 1280 + 256 + pos) * 96;
        vdst = vtsm + ((size_t)(b * 8 + hd) * 64) * 1280 + 256 + pos; vst = 1280;
      }
    }
    float ss = 0.f;
#pragma unroll
    for (int nt = 0; nt < 4; ++nt)
#pragma unroll
      for (int i = 0; i < 16; ++i) { acc[nt][mt][i] *= rs; if (nt < 2) ss += acc[nt][mt][i] * acc[nt][mt][i]; }
    ss += xor32(ss);
    const f32x4 a0 = gld((const f32x4*)(kp + 8 * h)), a1 = gld((const f32x4*)(kp + 8 * h + 4));
    const f32x4 b0 = gld((const f32x4*)(kp + 16 + 8 * h)), b1 = gld((const f32x4*)(kp + 16 + 8 * h + 4));
    float x1[8] = {a0.x, a0.y, a0.z, a0.w, a1.x, a1.y, a1.z, a1.w};
    float x2[8] = {b0.x, b0.y, b0.z, b0.w, b1.x, b1.y, b1.z, b1.w};
    float sp = 0.f;
#pragma unroll
    for (int j = 0; j < 8; ++j) sp += x1[j] * x1[j] + x2[j] * x2[j];
    sp += xor32(sp);
    const float rn = rsqrtf((ss + sp) * (1.f / 96.f) + EPS);
#pragma unroll
    for (int nt = 0; nt < 2; ++nt)
#pragma unroll
      for (int g = 0; g < 4; ++g) {
        const int d = nt * 32 + 8 * g + 4 * h;
        const f32x4 g4 = gld((const f32x4*)(gk + d));
        store_bf4(kdst + d, acc[nt][mt][4 * g] * rn * g4.x, acc[nt][mt][4 * g + 1] * rn * g4.y, acc[nt][mt][4 * g + 2] * rn * g4.z, acc[nt][mt][4 * g + 3] * rn * g4.w);
      }
    const float prow = (float)(pos >> 6), pcol = (float)(pos & 63);
#pragma unroll
    for (int j = 0; j < 8; ++j) {
      const int jj = 8 * h + j;
      float a = x1[j] * rn * gk[64 + jj], b = x2[j] * rn * gk[80 + jj];
      if (rope) {
        float c, s; rope_cs(j, h == 0 ? prow : pcol, c, s);
        const float na = a * c - b * s, nb2 = b * c + a * s;
        a = na; b = nb2;
      }
      x1[j] = a; x2[j] = b;
    }
    { u32x4 u; u.x = pack2(x1[0], x1[1]); u.y = pack2(x1[2], x1[3]); u.z = pack2(x1[4], x1[5]); u.w = pack2(x1[6], x1[7]); *(GAS u32x4*)(kdst + 64 + 8 * h) = u; }
    { u32x4 u; u.x = pack2(x2[0], x2[1]); u.y = pack2(x2[2], x2[3]); u.z = pack2(x2[4], x2[5]); u.w = pack2(x2[6], x2[7]); *(GAS u32x4*)(kdst + 80 + 8 * h) = u; }
#pragma unroll
    for (int nt = 2; nt < 4; ++nt)
#pragma unroll
      for (int i = 0; i < 16; ++i) {
        const int d = (nt - 2) * 32 + CROW(i, h);
        gst(vdst + (size_t)d * vst, f2bf(acc[nt][mt][i]));
      }
   }
  }
};

struct EpiPool {
  DI void side(int, int, int, unsigned char*) const {}
  const float* scale; bf16_t* cat;
  template <int NT, int MT> DI void operator()(f32x16 (&acc)[NT][MT], int nb, int mb, int lane, unsigned char* wlds, const unsigned char* side, int n0, int m0) const {
    const int r = lane & 31, h = lane >> 5;
#pragma unroll
    for (int mt = 0; mt < MT; ++mt) {
      const int m = mb + mt * 32 + r;
#pragma unroll
      for (int nt = 0; nt < NT; ++nt)
#pragma unroll
        for (int g = 0; g < 4; ++g) {
          const int n = nb + nt * 32 + 8 * g + 4 * h;
          const f32x4 s4 = gld((const f32x4*)(scale + n));
          store_bf4(cat + (size_t)m * 1024 + n, acc[nt][mt][4 * g] * s4.x, acc[nt][mt][4 * g + 1] * s4.y, acc[nt][mt][4 * g + 2] * s4.z, acc[nt][mt][4 * g + 3] * s4.w);
        }
    }
  }
};

template <int DQK>
DI void attn_task(const bf16_t* __restrict__ Q, int qs,
                  const bf16_t* __restrict__ K0, int ks0, const bf16_t* __restrict__ V0, int vs0, int nt0,
                  const bf16_t* __restrict__ K1, int ks1, const bf16_t* __restrict__ V1, int vs1, int nt1,
                  bool na, int qrow0, int krow0, const float* __restrict__ rpb_h,
                  bf16_t* __restrict__ O, int os, float scale, unsigned char* smem) {
  constexpr int KSTR = (DQK + 8) * 2;
  constexpr int CH = DQK / 8;
  constexpr int NKC = (CH * 64 + 511) / 512;
  constexpr int KSTAGE = 64 * 208, VSTAGE = 64 * 144;
  constexpr float LOG2E = 1.4426950408889634f;
  const int tid = otid(), lane = tid & 63, w = tid >> 6, r = lane & 31, h = lane >> 5;
  float* srpb = (float*)(smem + 2 * KSTAGE + 2 * VSTAGE);
  const int NTT = nt0 + nt1;

  __syncthreads();
  if (na) for (int i = tid; i < 465; i += 512) srpb[i] = rpb_h[i] * LOG2E;

  bf16x8 qf[DQK / 16];
  {
    const bf16_t* qp = Q + (size_t)(32 * w + r) * qs + 8 * h;
#pragma unroll
    for (int ks = 0; ks < DQK / 16; ++ks) qf[ks] = gld((const bf16x8*)(qp + ks * 16));
  }
  u32x4 rk[NKC], rv;
  const int vrow = tid >> 3, vkc = tid & 7;
  auto gload = [&](int j) {
    const bf16_t* kp; const bf16_t* vp; int kst, vst;
    if (j < nt0) { kp = K0 + (size_t)j * 64 * ks0; kst = ks0; vp = V0 + j * 64; vst = vs0; }
    else { kp = K1 + (size_t)(j - nt0) * 64 * ks1; kst = ks1; vp = V1 + (j - nt0) * 64; vst = vs1; }
#pragma unroll
    for (int i = 0; i < NKC; ++i) { const int c = tid + 512 * i; if (c < CH * 64) rk[i] = gld((const u32x4*)(kp + (size_t)(c / CH) * kst + (c % CH) * 8)); }
    rv = gld((const u32x4*)(vp + (size_t)vrow * vst + vkc * 8));
  };
  gload(0);

  f32x16 ot[2];
#pragma unroll
  for (int t = 0; t < 2; ++t)
#pragma unroll
    for (int i = 0; i < 16; ++i) ot[t][i] = 0.f;
  float m_run = -3.0e38f, l_run = 0.f;
  const float sc2 = scale * LOG2E;
  const int qrow = qrow0 + (w >> 1), qcol = 32 * (w & 1) + r;
  const int rsw = min(max(qrow - 4, 0), 8);
  const int csq = min(max(qcol - 8, 0), 48);

  for (int j = 0; j < NTT; ++j) {
    unsigned char* sK = smem + (j & 1) * KSTAGE;
    unsigned char* sV = smem + 2 * KSTAGE + (j & 1) * VSTAGE;
#pragma unroll
    for (int i = 0; i < NKC; ++i) { const int c = tid + 512 * i; if (c < CH * 64) *(u32x4*)(sK + (c / CH) * KSTR + (c % CH) * 16) = rk[i]; }
    *(u32x4*)(sV + vrow * 144 + vkc * 16) = rv;
    __syncthreads();
    if (j + 1 < NTT) gload(j + 1);
    __builtin_amdgcn_sched_barrier(0);
    const bool local = na && j < nt0;
    const int keyrow = krow0 + j;
    if (local && (keyrow < rsw || keyrow >= rsw + 8)) continue;
    f32x16 st[2];
#pragma unroll
    for (int t = 0; t < 2; ++t)
#pragma unroll
      for (int i = 0; i < 16; ++i) st[t][i] = 0.f;
    {
      bf16x8 kf[DQK / 16][2];
#pragma unroll
      for (int ks = 0; ks < DQK / 16; ++ks)
#pragma unroll
        for (int t = 0; t < 2; ++t) kf[ks][t] = *(const bf16x8*)(sK + (t * 32 + r) * KSTR + ks * 32 + h * 16);
      __builtin_amdgcn_sched_barrier(0);
#pragma unroll
      for (int ks = 0; ks < DQK / 16; ++ks)
#pragma unroll
        for (int t = 0; t < 2; ++t) st[t] = MFMA(kf[ks][t], qf[ks], st[t]);
    }
    bf16x8 vfr[4][2];
#pragma unroll
    for (int s2 = 0; s2 < 4; ++s2)
#pragma unroll
      for (int dv = 0; dv < 2; ++dv) {
        const unsigned char* vb = sV + (dv * 32 + r) * 144 + (16 * s2 + 4 * h) * 2;
        const u32x2 v0 = *(const u32x2*)(vb), v1 = *(const u32x2*)(vb + 16);
        const u32x4 vu = {v0.x, v0.y, v1.x, v1.y};
        vfr[s2][dv] = __builtin_bit_cast(bf16x8, vu);
      }
    __builtin_amdgcn_sched_barrier(0);
    float mx = -3.0e38f;
    if (local) {
      const int dr = keyrow - qrow + 7;
#pragma unroll
      for (int t = 0; t < 2; ++t)
#pragma unroll
        for (int i = 0; i < 16; ++i) {
          const int kc = t * 32 + CROW(i, h);
          const bool valid = (kc >= csq) && (kc < csq + 16);
          const int dc = min(max(kc - qcol + 15, 0), 30);
          const float bias = srpb[dr * 31 + dc];
          const float s = valid ? __builtin_fmaf(st[t][i], sc2, bias) : -1.0e30f;
          st[t][i] = s; mx = fmaxf(mx, s);
        }
    } else {
#pragma unroll
      for (int t = 0; t < 2; ++t)
#pragma unroll
        for (int i = 0; i < 16; ++i) mx = fmaxf(mx, st[t][i]);
      mx *= sc2;
    }
    mx = fmaxf(mx, xor32(mx));
    const float m_new = fmaxf(m_run, mx);
    if (__builtin_amdgcn_ballot_w64(m_new > m_run) != 0ull) {
      const float alpha = __builtin_amdgcn_exp2f(m_run - m_new);
      l_run *= alpha;
#pragma unroll
      for (int t = 0; t < 2; ++t)
#pragma unroll
        for (int i = 0; i < 16; ++i) ot[t][i] *= alpha;
    }
    m_run = m_new;
    if (local) {
#pragma unroll
      for (int t = 0; t < 2; ++t)
#pragma unroll
        for (int i = 0; i < 16; ++i) { const float p = __builtin_amdgcn_exp2f(st[t][i] - m_new); st[t][i] = p; l_run += p; }
    } else {
#pragma unroll
      for (int t = 0; t < 2; ++t)
#pragma unroll
        for (int i = 0; i < 16; ++i) { const float p = __builtin_amdgcn_exp2f(__builtin_fmaf(st[t][i], sc2, -m_new)); st[t][i] = p; l_run += p; }
    }
#pragma unroll
    for (int s2 = 0; s2 < 4; ++s2) {
      const int t = s2 >> 1, o = (s2 & 1) * 8;
      const u32x4 pu = {pack2(st[t][o + 0], st[t][o + 1]), pack2(st[t][o + 2], st[t][o + 3]), pack2(st[t][o + 4], st[t][o + 5]), pack2(st[t][o + 6], st[t][o + 7])};
      const bf16x8 pfv = __builtin_bit_cast(bf16x8, pu);
#pragma unroll
      for (int dv = 0; dv < 2; ++dv) ot[dv] = MFMA(vfr[s2][dv], pfv, ot[dv]);
    }
  }
  const float lt = l_run + xor32(l_run);
  const float inv = 1.f / lt;
  bf16_t* op = O + (size_t)(32 * w + r) * os;
#pragma unroll
  for (int dv = 0; dv < 2; ++dv)
#pragma unroll
    for (int g = 0; g < 4; ++g)
      store_bf4(op + dv * 32 + 8 * g + 4 * h, ot[dv][4 * g] * inv, ot[dv][4 * g + 1] * inv, ot[dv][4 * g + 2] * inv, ot[dv][4 * g + 3] * inv);
}

DI void job_mods(const Params& p, int j, unsigned char* smem) {
  const int tid = otid(), lane = tid & 63, w = tid >> 6, kq = lane >> 4, c4 = lane & 15;
  const int l = j / 96, n0 = (j % 96) * 64;
  float* s = (float*)smem;
  __syncthreads();
  for (int idx = tid; idx < 9 * 1024; idx += 512) {
    const int mi = idx >> 10, k = idx & 1023;
    const float x = mi == 0 ? p.in[7][k] : p.in[6][(mi - 1) * 1024 + k];
    s[idx] = x / (1.f + expf(-x));
  }
  __syncthreads();
  const float* Wp = p.in[8] + ((size_t)l * 1024 + w * 128 + kq) * 6144 + n0 + 4 * c4;
  float acc[9][4];
#pragma unroll
  for (int mi = 0; mi < 9; ++mi)
#pragma unroll
    for (int q = 0; q < 4; ++q) acc[mi][q] = 0.f;
#pragma unroll 8
  for (int i = 0; i < 32; ++i) {
    const f32x4 wv = gld_nt((const f32x4*)(Wp + (size_t)(4 * i) * 6144));
    const int k = w * 128 + 4 * i + kq;
#pragma unroll
    for (int mi = 0; mi < 9; ++mi) {
      const float sv = s[mi * 1024 + k];
      acc[mi][0] += sv * wv.x; acc[mi][1] += sv * wv.y; acc[mi][2] += sv * wv.z; acc[mi][3] += sv * wv.w;
    }
  }
#pragma unroll
  for (int mi = 0; mi < 9; ++mi)
#pragma unroll
    for (int q = 0; q < 4; ++q) { float v = acc[mi][q]; v += __shfl_xor(v, 16, 64); v += __shfl_xor(v, 32, 64); acc[mi][q] = v; }
  __syncthreads();
  float* red = (float*)smem;
  if (kq == 0) {
#pragma unroll
    for (int mi = 0; mi < 9; ++mi)
#pragma unroll
      for (int q = 0; q < 4; ++q) red[(w * 9 + mi) * 64 + 4 * c4 + q] = acc[mi][q];
  }
  __syncthreads();
  float* mod = (float*)(p.ws + OFF_MOD);
  for (int idx = tid; idx < 9 * 64; idx += 512) {
    const int mi = idx >> 6, ln = idx & 63;
    float v = 0.f;
#pragma unroll
    for (int q = 0; q < 8; ++q) v += red[(q * 9 + mi) * 64 + ln];
    mod[(size_t)(l * 9 + mi) * 6144 + n0 + ln] = v + p.in[9][l * 6144 + n0 + ln];
  }
}

DI void job_wconv(const Params& p, int t) {
  int mi = 0;
#pragma unroll 1
  for (int i = 1; i < NMATS; ++i) if (t >= p.mats[i].tile0) mi = i;
  const MatDesc md = p.mats[mi];
  const int lt = t - md.tile0;
  const int ktiles = md.K >> 7;
  const int k0 = (lt % ktiles) * 128 + (otid() >> 6) * 16, n = (lt / ktiles) * 64 + (otid() & 63);
  const float* sp; bool ok; size_t rs;
  if (md.blockdiag == 1) { ok = (k0 >> 7) == (n >> 7); sp = md.src + (size_t)(k0 >> 7) * 16384 + (size_t)(k0 & 127) * 128 + (n & 127); rs = 128; }
  else if (md.headpad) { const int hd = n >> 7, d = n & 127; ok = d < 96; sp = md.src + (size_t)k0 * md.N + hd * 96 + d; rs = md.N; }
  else { ok = n < md.N; sp = md.src + (size_t)k0 * md.N + n; rs = md.N; }
  float v[16];
  if (md.blockdiag >= 2 && k0 < 512) {
    const int li = md.blockdiag - 2, g = k0 >> 7;
    const int krow = __builtin_amdgcn_readfirstlane(k0 & 127);
    const float* pw = p.in[21] + ((size_t)(li * 4 + g) * 128 + krow) * 128;
    const float* scp = p.in[22] + li * 512 + g * 128;
    const float* wo = md.src + (size_t)(g * 128) * md.N + n;
#pragma unroll
    for (int q = 0; q < 16; ++q) v[q] = 0.f;
#pragma unroll 8
    for (int d = 0; d < 128; ++d) {
      const float x = scp[d] * wo[(size_t)d * md.N];
#pragma unroll
      for (int q = 0; q < 16; ++q) v[q] += pw[q * 128 + d] * x;
    }
  } else {
#pragma unroll
  for (int q = 0; q < 16; ++q) v[q] = ok ? gld_nt(sp + (size_t)q * rs) : 0.f;
  }
  if (md.rscale) {
#pragma unroll
    for (int q = 0; q < 16; ++q) v[q] *= md.rscale[k0 + q];
  }
  bf16_t* dst = (bf16_t*)(p.ws + md.dst) + (size_t)n * md.K + k0;
  u32x4 u0 = {pack2(v[0], v[1]), pack2(v[2], v[3]), pack2(v[4], v[5]), pack2(v[6], v[7])};
  u32x4 u1 = {pack2(v[8], v[9]), pack2(v[10], v[11]), pack2(v[12], v[13]), pack2(v[14], v[15])};
  *(GAS u32x4*)dst = u0;
  *(GAS u32x4*)(dst + 8) = u1;
}

DI void job_cache(const Params& p, int j) {
  const int tid = otid();
  if (j < 512) {
    const int item = j * 512 + tid;
    const int e = item * 8;
    const int c = e & 511, pos = (e >> 9) & 255, i = (e >> 17) & 1, b = e >> 18;
    const f32x4 a = gld_nt((const f32x4*)(p.in[2] + e)), bq = gld_nt((const f32x4*)(p.in[2] + e + 4));
    u32x4 u; u.x = pack2(a.x, a.y); u.y = pack2(a.z, a.w); u.z = pack2(bq.x, bq.y); u.w = pack2(bq.z, bq.w);
    *(GAS u32x4*)((bf16_t*)(p.ws + OFF_CNK) + ((size_t)(i * 2048 + b * 256 + pos)) * 512 + c) = u;
  } else if (j < 1024) {
    const int item = (j - 512) * 512 + tid;
    const int hd = item & 511, pos8 = (item >> 9) & 31, i = (item >> 14) & 1, b = item >> 15;
    const float* src = p.in[3] + ((size_t)((b * 2 + i) * 256 + pos8 * 8)) * 512 + hd;
    float v[8];
#pragma unroll
    for (int q = 0; q < 8; ++q) v[q] = src[(size_t)q * 512];
    u32x4 u; u.x = pack2(v[0], v[1]); u.y = pack2(v[2], v[3]); u.z = pack2(v[4], v[5]); u.w = pack2(v[6], v[7]);
    *(GAS u32x4*)((bf16_t*)(p.ws + OFF_CNVT) + ((size_t)((i * 8 + b) * 512 + hd)) * 256 + pos8 * 8) = u;
  } else {
    const int item = (j - 1024) * 512 + tid;
    const int e = item * 8;
    const int c = e & 255, pos = (e >> 8) & 255, i = (e >> 16) & 1, b = e >> 17;
    const f32x4 a = gld_nt((const f32x4*)(p.in[4] + e)), bq = gld_nt((const f32x4*)(p.in[4] + e + 4));
    u32x4 u; u.x = pack2(a.x, a.y); u.y = pack2(a.z, a.w); u.z = pack2(bq.x, bq.y); u.w = pack2(bq.z, bq.w);
    *(GAS u32x4*)((bf16_t*)(p.ws + OFF_CCKV) + ((size_t)(i * 2048 + b * 256 + pos)) * 256 + c) = u;
  }
}

DI void job_shw(const Params& p, int j, unsigned char* smem) {
  int l = 0, jj = j;
  if (jj >= 112) { jj -= 112; l = 1; if (jj >= 84) { jj -= 84; l = 2; if (jj >= 112) { jj -= 112; l = 3; } } }
  const int n1 = (l & 1) ? 20 : 48;
  const int which = jj >= n1;
  const int n0 = (which ? jj - n1 : jj) * 64;
  const bf16_t* Wt = which ? (const bf16_t*)(p.ws + OFF_W1T) + (size_t)l * 4096 * 1024
                           : ((l & 1) ? (const bf16_t*)(p.ws + OFF_OWIN) + (size_t)(l >> 1) * 1280 * 1024
                                      : (const bf16_t*)(p.ws + OFF_EWIN) + (size_t)(l >> 1) * 3072 * 1024);
  float* dst = which ? (float*)(p.ws + OFF_SHW2) + (size_t)l * 9 * 4096 : (float*)(p.ws + OFF_SHW1) + (size_t)l * 9 * 3072;
  const int ns = which ? 4096 : 3072;
  const float* mod = (const float*)(p.ws + OFF_MOD) + (size_t)l * 9 * 6144 + (which ? 3072 : 0);
  const int tid = otid(), lane = tid & 63, w = tid >> 6;
  float* s = (float*)smem;
  __syncthreads();
  for (int idx = tid; idx < 9 * 1024; idx += 512) s[idx] = mod[(idx >> 10) * 6144 + (idx & 1023)];
  __syncthreads();
  const bf16_t* wr = Wt + (size_t)(n0 + lane) * 1024 + w * 128;
  float acc[9];
#pragma unroll
  for (int mi = 0; mi < 9; ++mi) acc[mi] = 0.f;
#pragma unroll 2
  for (int c = 0; c < 16; ++c) {
    const u32x4 u = gld((const u32x4*)(wr + c * 8));
    const float wv[8] = {bflo(u.x), bfhi(u.x), bflo(u.y), bfhi(u.y), bflo(u.z), bfhi(u.z), bflo(u.w), bfhi(u.w)};
#pragma unroll
    for (int q = 0; q < 8; ++q)
#pragma unroll
      for (int mi = 0; mi < 9; ++mi) acc[mi] += s[mi * 1024 + w * 128 + c * 8 + q] * wv[q];
  }
  __syncthreads();
  float* red = (float*)smem;
#pragma unroll
  for (int mi = 0; mi < 9; ++mi) red[(w * 9 + mi) * 64 + lane] = acc[mi];
  __syncthreads();
  for (int idx = tid; idx < 9 * 64; idx += 512) {
    const int mi = idx >> 6, ln = idx & 63;
    float v = 0.f;
#pragma unroll
    for (int q = 0; q < 8; ++q) v += red[(q * 9 + mi) * 64 + ln];
    dst[(size_t)mi * ns + n0 + ln] = v;
  }
}

DI void job_xpass(const Params& p, int j) {
  const int tid = otid(), lane = tid & 63, w = tid >> 6;
  const int m = j * 8 + w, mi = mi_of(m);
  const float* x = m < TP ? p.in[0] + (size_t)m * 1024 : p.in[1] + (size_t)(m - TP) * 1024;
  const float* g1 = p.in[10];
  const float* sc = (const float*)(p.ws + OFF_MOD) + (size_t)mi * 6144 + 1024;
  float* y = p.out + OUT_Y + (size_t)m * 1024;
  bf16_t* ab = (bf16_t*)(p.ws + OFF_ABUF) + (size_t)m * 1024;
  float ss = 0.f;
#pragma unroll
  for (int i = 0; i < 4; ++i) {
    const int k = lane * 4 + 256 * i;
    const f32x4 v = gld_nt((const f32x4*)(x + k));
    const f32x4 g = gld((const f32x4*)(g1 + k));
    const f32x4 s4 = gld((const f32x4*)(sc + k));
    ss += v.x * v.x + v.y * v.y + v.z * v.z + v.w * v.w;
    *(GAS f32x4*)(y + k) = v;
    store_bf4(ab + k, v.x * g.x * (1.f + s4.x), v.y * g.y * (1.f + s4.y), v.z * g.z * (1.f + s4.z), v.w * g.w * (1.f + s4.w));
  }
#pragma unroll
  for (int o = 32; o >= 1; o >>= 1) ss += __shfl_xor(ss, o, 64);
  float* ssq = (float*)(p.ws + OFF_SSQ1);
  if (lane < 16) ssq[(size_t)lane * T + m] = lane == 0 ? ss : 0.f;
}

DI void job_conv(const Params& p, int j, int li) {
  const int item = j * 512 + otid();
  const int m = item >> 6, c = (item & 63) * 8;
  const bf16_t* bc = (const bf16_t*)(p.ws + OFF_BCONV);
  int pos, L;
  if (m < TP) { pos = m & 255; L = 256; } else { pos = (m - TP) & 1023; L = 1024; }
  const float* cw = p.in[15] + (size_t)li * 3 * 512 + c;
  float accv[8];
#pragma unroll
  for (int q = 0; q < 8; ++q) accv[q] = 0.f;
#pragma unroll
  for (int d = -1; d <= 1; ++d) {
    const int pp = pos + d;
    if (pp < 0 || pp >= L) continue;
    const u32x4 cg = gld((const u32x4*)(bc + (size_t)(m + d) * 1536 + 512 + c));
    const u32x4 xa = gld((const u32x4*)(bc + (size_t)(m + d) * 1536 + 1024 + c));
    const f32x4 w0 = gld((const f32x4*)(cw + (d + 1) * 512)), w1 = gld((const f32x4*)(cw + (d + 1) * 512 + 4));
    accv[0] += bflo(cg.x) * bflo(xa.x) * w0.x; accv[1] += bfhi(cg.x) * bfhi(xa.x) * w0.y;
    accv[2] += bflo(cg.y) * bflo(xa.y) * w0.z; accv[3] += bfhi(cg.y) * bfhi(xa.y) * w0.w;
    accv[4] += bflo(cg.z) * bflo(xa.z) * w1.x; accv[5] += bfhi(cg.z) * bfhi(xa.z) * w1.y;
    accv[6] += bflo(cg.w) * bflo(xa.w) * w1.z; accv[7] += bfhi(cg.w) * bfhi(xa.w) * w1.w;
  }
  const u32x4 bg = gld((const u32x4*)(bc + (size_t)m * 1536 + c));
  u32x4 u;
  u.x = pack2(bflo(bg.x) * accv[0], bfhi(bg.x) * accv[1]); u.y = pack2(bflo(bg.y) * accv[2], bfhi(bg.y) * accv[3]);
  u.z = pack2(bflo(bg.z) * accv[4], bfhi(bg.z) * accv[5]); u.w = pack2(bflo(bg.w) * accv[6], bfhi(bg.w) * accv[7]);
  *(GAS u32x4*)((bf16_t*)(p.ws + OFF_CAT) + (size_t)m * 1024 + c) = u;
}

DI void job_poolx(const Params& p, int j) {
  const int item = j * 512 + otid();
  const int m = item >> 6, c = (item & 63) * 8;
  const bf16_t* ub = (const bf16_t*)(p.ws + OFF_UBUF);
  int pos, L;
  if (m < TP) { pos = m & 255; L = 256; } else { pos = (m - TP) & 1023; L = 1024; }
  const int wsz = 2 << (c >> 7);
  const int lo = min(max(pos - wsz / 2, 0), L), hi = min(max(pos - wsz / 2 + wsz, 0), L);
  float s[8];
#pragma unroll
  for (int q = 0; q < 8; ++q) s[q] = 0.f;
  u32x4 uu[16];
#pragma unroll
  for (int q = 0; q < 16; ++q) {
    const u32x4 z = {0u, 0u, 0u, 0u};
    uu[q] = (lo + q < hi) ? gld((const u32x4*)(ub + (size_t)(m + lo + q - pos) * 512 + c)) : z;
  }
#pragma unroll
  for (int q = 0; q < 16; ++q) {
    const u32x4 u = uu[q];
    s[0] += bflo(u.x); s[1] += bfhi(u.x); s[2] += bflo(u.y); s[3] += bfhi(u.y); s[4] += bflo(u.z); s[5] += bfhi(u.z); s[6] += bflo(u.w); s[7] += bfhi(u.w);
  }
  const float inv = 1.f / (float)(hi - lo);
  const u32x4 u = gld((const u32x4*)(ub + (size_t)m * 512 + c));
  u32x4 o;
  o.x = pack2(s[0] * inv - bflo(u.x), s[1] * inv - bfhi(u.x)); o.y = pack2(s[2] * inv - bflo(u.y), s[3] * inv - bfhi(u.y));
  o.z = pack2(s[4] * inv - bflo(u.z), s[5] * inv - bfhi(u.z)); o.w = pack2(s[6] * inv - bflo(u.w), s[7] * inv - bfhi(u.w));
  *(GAS u32x4*)((bf16_t*)(p.ws + OFF_CAT) + (size_t)m * 1024 + c) = o;
}

DI void job_ckvstate(const Params& p, int j, int li) {
  const int item = j * 512 + otid();
  const int m = item >> 6, c = (item & 63) * 4;
  const float rs = rstd_parts<2>((const float*)(p.ws + OFF_SSQKV), m, 1.f / 256.f);
  float* o = p.out + OUT_CKV + ((size_t)(((m >> 8) * 2 + li) * 256 + (m & 255))) * 256 + c;
  const f32x4 g = gld((const f32x4*)(p.in[25] + li * 256 + c));
  f32x4 v = gld((const f32x4*)((const float*)(p.ws + OFF_KVRAW) + (size_t)m * 256 + c));
  v.x *= rs * g.x; v.y *= rs * g.y; v.z *= rs * g.z; v.w *= rs * g.w;
  *(GAS f32x4*)o = v;
}

__global__ void __launch_bounds__(NTHREADS, 2) fwd_megakernel(Params p) {
  __shared__ __attribute__((aligned(16))) unsigned char smem[SMEM_BYTES];
  __shared__ u32x4 xb_words;
  cg::grid_group grid = cg::this_grid();
  if (p.pad_ == 0x7fffffff) grid.sync();
  if (threadIdx.x == 0) { const u32x4 z = {0u, 0u, 0u, 0u}; xb_words = z; }
  __syncthreads();
  const XcdBarrier xb = xcd_barrier_post((unsigned*)(p.ws + OFF_BAR), (volatile LAS unsigned*)&xb_words);
  const int nb = gridDim.x, bid = blockIdx.x;
  unsigned char* const ws_ = p.ws;
  float* const out_ = p.out;

#ifndef SKIP_PH0
  for (int rep_ = 0; rep_ < REP_PH0; ++rep_) {
    const int n_mod = 384, n_conv = p.conv_tiles, n_cache = 1280;
    for (int j = bid; j < n_mod + n_conv + n_cache; j += nb) {
      if (j < n_mod) { for (int q_ = 0; q_ < REP_MODS; ++q_) job_mods(p, j, smem); }
      else if (j < n_mod + n_conv) { for (int q_ = 0; q_ < REP_WCONV; ++q_) job_wconv(p, j - n_mod); }
      else { for (int q_ = 0; q_ < REP_CACHE; ++q_) job_cache(p, j - n_mod - n_conv); }
    }
  }
#endif
  xcd_barrier(xb);
#ifndef SKIP_PH1
  for (int rep_ = 0; rep_ < REP_PH1; ++rep_) {
    for (int j = bid; j < 392 + 1536; j += nb) {
      if (j < 392) job_shw(p, j, smem); else job_xpass(p, j - 392);
    }
  }
#endif
  xcd_barrier(xb);

#pragma unroll 1
  for (int l = 0; l < 4; ++l) {
    const int li = l >> 1;
    if ((l & 1) == 0) {
#ifndef SKIP_E2
      for (int rep_ = 0; rep_ < REP_E2; ++rep_) {
        unsigned char* ws = uniform_ptr(ws_); float* ybuf = (float*)uniform_ptr(out_); asm volatile("" : "+s"(ws), "+s"(ybuf));
        float* mod = (float*)(ws + OFF_MOD); bf16_t* abuf = (bf16_t*)(ws + OFF_ABUF); bf16_t* cat = (bf16_t*)(ws + OFF_CAT); bf16_t* act = (bf16_t*)(ws + OFF_ACT);
        float* ssq1 = (float*)(ws + OFF_SSQ1); float* ssq2 = (float*)(ws + OFF_SSQ2); const float* modl = mod + (size_t)l * 9 * 6144;
        (void)mod; (void)abuf; (void)cat; (void)act; (void)ssq1; (void)ssq2; (void)modl; (void)ybuf;
        EpiEvenIn e;
        e.ssq = ssq1; e.shw = (const float*)(ws + OFF_SHW1) + (size_t)l * 9 * 3072; e.gq = p.in[16] + li * 64; e.gk = p.in[17] + li * 64;
        e.bconv = (bf16_t*)(ws + OFF_BCONV); e.qbuf = (bf16_t*)(ws + OFF_QBUF); e.kbuf = (bf16_t*)(ws + OFF_KBUF);
        e.vtp = (bf16_t*)(ws + OFF_VTP); e.vts = (bf16_t*)(ws + OFF_VTS); e.out_k = ybuf + OUT_NAK; e.out_v = ybuf + OUT_NAV; e.li = li;
        const bf16_t* W = (const bf16_t*)(ws + OFF_EWIN) + (size_t)li * 3072 * 1024;
        for (int t = bid; t < 64 * 12; t += nb) gemm_tile<192, 4>(abuf, 1024, W, 1024, (t % 64) * 192, (t / 64) * 256, e, smem);
      }
#endif
      xcd_barrier(xb);
#ifndef SKIP_E3
      for (int rep_ = 0; rep_ < REP_E3; ++rep_) {
        unsigned char* ws = uniform_ptr(ws_); float* ybuf = (float*)uniform_ptr(out_); asm volatile("" : "+s"(ws), "+s"(ybuf));
        float* mod = (float*)(ws + OFF_MOD); bf16_t* abuf = (bf16_t*)(ws + OFF_ABUF); bf16_t* cat = (bf16_t*)(ws + OFF_CAT); bf16_t* act = (bf16_t*)(ws + OFF_ACT);
        float* ssq1 = (float*)(ws + OFF_SSQ1); float* ssq2 = (float*)(ws + OFF_SSQ2); const float* modl = mod + (size_t)l * 9 * 6144;
        (void)mod; (void)abuf; (void)cat; (void)act; (void)ssq1; (void)ssq2; (void)modl; (void)ybuf;
        const bf16_t* qb = (const bf16_t*)(ws + OFF_QBUF); const bf16_t* kb = (const bf16_t*)(ws + OFF_KBUF);
        const bf16_t* vtp = (const bf16_t*)(ws + OFF_VTP); const bf16_t* vts = (const bf16_t*)(ws + OFF_VTS);
        const bf16_t* cnk = (const bf16_t*)(ws + OFF_CNK) + (size_t)li * 2048 * 512;
        const bf16_t* cnvt = (const bf16_t*)(ws + OFF_CNVT) + (size_t)li * 2048 * 512;
        for (int j = bid; j < 256 + 128 + 1536; j += nb) {
          if (j < 256) {
            const int rq = j & 3, hd = (j >> 2) & 7, b = j >> 5;
            const int tok0 = TP + b * 1024 + rq * 256;
            const int kr0 = min(max(4 * rq - 4, 0), 8), kr1 = min(max(4 * rq + 3 - 4, 0), 8) + 8;
            attn_task<64>(qb + (size_t)tok0 * 512 + hd * 64, 512,
                          kb + (size_t)(TP + b * 1024 + kr0 * 64) * 512 + hd * 64, 512, vts + ((size_t)(b * 8 + hd) * 64) * 1024 + kr0 * 64, 1024, kr1 - kr0,
                          cnk + (size_t)(b * 256) * 512 + hd * 64, 512, cnvt + ((size_t)(b * 8 + hd) * 64) * 256, 256, 4,
                          true, 4 * rq, kr0, p.in[18] + (size_t)(li * 8 + hd) * 465,
                          cat + (size_t)tok0 * 1024 + 512 + hd * 64, 1024, 0.125f, smem);
          } else if (j < 384) {
            const int jj = j - 256, hd = jj & 7, b = jj >> 3;
            const int tok0 = b * 256;
            attn_task<64>(qb + (size_t)tok0 * 512 + hd * 64, 512,
                          kb + (size_t)(b * 256) * 512 + hd * 64, 512, vtp + ((size_t)(b * 8 + hd) * 64) * 256, 256, 4,
                          kb, 512, vtp, 256, 0,
                          false, 0, 0, p.in[18],
                          cat + (size_t)tok0 * 1024 + 512 + hd * 64, 1024, 0.125f, smem);
          } else job_conv(p, j - 384, li);
        }
      }
#endif
      xcd_barrier(xb);
#ifndef SKIP_E4
      {
        unsigned char* ws = uniform_ptr(ws_); float* ybuf = (float*)uniform_ptr(out_); asm volatile("" : "+s"(ws), "+s"(ybuf));
        float* mod = (float*)(ws + OFF_MOD); bf16_t* abuf = (bf16_t*)(ws + OFF_ABUF); bf16_t* cat = (bf16_t*)(ws + OFF_CAT); bf16_t* act = (bf16_t*)(ws + OFF_ACT);
        float* ssq1 = (float*)(ws + OFF_SSQ1); float* ssq2 = (float*)(ws + OFF_SSQ2); const float* modl = mod + (size_t)l * 9 * 6144;
        (void)mod; (void)abuf; (void)cat; (void)act; (void)ssq1; (void)ssq2; (void)modl; (void)ybuf;
        EpiResid e; e.gscale = 1.f; e.y = ybuf; e.gate = modl + 2048; e.ng = p.in[11] + l * 1024; e.nsc = modl + 4096; e.abuf = abuf; e.ssq_out = ssq2;
        const bf16_t* W = (const bf16_t*)(ws + OFF_EWOUT) + (size_t)li * 1024 * 1024;
#if PROBE_RESID
        e.gscale = 0.f;
        for (int t = bid; t < 64 * 4; t += nb) gemm_tile<192, 4>(cat, 1024, W, 1024, (t % 64) * 192, (t / 64) * 256, e, smem);
        e.gscale = 1.f; __syncthreads();
#endif
        for (int t = bid; t < 64 * 4; t += nb) gemm_tile<192, 4>(cat, 1024, W, 1024, (t % 64) * 192, (t / 64) * 256, e, smem);
      }
#endif
      xcd_barrier(xb);
    } else {
#ifndef SKIP_O2
      for (int rep_ = 0; rep_ < REP_O2; ++rep_) {
        unsigned char* ws = uniform_ptr(ws_); float* ybuf = (float*)uniform_ptr(out_); asm volatile("" : "+s"(ws), "+s"(ybuf));
        float* mod = (float*)(ws + OFF_MOD); bf16_t* abuf = (bf16_t*)(ws + OFF_ABUF); bf16_t* cat = (bf16_t*)(ws + OFF_CAT); bf16_t* act = (bf16_t*)(ws + OFF_ACT);
        float* ssq1 = (float*)(ws + OFF_SSQ1); float* ssq2 = (float*)(ws + OFF_SSQ2); const float* modl = mod + (size_t)l * 9 * 6144;
        (void)mod; (void)abuf; (void)cat; (void)act; (void)ssq1; (void)ssq2; (void)modl; (void)ybuf;
        EpiOddIn e;
        e.ssq = ssq1; e.shw = (const float*)(ws + OFF_SHW1) + (size_t)l * 9 * 3072; e.ubuf = (bf16_t*)(ws + OFF_UBUF); e.qlat = (bf16_t*)(ws + OFF_QLAT);
        e.kvlat = (bf16_t*)(ws + OFF_KVLAT); e.kpebuf = (float*)(ws + OFF_KPE); e.ssqq = (float*)(ws + OFF_SSQQ); e.ssqkv = (float*)(ws + OFF_SSQKV);
        e.out_ckv = (float*)(ws + OFF_KVRAW); e.out_kpe = ybuf + OUT_KPE; e.li = li;
        const bf16_t* W = (const bf16_t*)(ws + OFF_OWIN) + (size_t)li * 1280 * 1024;
        for (int t = bid; t < 48 * 5; t += nb) gemm_tile<256, 2>(abuf, 1024, W, 1024, (t % 48) * 256, (t / 48) * 256, e, smem);
      }
#endif
      xcd_barrier(xb);
#ifndef SKIP_O3
      for (int rep_ = 0; rep_ < REP_O3; ++rep_) {
        unsigned char* ws = uniform_ptr(ws_); float* ybuf = (float*)uniform_ptr(out_); asm volatile("" : "+s"(ws), "+s"(ybuf));
        float* mod = (float*)(ws + OFF_MOD); bf16_t* abuf = (bf16_t*)(ws + OFF_ABUF); bf16_t* cat = (bf16_t*)(ws + OFF_CAT); bf16_t* act = (bf16_t*)(ws + OFF_ACT);
        float* ssq1 = (float*)(ws + OFF_SSQ1); float* ssq2 = (float*)(ws + OFF_SSQ2); const float* modl = mod + (size_t)l * 9 * 6144;
        (void)mod; (void)abuf; (void)cat; (void)act; (void)ssq1; (void)ssq2; (void)modl; (void)ybuf;
        EpiKvUp ek; ek.ssqkv = (const float*)(ws + OFF_SSQKV); ek.gk = p.in[28] + li * 96; ek.kpebuf = (const float*)(ws + OFF_KPE); ek.cache_kpe = p.in[5];
        ek.kpm = (bf16_t*)(ws + OFF_KPM); ek.ksm = (bf16_t*)(ws + OFF_KSM); ek.vtpm = (bf16_t*)(ws + OFF_VTPM); ek.vtsm = (bf16_t*)(ws + OFF_VTSM); ek.li = li; ek.cache = 0;
        EpiQUp eq; eq.ssqq = (const float*)(ws + OFF_SSQQ); eq.gq = p.in[27] + li * 96; eq.qmla = (bf16_t*)(ws + OFF_QMLA);
        const bf16_t* Wkv = (const bf16_t*)(ws + OFF_WKVB) + (size_t)li * 1024 * 256;
        const bf16_t* Wq = (const bf16_t*)(ws + OFF_WQB) + (size_t)li * 1024 * 384;
        const bf16_t* cckv = (const bf16_t*)(ws + OFF_CCKV) + (size_t)li * 2048 * 256;
        for (int j = bid; j < 448 + 384 + 1536 + 512; j += nb) {
          if (j < 448) {
            const int mt = j % 112, nt = j / 112;
            const bool cch = mt >= 96;
            ek.cache = cch ? 1 : 0;
            gemm_tile<128, 2>(cch ? cckv : (const bf16_t*)(ws + OFF_KVLAT), 256, Wkv, 256, (cch ? mt - 96 : mt) * 128, nt * 256, ek, smem);
          } else if (j < 448 + 384) {
            const int jj = j - 448;
            gemm_tile<128, 2>((const bf16_t*)(ws + OFF_QLAT), 384, Wq, 384, (jj % 96) * 128, (jj / 96) * 256, eq, smem);
          } else if (j < 448 + 384 + 1536) job_poolx(p, j - 448 - 384);
          else job_ckvstate(p, j - 448 - 384 - 1536, li);
        }
      }
#endif
      xcd_barrier(xb);
#ifndef SKIP_O4
      for (int rep_ = 0; rep_ < REP_O4; ++rep_) {
        unsigned char* ws = uniform_ptr(ws_); float* ybuf = (float*)uniform_ptr(out_); asm volatile("" : "+s"(ws), "+s"(ybuf));
        float* mod = (float*)(ws + OFF_MOD); bf16_t* abuf = (bf16_t*)(ws + OFF_ABUF); bf16_t* cat = (bf16_t*)(ws + OFF_CAT); bf16_t* act = (bf16_t*)(ws + OFF_ACT);
        float* ssq1 = (float*)(ws + OFF_SSQ1); float* ssq2 = (float*)(ws + OFF_SSQ2); const float* modl = mod + (size_t)l * 9 * 6144;
        (void)mod; (void)abuf; (void)cat; (void)act; (void)ssq1; (void)ssq2; (void)modl; (void)ybuf;
        const bf16_t* qm = (const bf16_t*)(ws + OFF_QMLA);
        const bf16_t* kpm = (const bf16_t*)(ws + OFF_KPM); const bf16_t* ksm = (const bf16_t*)(ws + OFF_KSM);
        const bf16_t* vtpm = (const bf16_t*)(ws + OFF_VTPM); const bf16_t* vtsm = (const bf16_t*)(ws + OFF_VTSM);
        const float sc = 0.10206207261596575f;
        for (int j = bid; j < 256 + 128; j += nb) {
          if (j < 256) {
            const int qb2 = j & 3, hd = (j >> 2) & 7, b = j >> 5;
            const int tok0 = TP + b * 1024 + qb2 * 256;
            attn_task<96>(qm + (size_t)tok0 * 768 + hd * 96, 768,
                          ksm + ((size_t)(b * 8 + hd) * 1280) * 96, 96, vtsm + ((size_t)(b * 8 + hd) * 64) * 1280, 1280, 20,
                          ksm, 96, vtsm, 1280, 0, false, 0, 0, p.in[18],
                          cat + (size_t)tok0 * 1024 + 512 + hd * 64, 1024, sc, smem);
          } else if (j < 384) {
            const int jj = j - 256, hd = jj & 7, b = jj >> 3;
            const int tok0 = b * 256;
            attn_task<96>(qm + (size_t)tok0 * 768 + hd * 96, 768,
                          kpm + ((size_t)(b * 8 + hd) * 256) * 96, 96, vtpm + ((size_t)(b * 8 + hd) * 64) * 256, 256, 4,
                          kpm, 96, vtpm, 256, 0, false, 0, 0, p.in[18],
                          cat + (size_t)tok0 * 1024 + 512 + hd * 64, 1024, sc, smem);
          }
        }
      }
#endif
      xcd_barrier(xb);
#ifndef SKIP_O5
      {
        unsigned char* ws = uniform_ptr(ws_); float* ybuf = (float*)uniform_ptr(out_); asm volatile("" : "+s"(ws), "+s"(ybuf));
        float* mod = (float*)(ws + OFF_MOD); bf16_t* abuf = (bf16_t*)(ws + OFF_ABUF); bf16_t* cat = (bf16_t*)(ws + OFF_CAT); bf16_t* act = (bf16_t*)(ws + OFF_ACT);
        float* ssq1 = (float*)(ws + OFF_SSQ1); float* ssq2 = (float*)(ws + OFF_SSQ2); const float* modl = mod + (size_t)l * 9 * 6144;
        (void)mod; (void)abuf; (void)cat; (void)act; (void)ssq1; (void)ssq2; (void)modl; (void)ybuf;
        EpiResid e; e.gscale = 1.f; e.y = ybuf; e.gate = modl + 2048; e.ng = p.in[11] + l * 1024; e.nsc = modl + 4096; e.abuf = abuf; e.ssq_out = ssq2;
        const bf16_t* W = (const bf16_t*)(ws + OFF_OWOUT) + (size_t)li * 1024 * 1024;
#if PROBE_RESID
        e.gscale = 0.f;
        for (int t = bid; t < 64 * 4; t += nb) gemm_tile<192, 4>(cat, 1024, W, 1024, (t % 64) * 192, (t / 64) * 256, e, smem);
        e.gscale = 1.f; __syncthreads();
#endif
        for (int t = bid; t < 64 * 4; t += nb) gemm_tile<192, 4>(cat, 1024, W, 1024, (t % 64) * 192, (t / 64) * 256, e, smem);
      }
#endif
      xcd_barrier(xb);
    }
#ifndef SKIP_M1
    {
        unsigned char* ws = uniform_ptr(ws_); float* ybuf = (float*)uniform_ptr(out_); asm volatile("" : "+s"(ws), "+s"(ybuf));
        float* mod = (float*)(ws + OFF_MOD); bf16_t* abuf = (bf16_t*)(ws + OFF_ABUF); bf16_t* cat = (bf16_t*)(ws + OFF_CAT); bf16_t* act = (bf16_t*)(ws + OFF_ACT);
        float* ssq1 = (float*)(ws + OFF_SSQ1); float* ssq2 = (float*)(ws + OFF_SSQ2); const float* modl = mod + (size_t)l * 9 * 6144;
        (void)mod; (void)abuf; (void)cat; (void)act; (void)ssq1; (void)ssq2; (void)modl; (void)ybuf;
      EpiMlp1 e; e.ssq = ssq2; e.shw = (const float*)(ws + OFF_SHW2) + (size_t)l * 9 * 4096; e.act = act;
      const bf16_t* W = (const bf16_t*)(ws + OFF_W1T) + (size_t)l * 4096 * 1024;
#if PROBE_M1 == 1
      for (int t = bid; t < 48 * 16; t += nb) gemm_tile<256, 2>(abuf, 1024, W, 1024, (t % 48) * 256, (t / 48) * 256, e, smem);
#elif PROBE_M1 == 2
      for (int t = bid; t < 48 * 16; t += nb) gemm_tile<256, 2, true>(abuf, 1024, W, 1024, (t % 48) * 256, (t / 48) * 256, e, smem);
#endif
      for (int t = bid; t < 48 * 16; t += nb) gemm_tile<256, 2>(abuf, 1024, W, 1024, (t % 48) * 256, (t / 48) * 256, e, smem);
    }
#endif
    xcd_barrier(xb);
#ifndef SKIP_M2
    {
        unsigned char* ws = uniform_ptr(ws_); float* ybuf = (float*)uniform_ptr(out_); asm volatile("" : "+s"(ws), "+s"(ybuf));
        float* mod = (float*)(ws + OFF_MOD); bf16_t* abuf = (bf16_t*)(ws + OFF_ABUF); bf16_t* cat = (bf16_t*)(ws + OFF_CAT); bf16_t* act = (bf16_t*)(ws + OFF_ACT);
        float* ssq1 = (float*)(ws + OFF_SSQ1); float* ssq2 = (float*)(ws + OFF_SSQ2); const float* modl = mod + (size_t)l * 9 * 6144;
        (void)mod; (void)abuf; (void)cat; (void)act; (void)ssq1; (void)ssq2; (void)modl; (void)ybuf;
      EpiResid e; e.gscale = 1.f; e.y = ybuf; e.gate = modl + 5120;
      if (l < 3) { e.ng = p.in[10] + (l + 1) * 1024; e.nsc = mod + (size_t)(l + 1) * 9 * 6144 + 1024; } else { e.ng = nullptr; e.nsc = nullptr; }
      e.abuf = abuf; e.ssq_out = ssq1;
      const bf16_t* W = (const bf16_t*)(ws + OFF_W2T) + (size_t)l * 1024 * 4096;
#if PROBE_M2
      e.gscale = 0.f;
      for (int t = bid; t < 64 * 4; t += nb) gemm_tile<192, 4>(act, 4096, W, 4096, (t % 64) * 192, (t / 64) * 256, e, smem);
      e.gscale = 1.f; __syncthreads();
#endif
      for (int t = bid; t < 64 * 4; t += nb) gemm_tile<192, 4>(act, 4096, W, 4096, (t % 64) * 192, (t / 64) * 256, e, smem);
    }
#endif
    if (l < 3) xcd_barrier(xb);
  }
}

static void add_mat(Params& p, int& idx, int& tiles, const float* src, const float* rscale, size_t dst, int K, int N, int Npad, int headpad, int blockdiag) {
  MatDesc& m = p.mats[idx++];
  m.src = src; m.rscale = rscale; m.dst = dst; m.K = K; m.N = N; m.Npad = Npad; m.headpad = headpad; m.tile0 = tiles; m.blockdiag = blockdiag;
  tiles += (K / 128) * (Npad / 64);
}

extern "C" void kernel_launch(void* const* d_in, const int* in_sizes, int n_in, void* d_out, int out_size, void* d_ws, size_t ws_size, hipStream_t stream) {
  if (ws_size < WS_NEED) { fprintf(stderr, "kernel_launch: workspace too small (%zu < %zu)\n", ws_size, (size_t)WS_NEED); return; }
  static int grid_blocks = 0;
  if (!grid_blocks) {
    int dev = 0, cus = 0, per_cu = 0;
    (void)hipGetDevice(&dev);
    (void)hipDeviceGetAttribute(&cus, hipDeviceAttributeMultiprocessorCount, dev);
    (void)hipOccupancyMaxActiveBlocksPerMultiprocessor(&per_cu, fwd_megakernel, NTHREADS, 0);
    if (per_cu < 1) fprintf(stderr, "kernel_launch: occupancy query reports %d blocks per CU\n", per_cu);
    grid_blocks = cus;
  }
  Params p;
  memset(&p, 0, sizeof(p));
  for (int i = 0; i < 30; ++i) p.in[i] = (const float*)d_in[i];
  p.out = (float*)d_out; p.ws = (unsigned char*)d_ws;
  int idx = 0, tiles = 0;
  for (int i = 0; i < 2; ++i) add_mat(p, idx, tiles, p.in[29] + (size_t)i * 1024 * 1024, nullptr, OFF_OWOUT + (size_t)i * 1024 * 1024 * 2, 1024, 1024, 1024, 0, 2 + i);
  for (int l = 0; l < 4; ++l) add_mat(p, idx, tiles, p.in[12] + (size_t)l * 1024 * 4096, nullptr, OFF_W1T + (size_t)l * 4096 * 1024 * 2, 1024, 4096, 4096, 0, 0);
  for (int l = 0; l < 4; ++l) add_mat(p, idx, tiles, p.in[13] + (size_t)l * 4096 * 1024, nullptr, OFF_W2T + (size_t)l * 4096 * 1024 * 2, 4096, 1024, 1024, 0, 0);
  for (int i = 0; i < 2; ++i) add_mat(p, idx, tiles, p.in[14] + (size_t)i * 1024 * 3072, nullptr, OFF_EWIN + (size_t)i * 3072 * 1024 * 2, 1024, 3072, 3072, 0, 0);
  for (int i = 0; i < 2; ++i) add_mat(p, idx, tiles, p.in[19] + (size_t)i * 1024 * 1024, nullptr, OFF_EWOUT + (size_t)i * 1024 * 1024 * 2, 1024, 1024, 1024, 0, 0);
  for (int i = 0; i < 2; ++i) add_mat(p, idx, tiles, p.in[20] + (size_t)i * 1024 * 1184, nullptr, OFF_OWIN + (size_t)i * 1280 * 1024 * 2, 1024, 1184, 1280, 0, 0);
  for (int i = 0; i < 2; ++i) add_mat(p, idx, tiles, p.in[24] + (size_t)i * 384 * 768, p.in[23] + i * 384, OFF_WQB + (size_t)i * 1024 * 384 * 2, 384, 768, 1024, 1, 0);
  for (int i = 0; i < 2; ++i) add_mat(p, idx, tiles, p.in[26] + (size_t)i * 256 * 1024, p.in[25] + i * 256, OFF_WKVB + (size_t)i * 1024 * 256 * 2, 256, 1024, 1024, 0, 0);
  p.conv_tiles = tiles;
  if (hipMemsetAsync((unsigned char*)d_ws + OFF_BAR, 0, 16384, stream) != hipSuccess) { fprintf(stderr, "kernel_launch: memset of barrier words failed\n"); return; }
  void* args[] = {&p};
  hipError_t e = hipLaunchCooperativeKernel((void*)fwd_megakernel, dim3(grid_blocks), dim3(NTHREADS), args, 0, stream);
  if (e != hipSuccess) fprintf(stderr, "cooperative launch failed: %s (grid %d)\n", hipGetErrorString(e), grid_blocks);
}
```

```cpp
#include <hip/hip_runtime.h>
#include <hip/hip_cooperative_groups.h>
#include <cstdio>
#include <cstdint>
#include <cstring>
namespace cg = cooperative_groups;

typedef unsigned short bf16_t;
using bf16x8 = __attribute__((ext_vector_type(8))) short;
using f32x16 = __attribute__((ext_vector_type(16))) float;
typedef __bf16 bf16v2 __attribute__((ext_vector_type(2)));
typedef unsigned u32x4 __attribute__((ext_vector_type(4)));
typedef unsigned u32x2 __attribute__((ext_vector_type(2)));
typedef float f32x4 __attribute__((ext_vector_type(4)));
#define DI __device__ __forceinline__
#define MFMA(a, b, c) __builtin_amdgcn_mfma_f32_32x32x16_bf16((a), (b), (c), 0, 0, 0)
#define CROW(i, h) (((i) & 3) + 8 * ((i) >> 2) + 4 * (h))

#ifndef REP_PH0
#define REP_PH0 1
#endif
#ifndef REP_PH1
#define REP_PH1 1
#endif
#ifndef REP_E2
#define REP_E2 1
#endif
#ifndef REP_E3
#define REP_E3 1
#endif
#ifndef REP_O3
#define REP_O3 1
#endif
#ifndef REP_O4
#define REP_O4 1
#endif
#ifndef REP_M1
#define REP_M1 1
#endif
#ifndef REP_MODS
#define REP_MODS 1
#endif
#ifndef REP_WCONV
#define REP_WCONV 1
#endif
#ifndef REP_CACHE
#define REP_CACHE 1
#endif

#ifndef PROBE_M1
#define PROBE_M1 0
#endif
#ifndef REP_PH0
#define REP_PH0 1
#endif
#ifndef REP_PH1
#define REP_PH1 1
#endif
#ifndef REP_E2
#define REP_E2 1
#endif
#ifndef REP_E3
#define REP_E3 1
#endif
#ifndef REP_O2
#define REP_O2 1
#endif
#ifndef REP_O3
#define REP_O3 1
#endif
#ifndef REP_O4
#define REP_O4 1
#endif
#ifndef PROBE_RESID
#define PROBE_RESID 0
#endif
#ifndef PROBE_M2
#define PROBE_M2 0
#endif
constexpr int T = 12288, TP = 4096;
constexpr float EPS = 1e-6f;
constexpr int NTHREADS = 512;
constexpr int NWAVES = 8;
constexpr int SMEM_BYTES = 147456 + 8192;
constexpr int SIDE_OFF = 147456;

constexpr size_t al(size_t x) { return (x + 255) & ~size_t(255); }
constexpr size_t OFF_BAR   = 0;
constexpr size_t OFF_MOD   = 16384;
constexpr size_t OFF_SHW1  = al(OFF_MOD + 4ull * 9 * 6144 * 4);
constexpr size_t OFF_SHW2  = al(OFF_SHW1 + 4ull * 9 * 3072 * 4);
constexpr size_t OFF_SSQ1  = al(OFF_SHW2 + 4ull * 9 * 4096 * 4);
constexpr size_t OFF_SSQ2  = al(OFF_SSQ1 + 16ull * T * 4);
constexpr size_t OFF_SSQQ  = al(OFF_SSQ2 + 16ull * T * 4);
constexpr size_t OFF_SSQKV = al(OFF_SSQQ + 3ull * T * 4);
constexpr size_t OFF_KPE   = al(OFF_SSQKV + 2ull * T * 4);
constexpr size_t OFF_KVRAW = al(OFF_KPE + (size_t)T * 32 * 4);
constexpr size_t OFF_CNK   = al(OFF_KVRAW + 4096ull * 256 * 4);
constexpr size_t OFF_CNVT  = al(OFF_CNK + 2ull * 2048 * 512 * 2);
constexpr size_t OFF_CCKV  = al(OFF_CNVT + 2ull * 2048 * 512 * 2);
constexpr size_t OFF_W1T   = al(OFF_CCKV + 2ull * 2048 * 256 * 2);
constexpr size_t OFF_W2T   = al(OFF_W1T + 4ull * 4096 * 1024 * 2);
constexpr size_t OFF_EWIN  = al(OFF_W2T + 4ull * 4096 * 1024 * 2);
constexpr size_t OFF_EWOUT = al(OFF_EWIN + 2ull * 3072 * 1024 * 2);
constexpr size_t OFF_OWIN  = al(OFF_EWOUT + 2ull * 1024 * 1024 * 2);
constexpr size_t OFF_WQB   = al(OFF_OWIN + 2ull * 1280 * 1024 * 2);
constexpr size_t OFF_WKVB  = al(OFF_WQB + 2ull * 1024 * 384 * 2);
constexpr size_t OFF_OWOUT = al(OFF_WKVB + 2ull * 1024 * 256 * 2);
constexpr size_t OFF_POOLW = al(OFF_OWOUT + 2ull * 1024 * 1024 * 2);
constexpr size_t OFF_ABUF  = al(OFF_POOLW + 2ull * 512 * 512 * 2);
constexpr size_t OFF_CAT   = al(OFF_ABUF + (size_t)T * 1024 * 2);
constexpr size_t OFF_ACT   = al(OFF_CAT + (size_t)T * 1024 * 2);
constexpr size_t WS_NEED   = al(OFF_ACT + (size_t)T * 4096 * 2);
constexpr size_t OFF_BCONV = OFF_ACT;
constexpr size_t OFF_QBUF  = al(OFF_BCONV + (size_t)T * 1536 * 2);
constexpr size_t OFF_KBUF  = al(OFF_QBUF + (size_t)T * 512 * 2);
constexpr size_t OFF_VTP   = al(OFF_KBUF + (size_t)T * 512 * 2);
constexpr size_t OFF_VTS   = al(OFF_VTP + 16ull * 8 * 64 * 256 * 2);
constexpr size_t OFF_UBUF  = OFF_ACT;
constexpr size_t OFF_QLAT  = al(OFF_UBUF + (size_t)T * 512 * 2);
constexpr size_t OFF_KVLAT = al(OFF_QLAT + (size_t)T * 384 * 2);
constexpr size_t OFF_XP    = al(OFF_KVLAT + (size_t)T * 256 * 2);
constexpr size_t OFF_QMLA  = al(OFF_XP + (size_t)T * 512 * 2);
constexpr size_t OFF_KPM   = al(OFF_QMLA + (size_t)T * 768 * 2);
constexpr size_t OFF_KSM   = al(OFF_KPM + 16ull * 8 * 256 * 96 * 2);
constexpr size_t OFF_VTPM  = al(OFF_KSM + 8ull * 8 * 1280 * 96 * 2);
constexpr size_t OFF_VTSM  = al(OFF_VTPM + 16ull * 8 * 64 * 256 * 2);
static_assert(OFF_VTSM + 8ull * 8 * 64 * 1280 * 2 <= WS_NEED, "odd buffers overflow");
static_assert(OFF_VTS + 8ull * 8 * 64 * 1024 * 2 <= WS_NEED, "even buffers overflow");

constexpr size_t OUT_Y   = 0;
constexpr size_t OUT_NAK = (size_t)T * 1024;
constexpr size_t OUT_NAV = OUT_NAK + 16ull * 2 * 256 * 512;
constexpr size_t OUT_CKV = OUT_NAV + 16ull * 2 * 256 * 512;
constexpr size_t OUT_KPE = OUT_CKV + 16ull * 2 * 256 * 256;

struct MatDesc { const float* src; const float* rscale; unsigned long long dst; int K, N, Npad, headpad, tile0, blockdiag; };
constexpr int NMATS = 20;
struct Params {
  const float* in[30];
  float* out;
  unsigned char* ws;
  MatDesc mats[NMATS];
  int conv_tiles;
  int pad_;
};

__device__ __forceinline__ f32x4 make_f32x4(float a, float b, float c, float d) { f32x4 v = {a, b, c, d}; return v; }
#define GAS __attribute__((address_space(1)))
template <class T> DI void gst(T* p, const T& v) { *(GAS T*)p = v; }
template <class T> DI T gld_nt(const T* p) { return __builtin_nontemporal_load((const GAS T*)p); }
template <class T> DI T gld(const T* p) { return *(const GAS T*)p; }
DI unsigned char* uniform_ptr(const void* p) { const unsigned long long v = (unsigned long long)p; const unsigned lo = __builtin_amdgcn_readfirstlane((unsigned)v), hi = __builtin_amdgcn_readfirstlane((unsigned)(v >> 32)); return (unsigned char*)(((unsigned long long)hi << 32) | lo); }
DI int otid() { int t = threadIdx.x; asm volatile("" : "+v"(t)); return t; }
DI unsigned pack2(float a, float b) { bf16v2 v = {(__bf16)a, (__bf16)b}; return __builtin_bit_cast(unsigned, v); }
DI bf16_t f2bf(float a) { return __builtin_bit_cast(unsigned short, (__bf16)a); }
DI float bf2f(unsigned v16) { return __uint_as_float(v16 << 16); }
DI float bflo(unsigned u) { return __uint_as_float(u << 16); }
DI float bfhi(unsigned u) { return __uint_as_float(u & 0xffff0000u); }
DI int mi_of(int m) { return m < TP ? 0 : 1 + ((m - TP) >> 10); }
DI float xor32(float v) { return __shfl_xor(v, 32, 64); }
DI float hsum32(float v) { const u32x2 r = __builtin_amdgcn_permlane32_swap(__float_as_uint(v), __float_as_uint(v), false, false); return __uint_as_float(r.x) + __uint_as_float(r.y); }
DI float hmax32(float v) { const u32x2 r = __builtin_amdgcn_permlane32_swap(__float_as_uint(v), __float_as_uint(v), false, false); return fmaxf(__uint_as_float(r.x), __uint_as_float(r.y)); }
DI void store_bf4(bf16_t* p, float a, float b, float c, float d) { u32x2 u; u.x = pack2(a, b); u.y = pack2(c, d); *(GAS u32x2*)p = u; }
template <int NP> DI float rstd_parts(const float* ssq, int m, float invn) {
  float v[NP];
#pragma unroll
  for (int p = 0; p < NP; ++p) v[p] = gld(ssq + (size_t)p * T + m);
  float s = 0.f;
#pragma unroll
  for (int p = 0; p < NP; ++p) s += v[p];
  return rsqrtf(s * invn + EPS);
}

#define XB_TMO      128
#define XB_XCNT(j)  (256  + 64 * (j))
#define XB_XSUB(j)  (1280 + 64 * (j))
#define XB_XGEN(j)  (2304 + 64 * (j))
#define XB_TOP      3328
#define XB_TOPGEN   3392
#define XCD_BAR_WORDS 3456
#define XB_SPIN_CAP (1u << 20)
#define LAS __attribute__((address_space(3)))
DI unsigned xb_ld(unsigned* p)              { return __hip_atomic_load(p, __ATOMIC_RELAXED, __HIP_MEMORY_SCOPE_AGENT); }
DI unsigned xb_add(unsigned* p, unsigned v) { return __hip_atomic_fetch_add(p, v, __ATOMIC_RELAXED, __HIP_MEMORY_SCOPE_AGENT); }
DI unsigned xb_xcc_id() { return (unsigned)__builtin_amdgcn_s_getreg((3 << 11) | 20) & 0xFu; }
#define XB_SPIN(cond, bar) do { unsigned _sp = 0; while (cond) { __builtin_amdgcn_s_sleep(1); \
    if ((++_sp & 255u) == 0u) { if (xb_ld(&(bar)[XB_TMO])) break; if (_sp > XB_SPIN_CAP) { atomicAdd(&(bar)[XB_TMO], 1u); break; } } } } while (0)
struct XcdBarrier { unsigned* bar; unsigned x; volatile LAS unsigned* st; };
DI XcdBarrier xcd_barrier_post(unsigned* bar, volatile LAS unsigned* st) {
  XcdBarrier b; b.bar = bar; b.x = xb_xcc_id(); b.st = st;
  if (threadIdx.x == 0) (void)xb_add(&bar[XB_XCNT(b.x)], 1u);
  return b;
}
DI void xcd_barrier_complete(unsigned* bar, unsigned x, unsigned& nloc, unsigned& nx) {
  const unsigned G = gridDim.x * gridDim.y * gridDim.z;
  unsigned sum, cnt, mine, sp = 0u;
  for (;;) {
    sum = 0u; cnt = 0u; mine = 0u;
#pragma unroll
    for (unsigned j = 0; j < 16; ++j) { const unsigned c = xb_ld(&bar[XB_XCNT(j)]); sum += c; cnt += (c > 0u) ? 1u : 0u; mine = (j == x) ? c : mine; }
    if (sum == G) break;
    __builtin_amdgcn_s_sleep(1);
    if ((++sp & 255u) == 0u) { if (xb_ld(&bar[XB_TMO])) break; if (sp > XB_SPIN_CAP) { atomicAdd(&bar[XB_TMO], 1u); break; } }
  }
  nloc = mine > 0u ? mine : 1u; nx = cnt > 0u ? cnt : 1u;
}
DI void xcd_barrier(const XcdBarrier& b) {
  asm volatile("s_waitcnt vmcnt(0)" ::: "memory");
  __syncthreads();
  if (threadIdx.x == 0) {
    unsigned* bar = b.bar;
    __builtin_amdgcn_s_waitcnt(0);
    unsigned nloc = b.st[0], nx = b.st[1];
    if (nloc == 0u) { xcd_barrier_complete(bar, b.x, nloc, nx); b.st[0] = nloc; b.st[1] = nx; }
    const unsigned old = xb_add(&bar[XB_XSUB(b.x)], 1u);
    const unsigned gen = old / nloc;
    if (old + 1u == (gen + 1u) * nloc) {
      __builtin_amdgcn_fence(__ATOMIC_RELEASE, "agent");
      asm volatile("s_waitcnt vmcnt(0)" ::: "memory");
      const unsigned og = xb_add(&bar[XB_TOP], 1u);
      const unsigned tg = og / nx;
      if (og + 1u == (tg + 1u) * nx) xb_add(&bar[XB_TOPGEN], 1u);
      else XB_SPIN(xb_ld(&bar[XB_TOPGEN]) == tg, bar);
      __builtin_amdgcn_fence(__ATOMIC_ACQUIRE, "agent");
      xb_add(&bar[XB_XGEN(b.x)], 1u);
      asm volatile("s_waitcnt vmcnt(0)" ::: "memory");
    } else {
      XB_SPIN(xb_ld(&bar[XB_XGEN(b.x)]) == gen, bar);
      __builtin_amdgcn_fence(__ATOMIC_ACQUIRE, "agent");
      asm volatile("s_waitcnt vmcnt(0)" ::: "memory");
    }
  }
  __syncthreads();
}

typedef __attribute__((address_space(3))) unsigned lds_u32_t;
template <int OFF> DI bf16x8 lds_rd128(unsigned addr) { bf16x8 v; asm volatile("ds_read_b128 %0, %1 offset:%2" : "=v"(v) : "v"(addr), "n"(OFF) : "memory"); return v; }
template <int N, int NW, int NA> DI void lgkm_wait(bf16x8 (&wf)[NW], bf16x8 (&af)[NA]) {
  if constexpr (NW == 4 && NA == 2) asm volatile("s_waitcnt lgkmcnt(%6)" : "+v"(wf[0]), "+v"(wf[1]), "+v"(wf[2]), "+v"(wf[3]), "+v"(af[0]), "+v"(af[1]) : "n"(N) : "memory");
  else if constexpr (NW == 2 && NA == 3) asm volatile("s_waitcnt lgkmcnt(%5)" : "+v"(wf[0]), "+v"(wf[1]), "+v"(af[0]), "+v"(af[1]), "+v"(af[2]) : "n"(N) : "memory");
  else asm volatile("s_waitcnt lgkmcnt(%5)" : "+v"(wf[0]), "+v"(wf[1]), "+v"(wf[2]), "+v"(wf[3]), "+v"(af[0]) : "n"(N) : "memory");
}
template <int TM, int WNW, bool DRY = false, class Epi>
DI void gemm_tile(const bf16_t* __restrict__ A, int lda, const bf16_t* __restrict__ W, int K, int m0, int n0, const Epi& epi, unsigned char* smem) {
  constexpr int WMW = 8 / WNW, NT = 256 / WNW / 32, MT = TM / WMW / 32, NLA = TM / 64, WAVE_N = 256 / WNW, WAVE_M = TM / WMW;
  constexpr int STAGE = (TM + 256) * 128;
  static_assert((NT == 4 && MT == 2) || (NT == 2 && MT == 3) || (NT == 4 && MT == 1), "fragment wait helper covers these shapes");
  const int tid = otid(), lane = tid & 63, w = tid >> 6, r = lane & 31, h = lane >> 5;
  const int wn = w % WNW, wm = w / WNW;
  f32x16 acc[NT][MT];
#pragma unroll
  for (int a = 0; a < NT; ++a)
#pragma unroll
    for (int b = 0; b < MT; ++b)
#pragma unroll
      for (int i = 0; i < 16; ++i) acc[a][b][i] = 0.f;
  const int KT = K >> 6;
  const int lrow = tid >> 3, lkc = (tid & 7) ^ ((tid >> 4) & 7);
  typedef const __attribute__((address_space(1))) unsigned* gsrc_t;
  const bf16_t* ga = A + (size_t)(m0 + lrow) * lda + lkc * 8;
  const bf16_t* gw = W + (size_t)(n0 + lrow) * K + lkc * 8;
#define DMA_TILE(KT_, ST_) do { \
    unsigned char* sa_ = smem + (ST_) * STAGE + tid * 16; \
    _Pragma("unroll") for (int i = 0; i < NLA; ++i) \
      __builtin_amdgcn_global_load_lds((gsrc_t)(ga + (size_t)(64 * i) * lda + (KT_) * 64), (lds_u32_t*)(sa_ + i * 8192), 16, 0, 0); \
    _Pragma("unroll") for (int i = 0; i < 4; ++i) \
      __builtin_amdgcn_global_load_lds((gsrc_t)(gw + (size_t)(64 * i) * K + (KT_) * 64), (lds_u32_t*)(sa_ + TM * 128 + i * 8192), 16, 0, 0); } while (0)
  __syncthreads();
  epi.side(n0, m0, tid, smem + SIDE_OFF);
  DMA_TILE(0, 0);
  const int swz = (r >> 1) & 7;
  const unsigned lbase = (unsigned)(size_t)smem;
  const unsigned offw = lbase + TM * 128 + (wn * WAVE_N + r) * 128, offa = lbase + (wm * WAVE_M + r) * 128;
  unsigned cx[4];
#pragma unroll
  for (int ks = 0; ks < 4; ++ks) cx[ks] = ((2 * ks + h) ^ swz) << 4;
#define FRAGS(BUF, KS_) do { \
    wf[BUF][0] = lds_rd128<0>(pw + cx[KS_]); wf[BUF][1] = lds_rd128<4096>(pw + cx[KS_]); \
    if constexpr (NT == 4) { wf[BUF][2] = lds_rd128<8192>(pw + cx[KS_]); wf[BUF][3] = lds_rd128<12288>(pw + cx[KS_]); } \
    af[BUF][0] = lds_rd128<0>(pa + cx[KS_]); \
    if constexpr (MT >= 2) af[BUF][1] = lds_rd128<4096>(pa + cx[KS_]); \
    if constexpr (MT >= 3) af[BUF][2] = lds_rd128<8192>(pa + cx[KS_]); } while (0)
#define MMAS(BUF) do { _Pragma("unroll") for (int a = 0; a < NT; ++a) _Pragma("unroll") for (int b = 0; b < MT; ++b) acc[a][b] = MFMA(wf[BUF][a], af[BUF][b], acc[a][b]); } while (0)
  for (int kt = 0; kt < KT; ++kt) {
    asm volatile("s_waitcnt vmcnt(0)" ::: "memory");
    __syncthreads();
    if (kt + 1 < KT) DMA_TILE(kt + 1, (kt + 1) & 1);
    __builtin_amdgcn_sched_barrier(0);
    const unsigned pw = offw + (kt & 1) * STAGE, pa = offa + (kt & 1) * STAGE;
    bf16x8 wf[2][NT], af[2][MT];
    FRAGS(0, 0);
    FRAGS(1, 1);
    lgkm_wait<NT + MT>(wf[0], af[0]);
    MMAS(0);
    __builtin_amdgcn_sched_barrier(0);
    FRAGS(0, 2);
    lgkm_wait<NT + MT>(wf[1], af[1]);
    MMAS(1);
    __builtin_amdgcn_sched_barrier(0);
    FRAGS(1, 3);
    lgkm_wait<NT + MT>(wf[0], af[0]);
    MMAS(0);
    __builtin_amdgcn_sched_barrier(0);
    lgkm_wait<0>(wf[1], af[1]);
    MMAS(1);
    __builtin_amdgcn_sched_barrier(0);
  }
#undef DMA_TILE
#undef FRAGS
#undef MMAS
  if (DRY) {
    float sdry = 0.f;
#pragma unroll
    for (int a = 0; a < NT; ++a)
#pragma unroll
      for (int b = 0; b < MT; ++b)
#pragma unroll
        for (int i = 0; i < 16; ++i) sdry += acc[a][b][i];
    if (sdry != 12345.678f) return;
  }
  __syncthreads();
  epi(acc, n0 + wn * WAVE_N, m0 + wm * WAVE_M, lane, smem + w * 9216, smem + SIDE_OFF, n0, m0);
}

struct EpiEvenIn {
  const float* ssq; const float* shw; const float* gq; const float* gk;
  bf16_t* bconv; bf16_t* qbuf; bf16_t* kbuf; bf16_t* vtp; bf16_t* vts; float* out_k; float* out_v; int li;
  DI void side(int n0, int m0, int tid, unsigned char* sd) const {
    float* f = (float*)sd;
    if (tid < 192) f[tid] = rstd_parts<16>(ssq, m0 + tid, 1.f / 1024.f);
    const int mi = mi_of(tid < 256 ? m0 : m0 + 191);
    f[192 + tid] = gld(shw + mi * 3072 + n0 + (tid & 255));
  }
  template <int MT> DI void operator()(f32x16 (&acc)[2][MT], int nb, int mb, int lane, unsigned char* wlds, const unsigned char* side, int n0, int m0) const {
    const int r = lane & 31, h = lane >> 5;
    const int region = nb >> 9;
#pragma unroll
    for (int mt = 0; mt < MT; ++mt) {
      const int m = mb + mt * 32 + r;
      const float* sf = (const float*)side;
      const float rs = sf[m - m0];
      const float* sw = sf + 192 + (mi_of(m) != mi_of(m0) ? 256 : 0) + (nb - n0);
      float ss = 0.f;
#pragma unroll
      for (int nt = 0; nt < 2; ++nt)
#pragma unroll
        for (int g = 0; g < 4; ++g) {
          const f32x4 s4 = *(const f32x4*)(sw + nt * 32 + 8 * g + 4 * h);
          acc[nt][mt][4 * g + 0] = rs * acc[nt][mt][4 * g + 0] + s4.x;
          acc[nt][mt][4 * g + 1] = rs * acc[nt][mt][4 * g + 1] + s4.y;
          acc[nt][mt][4 * g + 2] = rs * acc[nt][mt][4 * g + 2] + s4.z;
          acc[nt][mt][4 * g + 3] = rs * acc[nt][mt][4 * g + 3] + s4.w;
#pragma unroll
          for (int j = 0; j < 4; ++j) ss += acc[nt][mt][4 * g + j] * acc[nt][mt][4 * g + j];
        }
      if (region < 3) {
#pragma unroll
        for (int nt = 0; nt < 2; ++nt)
#pragma unroll
          for (int g = 0; g < 4; ++g)
            store_bf4(bconv + (size_t)m * 1536 + nb + nt * 32 + 8 * g + 4 * h, acc[nt][mt][4 * g], acc[nt][mt][4 * g + 1], acc[nt][mt][4 * g + 2], acc[nt][mt][4 * g + 3]);
      } else if (region < 5) {
        const bool isk = region == 4;
        const float* gain = isk ? gk : gq;
        bf16_t* dst = (isk ? kbuf : qbuf) + (size_t)m * 512 + (nb - (isk ? 2048 : 1536));
        float* od = nullptr;
        if (isk && m < TP) od = out_k + ((size_t)(((m >> 8) * 2 + li) * 256 + (m & 255))) * 512 + (nb - 2048);
        ss = hsum32(ss);
        const float rn = rsqrtf(ss * (1.f / 64.f) + EPS);
#pragma unroll
        for (int nt = 0; nt < 2; ++nt)
#pragma unroll
          for (int g = 0; g < 4; ++g) {
            const int d = nt * 32 + 8 * g + 4 * h;
            const f32x4 g4 = gld((const f32x4*)(gain + d));
            const float o0 = acc[nt][mt][4 * g] * rn * g4.x, o1 = acc[nt][mt][4 * g + 1] * rn * g4.y, o2 = acc[nt][mt][4 * g + 2] * rn * g4.z, o3 = acc[nt][mt][4 * g + 3] * rn * g4.w;
            store_bf4(dst + d, o0, o1, o2, o3);
            if (od) *(GAS f32x4*)(od + d) = make_f32x4(o0, o1, o2, o3);
          }
      } else {
        const bool pr = m < TP;
        const int s = m - TP;
        const int hd = (nb - 2560) >> 6;
        float* od = pr ? out_v + ((size_t)(((m >> 8) * 2 + li) * 256 + (m & 255))) * 512 + (nb - 2560) : nullptr;
        bf16_t* vt0 = pr ? vtp + ((size_t)((m >> 8) * 8 + hd) * 64) * 256 + (m & 255) : vts + ((size_t)((s >> 10) * 8 + hd) * 64) * 1024 + (s & 1023);
        const int st = pr ? 256 : 1024;
#pragma unroll
        for (int nt = 0; nt < 2; ++nt)
#pragma unroll
          for (int g = 0; g < 4; ++g) {
            const int d = nt * 32 + 8 * g + 4 * h;
#pragma unroll
            for (int j = 0; j < 4; ++j) gst(vt0 + (size_t)(d + j) * st, f2bf(acc[nt][mt][4 * g + j]));
            if (pr) *(GAS f32x4*)(od + d) = make_f32x4(acc[nt][mt][4 * g], acc[nt][mt][4 * g + 1], acc[nt][mt][4 * g + 2], acc[nt][mt][4 * g + 3]);
          }
      }
    }
  }
};

struct EpiResid {
  float* y; const float* gate; const float* ng; const float* nsc; bf16_t* abuf; float* ssq_out; float gscale;
  DI void side(int n0, int m0, int tid, unsigned char* sd) const {
    float* f = (float*)sd;
    const int mi = mi_of(tid < 256 ? m0 : m0 + 191), n = n0 + (tid & 255);
    f[tid] = gld(gate + mi * 6144 + n) * gscale;
    f[512 + tid] = ng ? gld(ng + n) * (1.f + gld(nsc + mi * 6144 + n)) : 0.f;
  }
  template <int MT> DI void operator()(f32x16 (&acc)[2][MT], int nb, int mb, int lane, unsigned char* wlds, const unsigned char* side, int n0, int m0) const {
    const int r = lane & 31, h = lane >> 5, cc = lane & 15, rq = lane >> 4;
    const int mi0 = mi_of(m0);
#pragma unroll
    for (int mt = 0; mt < MT; ++mt) {
#pragma unroll
      for (int nt = 0; nt < 2; ++nt)
#pragma unroll
        for (int g = 0; g < 4; ++g)
          *(f32x4*)(wlds + r * 272 + (nt * 32 + 8 * g + 4 * h) * 4) = make_f32x4(acc[nt][mt][4 * g], acc[nt][mt][4 * g + 1], acc[nt][mt][4 * g + 2], acc[nt][mt][4 * g + 3]);
#pragma unroll
      for (int i = 0; i < 8; ++i) {
        const int row = rq + 4 * i;
        const int m = mb + mt * 32 + row, n = nb + cc * 4;
        const float* sf = (const float*)side + (mi_of(m) != mi0 ? 256 : 0) + (n - n0);
        const f32x4 a = *(const f32x4*)(wlds + row * 272 + cc * 16);
        f32x4 yo = gld((const f32x4*)(y + (size_t)m * 1024 + n));
        const f32x4 gt = *(const f32x4*)sf;
        yo.x += gt.x * a.x; yo.y += gt.y * a.y; yo.z += gt.z * a.z; yo.w += gt.w * a.w;
        *(GAS f32x4*)(y + (size_t)m * 1024 + n) = yo;
        if (ng) {
          const f32x4 gg = *(const f32x4*)(sf + 512);
          store_bf4(abuf + (size_t)m * 1024 + n, yo.x * gg.x, yo.y * gg.y, yo.z * gg.z, yo.w * gg.w);
          float ss = yo.x * yo.x + yo.y * yo.y + yo.z * yo.z + yo.w * yo.w;
          ss += __shfl_xor(ss, 1, 64); ss += __shfl_xor(ss, 2, 64); ss += __shfl_xor(ss, 4, 64); ss += __shfl_xor(ss, 8, 64);
          if (cc == 0) gst(ssq_out + (size_t)(nb >> 6) * T + m, ss);
        }
      }
    }
  }
};

struct EpiMlp1 {
  const float* ssq; const float* shw; bf16_t* act;
  DI void side(int n0, int m0, int tid, unsigned char* sd) const {
    float* f = (float*)sd;
    if (tid < 256) f[tid] = rstd_parts<16>(ssq, m0 + tid, 1.f / 1024.f);
    else f[tid] = gld(shw + mi_of(m0) * 4096 + n0 + (tid - 256));
  }
  template <int NT, int MT> DI void operator()(f32x16 (&acc)[NT][MT], int nb, int mb, int lane, unsigned char* wlds, const unsigned char* side, int n0, int m0) const {
    const int r = lane & 31, h = lane >> 5;
    constexpr int RS = NT * 64 + 16;
    constexpr int CPR = NT * 4;
#pragma unroll
    for (int mt = 0; mt < MT; ++mt) {
      const float* sf = (const float*)side;
      const float rs = sf[mb - m0 + mt * 32 + r];
#pragma unroll
      for (int nt = 0; nt < NT; ++nt)
#pragma unroll
        for (int g = 0; g < 4; ++g) {
          const int nl = nt * 32 + 8 * g + 4 * h;
          const f32x4 s4 = *(const f32x4*)(sf + 256 + (nb - n0) + nl);
          float v0 = fmaxf(rs * acc[nt][mt][4 * g] + s4.x, 0.f), v1 = fmaxf(rs * acc[nt][mt][4 * g + 1] + s4.y, 0.f);
          float v2 = fmaxf(rs * acc[nt][mt][4 * g + 2] + s4.z, 0.f), v3 = fmaxf(rs * acc[nt][mt][4 * g + 3] + s4.w, 0.f);
          u32x2 u; u.x = pack2(v0 * v0, v1 * v1); u.y = pack2(v2 * v2, v3 * v3);
          *(u32x2*)(wlds + r * RS + nl * 2) = u;
        }
#pragma unroll
      for (int i = 0; i < 32 * CPR / 64; ++i) {
        const int c = lane + 64 * i, row = c / CPR, cc = c % CPR;
        const u32x4 v = *(const u32x4*)(wlds + row * RS + cc * 16);
        *(GAS u32x4*)(act + (size_t)(mb + mt * 32 + row) * 4096 + nb + cc * 8) = v;
      }
    }
  }
};

struct EpiOddIn {
  const float* ssq; const float* shw; bf16_t* ubuf; bf16_t* qlat; bf16_t* kvlat; float* kpebuf; float* ssqq; float* ssqkv; float* out_ckv; float* out_kpe; int li;
  DI void side(int n0, int m0, int tid, unsigned char* sd) const {
    float* f = (float*)sd;
    if (tid < 256) f[tid] = rstd_parts<16>(ssq, m0 + tid, 1.f / 1024.f);
    else f[tid] = gld(shw + mi_of(m0) * 3072 + n0 + (tid - 256));
  }
  template <int MT> DI void operator()(f32x16 (&acc)[4][MT], int nb, int mb, int lane, unsigned char* wlds, const unsigned char* side, int n0, int m0) const {
    const int r = lane & 31, h = lane >> 5;
#pragma unroll
    for (int mt = 0; mt < MT; ++mt) {
      __builtin_amdgcn_sched_barrier(0);
      const int m = mb + mt * 32 + r;
      const float* sf = (const float*)side;
      const float rs = sf[m - m0];
      const float* sw = sf + 256 + (nb - n0);
      float ss = 0.f;
#pragma unroll
      for (int nt = 0; nt < 4; ++nt)
#pragma unroll
        for (int g = 0; g < 4; ++g) {
          const f32x4 s4 = *(const f32x4*)(sw + nt * 32 + 8 * g + 4 * h);
          acc[nt][mt][4 * g + 0] = rs * acc[nt][mt][4 * g + 0] + s4.x;
          acc[nt][mt][4 * g + 1] = rs * acc[nt][mt][4 * g + 1] + s4.y;
          acc[nt][mt][4 * g + 2] = rs * acc[nt][mt][4 * g + 2] + s4.z;
          acc[nt][mt][4 * g + 3] = rs * acc[nt][mt][4 * g + 3] + s4.w;
#pragma unroll
          for (int j = 0; j < 4; ++j) ss += acc[nt][mt][4 * g + j] * acc[nt][mt][4 * g + j];
        }
      ss = hsum32(ss);
      const size_t prow = (size_t)(((m >> 8) * 2 + li) * 256 + (m & 255));
      if (nb < 512) {
#pragma unroll
        for (int nt = 0; nt < 4; ++nt)
#pragma unroll
          for (int g = 0; g < 4; ++g)
            store_bf4(ubuf + (size_t)m * 512 + nb + nt * 32 + 8 * g + 4 * h, acc[nt][mt][4 * g], acc[nt][mt][4 * g + 1], acc[nt][mt][4 * g + 2], acc[nt][mt][4 * g + 3]);
      } else if (nb < 896) {
#pragma unroll
        for (int nt = 0; nt < 4; ++nt)
#pragma unroll
          for (int g = 0; g < 4; ++g)
            store_bf4(qlat + (size_t)m * 384 + (nb - 512) + nt * 32 + 8 * g + 4 * h, acc[nt][mt][4 * g], acc[nt][mt][4 * g + 1], acc[nt][mt][4 * g + 2], acc[nt][mt][4 * g + 3]);
        if (h == 0) gst(ssqq + (size_t)((nb - 512) >> 7) * T + m, ss);
      } else if (nb < 1152) {
#pragma unroll
        for (int nt = 0; nt < 4; ++nt)
#pragma unroll
          for (int g = 0; g < 4; ++g) {
            const int c = (nb - 896) + nt * 32 + 8 * g + 4 * h;
            store_bf4(kvlat + (size_t)m * 256 + c, acc[nt][mt][4 * g], acc[nt][mt][4 * g + 1], acc[nt][mt][4 * g + 2], acc[nt][mt][4 * g + 3]);
            if (m < TP) *(GAS f32x4*)(out_ckv + (size_t)m * 256 + c) = make_f32x4(acc[nt][mt][4 * g], acc[nt][mt][4 * g + 1], acc[nt][mt][4 * g + 2], acc[nt][mt][4 * g + 3]);
          }
        if (h == 0) gst(ssqkv + (size_t)((nb - 896) >> 7) * T + m, ss);
      } else {
#pragma unroll
        for (int g = 0; g < 4; ++g) {
          const int c = 8 * g + 4 * h;
          const f32x4 v = make_f32x4(acc[0][mt][4 * g], acc[0][mt][4 * g + 1], acc[0][mt][4 * g + 2], acc[0][mt][4 * g + 3]);
          *(GAS f32x4*)(kpebuf + (size_t)m * 32 + c) = v;
          if (m < TP) *(GAS f32x4*)(out_kpe + prow * 32 + c) = v;
        }
      }
    }
  }
};

DI void rope_cs(int j8, float posv, float& c, float& s) {
  const float inv = __builtin_amdgcn_exp2f(-1.6609640474436813f * (float)j8);
  const float ang = posv * inv;
  c = __cosf(ang); s = __sinf(ang);
}

struct EpiQUp {
  DI void side(int, int, int, unsigned char*) const {}
  const float* ssqq; const float* gq; bf16_t* qmla;
  template <int MT> DI void operator()(f32x16 (&acc)[4][MT], int nb, int mb, int lane, unsigned char* wlds, const unsigned char* side, int n0, int m0) const {
   const int r = lane & 31, h = lane >> 5, hd = nb >> 7;
#pragma unroll
   for (int mt = 0; mt < MT; ++mt) {
    __builtin_amdgcn_sched_barrier(0);
    const int m = mb + mt * 32 + r;
    const float rq = rstd_parts<3>(ssqq, m, 1.f / 384.f);
    float ss = 0.f;
#pragma unroll
    for (int nt = 0; nt < 3; ++nt)
#pragma unroll
      for (int i = 0; i < 16; ++i) { acc[nt][mt][i] *= rq; ss += acc[nt][mt][i] * acc[nt][mt][i]; }
    ss = hsum32(ss);
    const float rn = rsqrtf(ss * (1.f / 96.f) + EPS);
#pragma unroll
    for (int nt = 0; nt < 3; ++nt)
#pragma unroll
      for (int g = 0; g < 4; ++g) {
        const f32x4 g4 = gld((const f32x4*)(gq + nt * 32 + 8 * g + 4 * h));
        acc[nt][mt][4 * g] *= rn * g4.x; acc[nt][mt][4 * g + 1] *= rn * g4.y; acc[nt][mt][4 * g + 2] *= rn * g4.z; acc[nt][mt][4 * g + 3] *= rn * g4.w;
      }
    if (m >= TP) {
      const int pos = (m - TP) & 1023;
      const float prow = (float)(pos >> 6), pcol = (float)(pos & 63);
#pragma unroll
      for (int g = 0; g < 2; ++g)
#pragma unroll
        for (int j = 0; j < 4; ++j) {
          float c, s; rope_cs(4 * h + j, g == 0 ? prow : pcol, c, s);
          const float x1 = acc[2][mt][4 * g + j], x2 = acc[2][mt][8 + 4 * g + j];
          acc[2][mt][4 * g + j] = x1 * c - x2 * s;
          acc[2][mt][8 + 4 * g + j] = x2 * c + x1 * s;
        }
    }
#pragma unroll
    for (int nt = 0; nt < 3; ++nt)
#pragma unroll
      for (int g = 0; g < 4; ++g)
        store_bf4(qmla + (size_t)m * 768 + hd * 96 + nt * 32 + 8 * g + 4 * h, acc[nt][mt][4 * g], acc[nt][mt][4 * g + 1], acc[nt][mt][4 * g + 2], acc[nt][mt][4 * g + 3]);
   }
  }
};

struct EpiKvUp {
  DI void side(int, int, int, unsigned char*) const {}
  const float* ssqkv; const float* gk; const float* kpebuf; const float* cache_kpe; bf16_t* kpm; bf16_t* ksm; bf16_t* vtpm; bf16_t* vtsm; int li; int cache;
  template <int MT> DI void operator()(f32x16 (&acc)[4][MT], int nb, int mb, int lane, unsigned char* wlds, const unsigned char* side, int n0, int m0) const {
   const int r = lane & 31, h = lane >> 5, hd = nb >> 7;
#pragma unroll
   for (int mt = 0; mt < MT; ++mt) {
    __builtin_amdgcn_sched_barrier(0);
    const int m = mb + mt * 32 + r;
    float rs = 1.f;
    const float* kp;
    bf16_t* kdst; bf16_t* vdst; int vst; bool rope = false; int pos = 0;
    if (cache) {
      const int b = m >> 8, p = m & 255;
      kp = cache_kpe + ((size_t)((b * 2 + li) * 256 + p)) * 32;
      kdst = ksm + ((size_t)(b * 8 + hd) * 1280 + p) * 96;
      vdst = vtsm + ((size_t)(b * 8 + hd) * 64) * 1280 + p; vst = 1280;
    } else {
      rs = rstd_parts<2>(ssqkv, m, 1.f / 256.f);
      kp = kpebuf + (size_t)m * 32;
      if (m < TP) {
        const int b = m >> 8, p = m & 255;
        kdst = kpm + ((size_t)(b * 8 + hd) * 256 + p) * 96;
        vdst = vtpm + ((size_t)(b * 8 + hd) * 64) * 256 + p; vst = 256;
      } else {
        const int s = m - TP, b = s >> 10; pos = s & 1023; rope = true;
        kdst = ksm + ((size_t)(b * 8 + hd) * 1280 + 256 + pos) * 96;
        vdst = vtsm + ((size_t)(b * 8 + hd) * 64) * 1280 + 256 + pos; vst = 1280;
      }
    }
    float ss = 0.f;
#pragma unroll
    for (int nt = 0; nt < 4; ++nt)
#pragma unroll
      for (int i = 0; i < 16; ++i) { acc[nt][mt][i] *= rs; if (nt < 2) ss += acc[nt][mt][i] * acc[nt][mt][i]; }
    ss = hsum32(ss);
    const f32x4 a0 = gld((const f32x4*)(kp + 8 * h)), a1 = gld((const f32x4*)(kp + 8 * h + 4));
    const f32x4 b0 = gld((const f32x4*)(kp + 16 + 8 * h)), b1 = gld((const f32x4*)(kp + 16 + 8 * h + 4));
    float x1[8] = {a0.x, a0.y, a0.z, a0.w, a1.x, a1.y, a1.z, a1.w};
    float x2[8] = {b0.x, b0.y, b0.z, b0.w, b1.x, b1.y, b1.z, b1.w};
    float sp = 0.f;
#pragma unroll
    for (int j = 0; j < 8; ++j) sp += x1[j] * x1[j] + x2[j] * x2[j];
    sp = hsum32(sp);
    const float rn = rsqrtf((ss + sp) * (1.f / 96.f) + EPS);
#pragma unroll
    for (int nt = 0; nt < 2; ++nt)
#pragma unroll
      for (int g = 0; g < 4; ++g) {
        const int d = nt * 32 + 8 * g + 4 * h;
        const f32x4 g4 = gld((const f32x4*)(gk + d));
        store_bf4(kdst + d, acc[nt][mt][4 * g] * rn * g4.x, acc[nt][mt][4 * g + 1] * rn * g4.y, acc[nt][mt][4 * g + 2] * rn * g4.z, acc[nt][mt][4 * g + 3] * rn * g4.w);
      }
    const float prow = (float)(pos >> 6), pcol = (float)(pos & 63);
#pragma unroll
    for (int j = 0; j < 8; ++j) {
      const int jj = 8 * h + j;
      float a = x1[j] * rn * gk[64 + jj], b = x2[j] * rn * gk[80 + jj];
      if (rope) {
        float c, s; rope_cs(j, h == 0 ? prow : pcol, c, s);
        const float na = a * c - b * s, nb2 = b * c + a * s;
        a = na; b = nb2;
      }
      x1[j] = a; x2[j] = b;
    }
    { u32x4 u; u.x = pack2(x1[0], x1[1]); u.y = pack2(x1[2], x1[3]); u.z = pack2(x1[4], x1[5]); u.w = pack2(x1[6], x1[7]); *(GAS u32x4*)(kdst + 64 + 8 * h) = u; }
    { u32x4 u; u.x = pack2(x2[0], x2[1]); u.y = pack2(x2[2], x2[3]); u.z = pack2(x2[4], x2[5]); u.w = pack2(x2[6], x2[7]); *(GAS u32x4*)(kdst + 80 + 8 * h) = u; }
#pragma unroll
    for (int nt = 2; nt < 4; ++nt)
#pragma unroll
      for (int i = 0; i < 16; ++i) {
        const int d = (nt - 2) * 32 + CROW(i, h);
        gst(vdst + (size_t)d * vst, f2bf(acc[nt][mt][i]));
      }
   }
  }
};

struct EpiPool {
  DI void side(int, int, int, unsigned char*) const {}
  const float* scale; bf16_t* cat;
  template <int NT, int MT> DI void operator()(f32x16 (&acc)[NT][MT], int nb, int mb, int lane, unsigned char* wlds, const unsigned char* side, int n0, int m0) const {
    const int r = lane & 31, h = lane >> 5;
#pragma unroll
    for (int mt = 0; mt < MT; ++mt) {
      const int m = mb + mt * 32 + r;
#pragma unroll
      for (int nt = 0; nt < NT; ++nt)
#pragma unroll
        for (int g = 0; g < 4; ++g) {
          const int n = nb + nt * 32 + 8 * g + 4 * h;
          const f32x4 s4 = gld((const f32x4*)(scale + n));
          store_bf4(cat + (size_t)m * 1024 + n, acc[nt][mt][4 * g] * s4.x, acc[nt][mt][4 * g + 1] * s4.y, acc[nt][mt][4 * g + 2] * s4.z, acc[nt][mt][4 * g + 3] * s4.w);
        }
    }
  }
};

template <int DQK>
DI void attn_task(const bf16_t* __restrict__ Q, int qs,
                  const bf16_t* __restrict__ K0, int ks0, const bf16_t* __restrict__ V0, int vs0, int nt0,
                  const bf16_t* __restrict__ K1, int ks1, const bf16_t* __restrict__ V1, int vs1, int nt1,
                  bool na, int qrow0, int krow0, const float* __restrict__ rpb_h,
                  bf16_t* __restrict__ O, int os, float scale, unsigned char* smem) {
  constexpr int KSTR = (DQK + 8) * 2;
  constexpr int CH = DQK / 8;
  constexpr int NKC = (CH * 64 + 511) / 512;
  constexpr int KSTAGE = 64 * 208, VSTAGE = 64 * 144;
  constexpr float LOG2E = 1.4426950408889634f;
  const int tid = otid(), lane = tid & 63, w = tid >> 6, r = lane & 31, h = lane >> 5;
  float* srpb = (float*)(smem + 2 * KSTAGE + 2 * VSTAGE);
  const int NTT = nt0 + nt1;

  __syncthreads();
  if (na) for (int i = tid; i < 465; i += 512) srpb[i] = rpb_h[i] * LOG2E;

  bf16x8 qf[DQK / 16];
  {
    const bf16_t* qp = Q + (size_t)(32 * w + r) * qs + 8 * h;
#pragma unroll
    for (int ks = 0; ks < DQK / 16; ++ks) qf[ks] = gld((const bf16x8*)(qp + ks * 16));
  }
  u32x4 rk[NKC], rv;
  const int vrow = tid >> 3, vkc = tid & 7;
  auto gload = [&](int j) {
    const bf16_t* kp; const bf16_t* vp; int kst, vst;
    if (j < nt0) { kp = K0 + (size_t)j * 64 * ks0; kst = ks0; vp = V0 + j * 64; vst = vs0; }
    else { kp = K1 + (size_t)(j - nt0) * 64 * ks1; kst = ks1; vp = V1 + (j - nt0) * 64; vst = vs1; }
#pragma unroll
    for (int i = 0; i < NKC; ++i) { const int c = tid + 512 * i; if (c < CH * 64) rk[i] = gld((const u32x4*)(kp + (size_t)(c / CH) * kst + (c % CH) * 8)); }
    rv = gld((const u32x4*)(vp + (size_t)vrow * vst + vkc * 8));
  };
  gload(0);

  f32x16 ot[2];
#pragma unroll
  for (int t = 0; t < 2; ++t)
#pragma unroll
    for (int i = 0; i < 16; ++i) ot[t][i] = 0.f;
  float m_run = -3.0e38f, l_run = 0.f;
  const float sc2 = scale * LOG2E;
  const int qrow = qrow0 + (w >> 1), qcol = 32 * (w & 1) + r;
  const int rsw = min(max(qrow - 4, 0), 8);
  const int csq = min(max(qcol - 8, 0), 48);

  for (int j = 0; j < NTT; ++j) {
    unsigned char* sK = smem + (j & 1) * KSTAGE;
    unsigned char* sV = smem + 2 * KSTAGE + (j & 1) * VSTAGE;
#pragma unroll
    for (int i = 0; i < NKC; ++i) { const int c = tid + 512 * i; if (c < CH * 64) *(u32x4*)(sK + (c / CH) * KSTR + (c % CH) * 16) = rk[i]; }
    *(u32x4*)(sV + vrow * 144 + vkc * 16) = rv;
    __syncthreads();
    if (j + 1 < NTT) gload(j + 1);
    __builtin_amdgcn_sched_barrier(0);
    const bool local = na && j < nt0;
    const int keyrow = krow0 + j;
    if (local && (keyrow < rsw || keyrow >= rsw + 8)) continue;
    f32x16 st[2];
#pragma unroll
    for (int t = 0; t < 2; ++t)
#pragma unroll
      for (int i = 0; i < 16; ++i) st[t][i] = 0.f;
    {
      bf16x8 kf[DQK / 16][2];
#pragma unroll
      for (int ks = 0; ks < DQK / 16; ++ks)
#pragma unroll
        for (int t = 0; t < 2; ++t) kf[ks][t] = *(const bf16x8*)(sK + (t * 32 + r) * KSTR + ks * 32 + h * 16);
      __builtin_amdgcn_sched_barrier(0);
#pragma unroll
      for (int ks = 0; ks < DQK / 16; ++ks)
#pragma unroll
        for (int t = 0; t < 2; ++t) st[t] = MFMA(kf[ks][t], qf[ks], st[t]);
    }
    bf16x8 vfr[4][2];
#pragma unroll
    for (int s2 = 0; s2 < 4; ++s2)
#pragma unroll
      for (int dv = 0; dv < 2; ++dv) {
        const unsigned char* vb = sV + (dv * 32 + r) * 144 + (16 * s2 + 4 * h) * 2;
        const u32x2 v0 = *(const u32x2*)(vb), v1 = *(const u32x2*)(vb + 16);
        const u32x4 vu = {v0.x, v0.y, v1.x, v1.y};
        vfr[s2][dv] = __builtin_bit_cast(bf16x8, vu);
      }
    __builtin_amdgcn_sched_barrier(0);
    float mx = -3.0e38f;
    if (local) {
      const int dr = keyrow - qrow + 7;
#pragma unroll
      for (int t = 0; t < 2; ++t)
#pragma unroll
        for (int i = 0; i < 16; ++i) {
          const int kc = t * 32 + CROW(i, h);
          const bool valid = (kc >= csq) && (kc < csq + 16);
          const int dc = min(max(kc - qcol + 15, 0), 30);
          const float bias = srpb[dr * 31 + dc];
          const float s = valid ? __builtin_fmaf(st[t][i], sc2, bias) : -1.0e30f;
          st[t][i] = s; mx = fmaxf(mx, s);
        }
    } else {
#pragma unroll
      for (int t = 0; t < 2; ++t)
#pragma unroll
        for (int i = 0; i < 16; ++i) mx = fmaxf(mx, st[t][i]);
      mx *= sc2;
    }
    mx = hmax32(mx);
    const float m_new = fmaxf(m_run, mx);
    if (__builtin_amdgcn_ballot_w64(m_new > m_run) != 0ull) {
      const float alpha = __builtin_amdgcn_exp2f(m_run - m_new);
      l_run *= alpha;
#pragma unroll
      for (int t = 0; t < 2; ++t)
#pragma unroll
        for (int i = 0; i < 16; ++i) ot[t][i] *= alpha;
    }
    m_run = m_new;
    if (local) {
#pragma unroll
      for (int t = 0; t < 2; ++t)
#pragma unroll
        for (int i = 0; i < 16; ++i) { const float p = __builtin_amdgcn_exp2f(st[t][i] - m_new); st[t][i] = p; l_run += p; }
    } else {
#pragma unroll
      for (int t = 0; t < 2; ++t)
#pragma unroll
        for (int i = 0; i < 16; ++i) { const float p = __builtin_amdgcn_exp2f(__builtin_fmaf(st[t][i], sc2, -m_new)); st[t][i] = p; l_run += p; }
    }
#pragma unroll
    for (int s2 = 0; s2 < 4; ++s2) {
      const int t = s2 >> 1, o = (s2 & 1) * 8;
      const u32x4 pu = {pack2(st[t][o + 0], st[t][o + 1]), pack2(st[t][o + 2], st[t][o + 3]), pack2(st[t][o + 4], st[t][o + 5]), pack2(st[t][o + 6], st[t][o + 7])};
      const bf16x8 pfv = __builtin_bit_cast(bf16x8, pu);
#pragma unroll
      for (int dv = 0; dv < 2; ++dv) ot[dv] = MFMA(vfr[s2][dv], pfv, ot[dv]);
    }
  }
  const float lt = hsum32(l_run);
  const float inv = 1.f / lt;
  bf16_t* op = O + (size_t)(32 * w + r) * os;
#pragma unroll
  for (int dv = 0; dv < 2; ++dv)
#pragma unroll
    for (int g = 0; g < 4; ++g)
      store_bf4(op + dv * 32 + 8 * g + 4 * h, ot[dv][4 * g] * inv, ot[dv][4 * g + 1] * inv, ot[dv][4 * g + 2] * inv, ot[dv][4 * g + 3] * inv);
}

DI void job_mods(const Params& p, int j, unsigned char* smem) {
  const int tid = otid(), lane = tid & 63, w = tid >> 6, kq = lane >> 4, c4 = lane & 15;
  const int l = j / 96, n0 = (j % 96) * 64;
  float* s = (float*)smem;
  __syncthreads();
  for (int idx = tid; idx < 9 * 1024; idx += 512) {
    const int mi = idx >> 10, k = idx & 1023;
    const float x = mi == 0 ? p.in[7][k] : p.in[6][(mi - 1) * 1024 + k];
    s[idx] = x / (1.f + expf(-x));
  }
  __syncthreads();
  const float* Wp = p.in[8] + ((size_t)l * 1024 + w * 128 + kq) * 6144 + n0 + 4 * c4;
  float acc[9][4];
#pragma unroll
  for (int mi = 0; mi < 9; ++mi)
#pragma unroll
    for (int q = 0; q < 4; ++q) acc[mi][q] = 0.f;
#pragma unroll 8
  for (int i = 0; i < 32; ++i) {
    const f32x4 wv = gld_nt((const f32x4*)(Wp + (size_t)(4 * i) * 6144));
    const int k = w * 128 + 4 * i + kq;
#pragma unroll
    for (int mi = 0; mi < 9; ++mi) {
      const float sv = s[mi * 1024 + k];
      acc[mi][0] += sv * wv.x; acc[mi][1] += sv * wv.y; acc[mi][2] += sv * wv.z; acc[mi][3] += sv * wv.w;
    }
  }
#pragma unroll
  for (int mi = 0; mi < 9; ++mi)
#pragma unroll
    for (int q = 0; q < 4; ++q) { float v = acc[mi][q]; v += __shfl_xor(v, 16, 64); v += __shfl_xor(v, 32, 64); acc[mi][q] = v; }
  __syncthreads();
  float* red = (float*)smem;
  if (kq == 0) {
#pragma unroll
    for (int mi = 0; mi < 9; ++mi)
#pragma unroll
      for (int q = 0; q < 4; ++q) red[(w * 9 + mi) * 64 + 4 * c4 + q] = acc[mi][q];
  }
  __syncthreads();
  float* mod = (float*)(p.ws + OFF_MOD);
  for (int idx = tid; idx < 9 * 64; idx += 512) {
    const int mi = idx >> 6, ln = idx & 63;
    float v = 0.f;
#pragma unroll
    for (int q = 0; q < 8; ++q) v += red[(q * 9 + mi) * 64 + ln];
    mod[(size_t)(l * 9 + mi) * 6144 + n0 + ln] = v + p.in[9][l * 6144 + n0 + ln];
  }
}

DI void job_wconv(const Params& p, int t) {
  int mi = 0;
#pragma unroll 1
  for (int i = 1; i < NMATS; ++i) if (t >= p.mats[i].tile0) mi = i;
  const MatDesc md = p.mats[mi];
  const int lt = t - md.tile0;
  const int ktiles = md.K >> 7;
  const int k0 = (lt % ktiles) * 128 + (otid() >> 6) * 16, n = (lt / ktiles) * 64 + (otid() & 63);
  const float* sp; bool ok; size_t rs;
  if (md.blockdiag == 1) { ok = (k0 >> 7) == (n >> 7); sp = md.src + (size_t)(k0 >> 7) * 16384 + (size_t)(k0 & 127) * 128 + (n & 127); rs = 128; }
  else if (md.headpad) { const int hd = n >> 7, d = n & 127; ok = d < 96; sp = md.src + (size_t)k0 * md.N + hd * 96 + d; rs = md.N; }
  else { ok = n < md.N; sp = md.src + (size_t)k0 * md.N + n; rs = md.N; }
  float v[16];
  if (md.blockdiag >= 2 && k0 < 512) {
    const int li = md.blockdiag - 2, g = k0 >> 7;
    const int krow = __builtin_amdgcn_readfirstlane(k0 & 127);
    const float* pw = p.in[21] + ((size_t)(li * 4 + g) * 128 + krow) * 128;
    const float* scp = p.in[22] + li * 512 + g * 128;
    const float* wo = md.src + (size_t)(g * 128) * md.N + n;
#pragma unroll
    for (int q = 0; q < 16; ++q) v[q] = 0.f;
#pragma unroll 8
    for (int d = 0; d < 128; ++d) {
      const float x = scp[d] * wo[(size_t)d * md.N];
#pragma unroll
      for (int q = 0; q < 16; ++q) v[q] += pw[q * 128 + d] * x;
    }
  } else {
#pragma unroll
  for (int q = 0; q < 16; ++q) v[q] = ok ? gld_nt(sp + (size_t)q * rs) : 0.f;
  }
  if (md.rscale) {
#pragma unroll
    for (int q = 0; q < 16; ++q) v[q] *= md.rscale[k0 + q];
  }
  bf16_t* dst = (bf16_t*)(p.ws + md.dst) + (size_t)n * md.K + k0;
  u32x4 u0 = {pack2(v[0], v[1]), pack2(v[2], v[3]), pack2(v[4], v[5]), pack2(v[6], v[7])};
  u32x4 u1 = {pack2(v[8], v[9]), pack2(v[10], v[11]), pack2(v[12], v[13]), pack2(v[14], v[15])};
  *(GAS u32x4*)dst = u0;
  *(GAS u32x4*)(dst + 8) = u1;
}

DI void job_cache(const Params& p, int j) {
  const int tid = otid();
  if (j < 512) {
    const int item = j * 512 + tid;
    const int e = item * 8;
    const int c = e & 511, pos = (e >> 9) & 255, i = (e >> 17) & 1, b = e >> 18;
    const f32x4 a = gld_nt((const f32x4*)(p.in[2] + e)), bq = gld_nt((const f32x4*)(p.in[2] + e + 4));
    u32x4 u; u.x = pack2(a.x, a.y); u.y = pack2(a.z, a.w); u.z = pack2(bq.x, bq.y); u.w = pack2(bq.z, bq.w);
    *(GAS u32x4*)((bf16_t*)(p.ws + OFF_CNK) + ((size_t)(i * 2048 + b * 256 + pos)) * 512 + c) = u;
  } else if (j < 1024) {
    const int item = (j - 512) * 512 + tid;
    const int hd = item & 511, pos8 = (item >> 9) & 31, i = (item >> 14) & 1, b = item >> 15;
    const float* src = p.in[3] + ((size_t)((b * 2 + i) * 256 + pos8 * 8)) * 512 + hd;
    float v[8];
#pragma unroll
    for (int q = 0; q < 8; ++q) v[q] = src[(size_t)q * 512];
    u32x4 u; u.x = pack2(v[0], v[1]); u.y = pack2(v[2], v[3]); u.z = pack2(v[4], v[5]); u.w = pack2(v[6], v[7]);
    *(GAS u32x4*)((bf16_t*)(p.ws + OFF_CNVT) + ((size_t)((i * 8 + b) * 512 + hd)) * 256 + pos8 * 8) = u;
  } else {
    const int item = (j - 1024) * 512 + tid;
    const int e = item * 8;
    const int c = e & 255, pos = (e >> 8) & 255, i = (e >> 16) & 1, b = e >> 17;
    const f32x4 a = gld_nt((const f32x4*)(p.in[4] + e)), bq = gld_nt((const f32x4*)(p.in[4] + e + 4));
    u32x4 u; u.x = pack2(a.x, a.y); u.y = pack2(a.z, a.w); u.z = pack2(bq.x, bq.y); u.w = pack2(bq.z, bq.w);
    *(GAS u32x4*)((bf16_t*)(p.ws + OFF_CCKV) + ((size_t)(i * 2048 + b * 256 + pos)) * 256 + c) = u;
  }
}

DI void job_shw(const Params& p, int j, unsigned char* smem) {
  int l = 0, jj = j;
  if (jj >= 112) { jj -= 112; l = 1; if (jj >= 84) { jj -= 84; l = 2; if (jj >= 112) { jj -= 112; l = 3; } } }
  const int n1 = (l & 1) ? 20 : 48;
  const int which = jj >= n1;
  const int n0 = (which ? jj - n1 : jj) * 64;
  const bf16_t* Wt = which ? (const bf16_t*)(p.ws + OFF_W1T) + (size_t)l * 4096 * 1024
                           : ((l & 1) ? (const bf16_t*)(p.ws + OFF_OWIN) + (size_t)(l >> 1) * 1280 * 1024
                                      : (const bf16_t*)(p.ws + OFF_EWIN) + (size_t)(l >> 1) * 3072 * 1024);
  float* dst = which ? (float*)(p.ws + OFF_SHW2) + (size_t)l * 9 * 4096 : (float*)(p.ws + OFF_SHW1) + (size_t)l * 9 * 3072;
  const int ns = which ? 4096 : 3072;
  const float* mod = (const float*)(p.ws + OFF_MOD) + (size_t)l * 9 * 6144 + (which ? 3072 : 0);
  const int tid = otid(), lane = tid & 63, w = tid >> 6;
  float* s = (float*)smem;
  __syncthreads();
  for (int idx = tid; idx < 9 * 1024; idx += 512) s[idx] = mod[(idx >> 10) * 6144 + (idx & 1023)];
  __syncthreads();
  const bf16_t* wr = Wt + (size_t)(n0 + lane) * 1024 + w * 128;
  float acc[9];
#pragma unroll
  for (int mi = 0; mi < 9; ++mi) acc[mi] = 0.f;
#pragma unroll 2
  for (int c = 0; c < 16; ++c) {
    const u32x4 u = gld((const u32x4*)(wr + c * 8));
    const float wv[8] = {bflo(u.x), bfhi(u.x), bflo(u.y), bfhi(u.y), bflo(u.z), bfhi(u.z), bflo(u.w), bfhi(u.w)};
#pragma unroll
    for (int q = 0; q < 8; ++q)
#pragma unroll
      for (int mi = 0; mi < 9; ++mi) acc[mi] += s[mi * 1024 + w * 128 + c * 8 + q] * wv[q];
  }
  __syncthreads();
  float* red = (float*)smem;
#pragma unroll
  for (int mi = 0; mi < 9; ++mi) red[(w * 9 + mi) * 64 + lane] = acc[mi];
  __syncthreads();
  for (int idx = tid; idx < 9 * 64; idx += 512) {
    const int mi = idx >> 6, ln = idx & 63;
    float v = 0.f;
#pragma unroll
    for (int q = 0; q < 8; ++q) v += red[(q * 9 + mi) * 64 + ln];
    dst[(size_t)mi * ns + n0 + ln] = v;
  }
}

DI void job_xpass(const Params& p, int j) {
  const int tid = otid(), lane = tid & 63, w = tid >> 6;
  const int m = j * 8 + w, mi = mi_of(m);
  const float* x = m < TP ? p.in[0] + (size_t)m * 1024 : p.in[1] + (size_t)(m - TP) * 1024;
  const float* g1 = p.in[10];
  const float* sc = (const float*)(p.ws + OFF_MOD) + (size_t)mi * 6144 + 1024;
  float* y = p.out + OUT_Y + (size_t)m * 1024;
  bf16_t* ab = (bf16_t*)(p.ws + OFF_ABUF) + (size_t)m * 1024;
  float ss = 0.f;
#pragma unroll
  for (int i = 0; i < 4; ++i) {
    const int k = lane * 4 + 256 * i;
    const f32x4 v = gld_nt((const f32x4*)(x + k));
    const f32x4 g = gld((const f32x4*)(g1 + k));
    const f32x4 s4 = gld((const f32x4*)(sc + k));
    ss += v.x * v.x + v.y * v.y + v.z * v.z + v.w * v.w;
    *(GAS f32x4*)(y + k) = v;
    store_bf4(ab + k, v.x * g.x * (1.f + s4.x), v.y * g.y * (1.f + s4.y), v.z * g.z * (1.f + s4.z), v.w * g.w * (1.f + s4.w));
  }
#pragma unroll
  for (int o = 32; o >= 1; o >>= 1) ss += __shfl_xor(ss, o, 64);
  float* ssq = (float*)(p.ws + OFF_SSQ1);
  if (lane < 16) ssq[(size_t)lane * T + m] = lane == 0 ? ss : 0.f;
}

DI void job_conv(const Params& p, int j, int li) {
  const int item = j * 512 + otid();
  const int m = item >> 6, c = (item & 63) * 8;
  const bf16_t* bc = (const bf16_t*)(p.ws + OFF_BCONV);
  int pos, L;
  if (m < TP) { pos = m & 255; L = 256; } else { pos = (m - TP) & 1023; L = 1024; }
  const float* cw = p.in[15] + (size_t)li * 3 * 512 + c;
  float accv[8];
#pragma unroll
  for (int q = 0; q < 8; ++q) accv[q] = 0.f;
#pragma unroll
  for (int d = -1; d <= 1; ++d) {
    const int pp = pos + d;
    if (pp < 0 || pp >= L) continue;
    const u32x4 cg = gld((const u32x4*)(bc + (size_t)(m + d) * 1536 + 512 + c));
    const u32x4 xa = gld((const u32x4*)(bc + (size_t)(m + d) * 1536 + 1024 + c));
    const f32x4 w0 = gld((const f32x4*)(cw + (d + 1) * 512)), w1 = gld((const f32x4*)(cw + (d + 1) * 512 + 4));
    accv[0] += bflo(cg.x) * bflo(xa.x) * w0.x; accv[1] += bfhi(cg.x) * bfhi(xa.x) * w0.y;
    accv[2] += bflo(cg.y) * bflo(xa.y) * w0.z; accv[3] += bfhi(cg.y) * bfhi(xa.y) * w0.w;
    accv[4] += bflo(cg.z) * bflo(xa.z) * w1.x; accv[5] += bfhi(cg.z) * bfhi(xa.z) * w1.y;
    accv[6] += bflo(cg.w) * bflo(xa.w) * w1.z; accv[7] += bfhi(cg.w) * bfhi(xa.w) * w1.w;
  }
  const u32x4 bg = gld((const u32x4*)(bc + (size_t)m * 1536 + c));
  u32x4 u;
  u.x = pack2(bflo(bg.x) * accv[0], bfhi(bg.x) * accv[1]); u.y = pack2(bflo(bg.y) * accv[2], bfhi(bg.y) * accv[3]);
  u.z = pack2(bflo(bg.z) * accv[4], bfhi(bg.z) * accv[5]); u.w = pack2(bflo(bg.w) * accv[6], bfhi(bg.w) * accv[7]);
  *(GAS u32x4*)((bf16_t*)(p.ws + OFF_CAT) + (size_t)m * 1024 + c) = u;
}

DI void job_poolx(const Params& p, int j) {
  const int item = j * 512 + otid();
  const int m = item >> 6, c = (item & 63) * 8;
  const bf16_t* ub = (const bf16_t*)(p.ws + OFF_UBUF);
  int pos, L;
  if (m < TP) { pos = m & 255; L = 256; } else { pos = (m - TP) & 1023; L = 1024; }
  const int wsz = 2 << (c >> 7);
  const int lo = min(max(pos - wsz / 2, 0), L), hi = min(max(pos - wsz / 2 + wsz, 0), L);
  float s[8];
#pragma unroll
  for (int q = 0; q < 8; ++q) s[q] = 0.f;
  u32x4 uu[16];
#pragma unroll
  for (int q = 0; q < 16; ++q) {
    const u32x4 z = {0u, 0u, 0u, 0u};
    uu[q] = (lo + q < hi) ? gld((const u32x4*)(ub + (size_t)(m + lo + q - pos) * 512 + c)) : z;
  }
#pragma unroll
  for (int q = 0; q < 16; ++q) {
    const u32x4 u = uu[q];
    s[0] += bflo(u.x); s[1] += bfhi(u.x); s[2] += bflo(u.y); s[3] += bfhi(u.y); s[4] += bflo(u.z); s[5] += bfhi(u.z); s[6] += bflo(u.w); s[7] += bfhi(u.w);
  }
  const float inv = 1.f / (float)(hi - lo);
  const u32x4 u = gld((const u32x4*)(ub + (size_t)m * 512 + c));
  u32x4 o;
  o.x = pack2(s[0] * inv - bflo(u.x), s[1] * inv - bfhi(u.x)); o.y = pack2(s[2] * inv - bflo(u.y), s[3] * inv - bfhi(u.y));
  o.z = pack2(s[4] * inv - bflo(u.z), s[5] * inv - bfhi(u.z)); o.w = pack2(s[6] * inv - bflo(u.w), s[7] * inv - bfhi(u.w));
  *(GAS u32x4*)((bf16_t*)(p.ws + OFF_CAT) + (size_t)m * 1024 + c) = o;
}

DI void job_ckvstate(const Params& p, int j, int li) {
  const int item = j * 512 + otid();
  const int m = item >> 6, c = (item & 63) * 4;
  const float rs = rstd_parts<2>((const float*)(p.ws + OFF_SSQKV), m, 1.f / 256.f);
  float* o = p.out + OUT_CKV + ((size_t)(((m >> 8) * 2 + li) * 256 + (m & 255))) * 256 + c;
  const f32x4 g = gld((const f32x4*)(p.in[25] + li * 256 + c));
  f32x4 v = gld((const f32x4*)((const float*)(p.ws + OFF_KVRAW) + (size_t)m * 256 + c));
  v.x *= rs * g.x; v.y *= rs * g.y; v.z *= rs * g.z; v.w *= rs * g.w;
  *(GAS f32x4*)o = v;
}

__global__ void __launch_bounds__(NTHREADS, 2) fwd_megakernel(Params p) {
  __shared__ __attribute__((aligned(16))) unsigned char smem[SMEM_BYTES];
  __shared__ u32x4 xb_words;
  cg::grid_group grid = cg::this_grid();
  if (p.pad_ == 0x7fffffff) grid.sync();
  if (threadIdx.x == 0) { const u32x4 z = {0u, 0u, 0u, 0u}; xb_words = z; }
  __syncthreads();
  const XcdBarrier xb = xcd_barrier_post((unsigned*)(p.ws + OFF_BAR), (volatile LAS unsigned*)&xb_words);
  const int nb = gridDim.x, bid = blockIdx.x;
  unsigned char* const ws_ = p.ws;
  float* const out_ = p.out;

#ifndef SKIP_PH0
  for (int rep_ = 0; rep_ < REP_PH0; ++rep_) {
    const int n_mod = 384, n_conv = p.conv_tiles, n_cache = 1280;
    for (int j = bid; j < n_mod + n_conv + n_cache; j += nb) {
      if (j < n_mod) { for (int q_ = 0; q_ < REP_MODS; ++q_) job_mods(p, j, smem); }
      else if (j < n_mod + n_conv) { for (int q_ = 0; q_ < REP_WCONV; ++q_) job_wconv(p, j - n_mod); }
      else { for (int q_ = 0; q_ < REP_CACHE; ++q_) job_cache(p, j - n_mod - n_conv); }
    }
  }
#endif
  xcd_barrier(xb);
#ifndef SKIP_PH1
  for (int rep_ = 0; rep_ < REP_PH1; ++rep_) {
    for (int j = bid; j < 392 + 1536; j += nb) {
      if (j < 392) job_shw(p, j, smem); else job_xpass(p, j - 392);
    }
  }
#endif
  xcd_barrier(xb);

#pragma unroll 1
  for (int l = 0; l < 4; ++l) {
    const int li = l >> 1;
    if ((l & 1) == 0) {
#ifndef SKIP_E2
      for (int rep_ = 0; rep_ < REP_E2; ++rep_) {
        unsigned char* ws = uniform_ptr(ws_); float* ybuf = (float*)uniform_ptr(out_); asm volatile("" : "+s"(ws), "+s"(ybuf));
        float* mod = (float*)(ws + OFF_MOD); bf16_t* abuf = (bf16_t*)(ws + OFF_ABUF); bf16_t* cat = (bf16_t*)(ws + OFF_CAT); bf16_t* act = (bf16_t*)(ws + OFF_ACT);
        float* ssq1 = (float*)(ws + OFF_SSQ1); float* ssq2 = (float*)(ws + OFF_SSQ2); const float* modl = mod + (size_t)l * 9 * 6144;
        (void)mod; (void)abuf; (void)cat; (void)act; (void)ssq1; (void)ssq2; (void)modl; (void)ybuf;
        EpiEvenIn e;
        e.ssq = ssq1; e.shw = (const float*)(ws + OFF_SHW1) + (size_t)l * 9 * 3072; e.gq = p.in[16] + li * 64; e.gk = p.in[17] + li * 64;
        e.bconv = (bf16_t*)(ws + OFF_BCONV); e.qbuf = (bf16_t*)(ws + OFF_QBUF); e.kbuf = (bf16_t*)(ws + OFF_KBUF);
        e.vtp = (bf16_t*)(ws + OFF_VTP); e.vts = (bf16_t*)(ws + OFF_VTS); e.out_k = ybuf + OUT_NAK; e.out_v = ybuf + OUT_NAV; e.li = li;
        const bf16_t* W = (const bf16_t*)(ws + OFF_EWIN) + (size_t)li * 3072 * 1024;
        for (int t = bid; t < 64 * 12; t += nb) gemm_tile<192, 4>(abuf, 1024, W, 1024, (t % 64) * 192, (t / 64) * 256, e, smem);
      }
#endif
      xcd_barrier(xb);
#ifndef SKIP_E3
      for (int rep_ = 0; rep_ < REP_E3; ++rep_) {
        unsigned char* ws = uniform_ptr(ws_); float* ybuf = (float*)uniform_ptr(out_); asm volatile("" : "+s"(ws), "+s"(ybuf));
        float* mod = (float*)(ws + OFF_MOD); bf16_t* abuf = (bf16_t*)(ws + OFF_ABUF); bf16_t* cat = (bf16_t*)(ws + OFF_CAT); bf16_t* act = (bf16_t*)(ws + OFF_ACT);
        float* ssq1 = (float*)(ws + OFF_SSQ1); float* ssq2 = (float*)(ws + OFF_SSQ2); const float* modl = mod + (size_t)l * 9 * 6144;
        (void)mod; (void)abuf; (void)cat; (void)act; (void)ssq1; (void)ssq2; (void)modl; (void)ybuf;
        const bf16_t* qb = (const bf16_t*)(ws + OFF_QBUF); const bf16_t* kb = (const bf16_t*)(ws + OFF_KBUF);
        const bf16_t* vtp = (const bf16_t*)(ws + OFF_VTP); const bf16_t* vts = (const bf16_t*)(ws + OFF_VTS);
        const bf16_t* cnk = (const bf16_t*)(ws + OFF_CNK) + (size_t)li * 2048 * 512;
        const bf16_t* cnvt = (const bf16_t*)(ws + OFF_CNVT) + (size_t)li * 2048 * 512;
        for (int j = bid; j < 256 + 128 + 1536; j += nb) {
          if (j < 256) {
            const int rq = j & 3, hd = (j >> 2) & 7, b = j >> 5;
            const int tok0 = TP + b * 1024 + rq * 256;
            const int kr0 = min(max(4 * rq - 4, 0), 8), kr1 = min(max(4 * rq + 3 - 4, 0), 8) + 8;
            attn_task<64>(qb + (size_t)tok0 * 512 + hd * 64, 512,
                          kb + (size_t)(TP + b * 1024 + kr0 * 64) * 512 + hd * 64, 512, vts + ((size_t)(b * 8 + hd) * 64) * 1024 + kr0 * 64, 1024, kr1 - kr0,
                          cnk + (size_t)(b * 256) * 512 + hd * 64, 512, cnvt + ((size_t)(b * 8 + hd) * 64) * 256, 256, 4,
                          true, 4 * rq, kr0, p.in[18] + (size_t)(li * 8 + hd) * 465,
                          cat + (size_t)tok0 * 1024 + 512 + hd * 64, 1024, 0.125f, smem);
          } else if (j < 384) {
            const int jj = j - 256, hd = jj & 7, b = jj >> 3;
            const int tok0 = b * 256;
            attn_task<64>(qb + (size_t)tok0 * 512 + hd * 64, 512,
                          kb + (size_t)(b * 256) * 512 + hd * 64, 512, vtp + ((size_t)(b * 8 + hd) * 64) * 256, 256, 4,
                          kb, 512, vtp, 256, 0,
                          false, 0, 0, p.in[18],
                          cat + (size_t)tok0 * 1024 + 512 + hd * 64, 1024, 0.125f, smem);
          } else job_conv(p, j - 384, li);
        }
      }
#endif
      xcd_barrier(xb);
#ifndef SKIP_E4
      {
        unsigned char* ws = uniform_ptr(ws_); float* ybuf = (float*)uniform_ptr(out_); asm volatile("" : "+s"(ws), "+s"(ybuf));
        float* mod = (float*)(ws + OFF_MOD); bf16_t* abuf = (bf16_t*)(ws + OFF_ABUF); bf16_t* cat = (bf16_t*)(ws + OFF_CAT); bf16_t* act = (bf16_t*)(ws + OFF_ACT);
        float* ssq1 = (float*)(ws + OFF_SSQ1); float* ssq2 = (float*)(ws + OFF_SSQ2); const float* modl = mod + (size_t)l * 9 * 6144;
        (void)mod; (void)abuf; (void)cat; (void)act; (void)ssq1; (void)ssq2; (void)modl; (void)ybuf;
        EpiResid e; e.gscale = 1.f; e.y = ybuf; e.gate = modl + 2048; e.ng = p.in[11] + l * 1024; e.nsc = modl + 4096; e.abuf = abuf; e.ssq_out = ssq2;
        const bf16_t* W = (const bf16_t*)(ws + OFF_EWOUT) + (size_t)li * 1024 * 1024;
#if PROBE_RESID
        e.gscale = 0.f;
        for (int t = bid; t < 64 * 4; t += nb) gemm_tile<192, 4>(cat, 1024, W, 1024, (t % 64) * 192, (t / 64) * 256, e, smem);
        e.gscale = 1.f; __syncthreads();
#endif
        for (int t = bid; t < 64 * 4; t += nb) gemm_tile<192, 4>(cat, 1024, W, 1024, (t % 64) * 192, (t / 64) * 256, e, smem);
      }
#endif
      xcd_barrier(xb);
    } else {
#ifndef SKIP_O2
      for (int rep_ = 0; rep_ < REP_O2; ++rep_) {
        unsigned char* ws = uniform_ptr(ws_); float* ybuf = (float*)uniform_ptr(out_); asm volatile("" : "+s"(ws), "+s"(ybuf));
        float* mod = (float*)(ws + OFF_MOD); bf16_t* abuf = (bf16_t*)(ws + OFF_ABUF); bf16_t* cat = (bf16_t*)(ws + OFF_CAT); bf16_t* act = (bf16_t*)(ws + OFF_ACT);
        float* ssq1 = (float*)(ws + OFF_SSQ1); float* ssq2 = (float*)(ws + OFF_SSQ2); const float* modl = mod + (size_t)l * 9 * 6144;
        (void)mod; (void)abuf; (void)cat; (void)act; (void)ssq1; (void)ssq2; (void)modl; (void)ybuf;
        EpiOddIn e;
        e.ssq = ssq1; e.shw = (const float*)(ws + OFF_SHW1) + (size_t)l * 9 * 3072; e.ubuf = (bf16_t*)(ws + OFF_UBUF); e.qlat = (bf16_t*)(ws + OFF_QLAT);
        e.kvlat = (bf16_t*)(ws + OFF_KVLAT); e.kpebuf = (float*)(ws + OFF_KPE); e.ssqq = (float*)(ws + OFF_SSQQ); e.ssqkv = (float*)(ws + OFF_SSQKV);
        e.out_ckv = (float*)(ws + OFF_KVRAW); e.out_kpe = ybuf + OUT_KPE; e.li = li;
        const bf16_t* W = (const bf16_t*)(ws + OFF_OWIN) + (size_t)li * 1280 * 1024;
        for (int t = bid; t < 48 * 5; t += nb) gemm_tile<256, 2>(abuf, 1024, W, 1024, (t % 48) * 256, (t / 48) * 256, e, smem);
      }
#endif
      xcd_barrier(xb);
#ifndef SKIP_O3
      for (int rep_ = 0; rep_ < REP_O3; ++rep_) {
        unsigned char* ws = uniform_ptr(ws_); float* ybuf = (float*)uniform_ptr(out_); asm volatile("" : "+s"(ws), "+s"(ybuf));
        float* mod = (float*)(ws + OFF_MOD); bf16_t* abuf = (bf16_t*)(ws + OFF_ABUF); bf16_t* cat = (bf16_t*)(ws + OFF_CAT); bf16_t* act = (bf16_t*)(ws + OFF_ACT);
        float* ssq1 = (float*)(ws + OFF_SSQ1); float* ssq2 = (float*)(ws + OFF_SSQ2); const float* modl = mod + (size_t)l * 9 * 6144;
        (void)mod; (void)abuf; (void)cat; (void)act; (void)ssq1; (void)ssq2; (void)modl; (void)ybuf;
        EpiKvUp ek; ek.ssqkv = (const float*)(ws + OFF_SSQKV); ek.gk = p.in[28] + li * 96; ek.kpebuf = (const float*)(ws + OFF_KPE); ek.cache_kpe = p.in[5];
        ek.kpm = (bf16_t*)(ws + OFF_KPM); ek.ksm = (bf16_t*)(ws + OFF_KSM); ek.vtpm = (bf16_t*)(ws + OFF_VTPM); ek.vtsm = (bf16_t*)(ws + OFF_VTSM); ek.li = li; ek.cache = 0;
        EpiQUp eq; eq.ssqq = (const float*)(ws + OFF_SSQQ); eq.gq = p.in[27] + li * 96; eq.qmla = (bf16_t*)(ws + OFF_QMLA);
        const bf16_t* Wkv = (const bf16_t*)(ws + OFF_WKVB) + (size_t)li * 1024 * 256;
        const bf16_t* Wq = (const bf16_t*)(ws + OFF_WQB) + (size_t)li * 1024 * 384;
        const bf16_t* cckv = (const bf16_t*)(ws + OFF_CCKV) + (size_t)li * 2048 * 256;
        for (int j = bid; j < 448 + 384 + 1536 + 512; j += nb) {
          if (j < 448) {
            const int mt = j % 112, nt = j / 112;
            const bool cch = mt >= 96;
            ek.cache = cch ? 1 : 0;
            gemm_tile<128, 2>(cch ? cckv : (const bf16_t*)(ws + OFF_KVLAT), 256, Wkv, 256, (cch ? mt - 96 : mt) * 128, nt * 256, ek, smem);
          } else if (j < 448 + 384) {
            const int jj = j - 448;
            gemm_tile<128, 2>((const bf16_t*)(ws + OFF_QLAT), 384, Wq, 384, (jj % 96) * 128, (jj / 96) * 256, eq, smem);
          } else if (j < 448 + 384 + 1536) job_poolx(p, j - 448 - 384);
          else job_ckvstate(p, j - 448 - 384 - 1536, li);
        }
      }
#endif
      xcd_barrier(xb);
#ifndef SKIP_O4
      for (int rep_ = 0; rep_ < REP_O4; ++rep_) {
        unsigned char* ws = uniform_ptr(ws_); float* ybuf = (float*)uniform_ptr(out_); asm volatile("" : "+s"(ws), "+s"(ybuf));
        float* mod = (float*)(ws + OFF_MOD); bf16_t* abuf = (bf16_t*)(ws + OFF_ABUF); bf16_t* cat = (bf16_t*)(ws + OFF_CAT); bf16_t* act = (bf16_t*)(ws + OFF_ACT);
        float* ssq1 = (float*)(ws + OFF_SSQ1); float* ssq2 = (float*)(ws + OFF_SSQ2); const float* modl = mod + (size_t)l * 9 * 6144;
        (void)mod; (void)abuf; (void)cat; (void)act; (void)ssq1; (void)ssq2; (void)modl; (void)ybuf;
        const bf16_t* qm = (const bf16_t*)(ws + OFF_QMLA);
        const bf16_t* kpm = (const bf16_t*)(ws + OFF_KPM); const bf16_t* ksm = (const bf16_t*)(ws + OFF_KSM);
        const bf16_t* vtpm = (const bf16_t*)(ws + OFF_VTPM); const bf16_t* vtsm = (const bf16_t*)(ws + OFF_VTSM);
        const float sc = 0.10206207261596575f;
        for (int j = bid; j < 256 + 128; j += nb) {
          if (j < 256) {
            const int qb2 = j & 3, hd = (j >> 2) & 7, b = j >> 5;
            const int tok0 = TP + b * 1024 + qb2 * 256;
            attn_task<96>(qm + (size_t)tok0 * 768 + hd * 96, 768,
                          ksm + ((size_t)(b * 8 + hd) * 1280) * 96, 96, vtsm + ((size_t)(b * 8 + hd) * 64) * 1280, 1280, 20,
                          ksm, 96, vtsm, 1280, 0, false, 0, 0, p.in[18],
                          cat + (size_t)tok0 * 1024 + 512 + hd * 64, 1024, sc, smem);
          } else if (j < 384) {
            const int jj = j - 256, hd = jj & 7, b = jj >> 3;
            const int tok0 = b * 256;
            attn_task<96>(qm + (size_t)tok0 * 768 + hd * 96, 768,
                          kpm + ((size_t)(b * 8 + hd) * 256) * 96, 96, vtpm + ((size_t)(b * 8 + hd) * 64) * 256, 256, 4,
                          kpm, 96, vtpm, 256, 0, false, 0, 0, p.in[18],
                          cat + (size_t)tok0 * 1024 + 512 + hd * 64, 1024, sc, smem);
          }
        }
      }
#endif
      xcd_barrier(xb);
#ifndef SKIP_O5
      {
        unsigned char* ws = uniform_ptr(ws_); float* ybuf = (float*)uniform_ptr(out_); asm volatile("" : "+s"(ws), "+s"(ybuf));
        float* mod = (float*)(ws + OFF_MOD); bf16_t* abuf = (bf16_t*)(ws + OFF_ABUF); bf16_t* cat = (bf16_t*)(ws + OFF_CAT); bf16_t* act = (bf16_t*)(ws + OFF_ACT);
        float* ssq1 = (float*)(ws + OFF_SSQ1); float* ssq2 = (float*)(ws + OFF_SSQ2); const float* modl = mod + (size_t)l * 9 * 6144;
        (void)mod; (void)abuf; (void)cat; (void)act; (void)ssq1; (void)ssq2; (void)modl; (void)ybuf;
        EpiResid e; e.gscale = 1.f; e.y = ybuf; e.gate = modl + 2048; e.ng = p.in[11] + l * 1024; e.nsc = modl + 4096; e.abuf = abuf; e.ssq_out = ssq2;
        const bf16_t* W = (const bf16_t*)(ws + OFF_OWOUT) + (size_t)li * 1024 * 1024;
#if PROBE_RESID
        e.gscale = 0.f;
        for (int t = bid; t < 64 * 4; t += nb) gemm_tile<192, 4>(cat, 1024, W, 1024, (t % 64) * 192, (t / 64) * 256, e, smem);
        e.gscale = 1.f; __syncthreads();
#endif
        for (int t = bid; t < 64 * 4; t += nb) gemm_tile<192, 4>(cat, 1024, W, 1024, (t % 64) * 192, (t / 64) * 256, e, smem);
      }
#endif
      xcd_barrier(xb);
    }
#ifndef SKIP_M1
    {
        unsigned char* ws = uniform_ptr(ws_); float* ybuf = (float*)uniform_ptr(out_); asm volatile("" : "+s"(ws), "+s"(ybuf));
        float* mod = (float*)(ws + OFF_MOD); bf16_t* abuf = (bf16_t*)(ws + OFF_ABUF); bf16_t* cat = (bf16_t*)(ws + OFF_CAT); bf16_t* act = (bf16_t*)(ws + OFF_ACT);
        float* ssq1 = (float*)(ws + OFF_SSQ1); float* ssq2 = (float*)(ws + OFF_SSQ2); const float* modl = mod + (size_t)l * 9 * 6144;
        (void)mod; (void)abuf; (void)cat; (void)act; (void)ssq1; (void)ssq2; (void)modl; (void)ybuf;
      EpiMlp1 e; e.ssq = ssq2; e.shw = (const float*)(ws + OFF_SHW2) + (size_t)l * 9 * 4096; e.act = act;
      const bf16_t* W = (const bf16_t*)(ws + OFF_W1T) + (size_t)l * 4096 * 1024;
#if PROBE_M1 == 1
      for (int t = bid; t < 48 * 16; t += nb) gemm_tile<256, 2>(abuf, 1024, W, 1024, (t % 48) * 256, (t / 48) * 256, e, smem);
#elif PROBE_M1 == 2
      for (int t = bid; t < 48 * 16; t += nb) gemm_tile<256, 2, true>(abuf, 1024, W, 1024, (t % 48) * 256, (t / 48) * 256, e, smem);
#endif
      for (int t = bid; t < 48 * 16; t += nb) gemm_tile<256, 2>(abuf, 1024, W, 1024, (t % 48) * 256, (t / 48) * 256, e, smem);
    }
#endif
    xcd_barrier(xb);
#ifndef SKIP_M2
    {
        unsigned char* ws = uniform_ptr(ws_); float* ybuf = (float*)uniform_ptr(out_); asm volatile("" : "+s"(ws), "+s"(ybuf));
        float* mod = (float*)(ws + OFF_MOD); bf16_t* abuf = (bf16_t*)(ws + OFF_ABUF); bf16_t* cat = (bf16_t*)(ws + OFF_CAT); bf16_t* act = (bf16_t*)(ws + OFF_ACT);
        float* ssq1 = (float*)(ws + OFF_SSQ1); float* ssq2 = (float*)(ws + OFF_SSQ2); const float* modl = mod + (size_t)l * 9 * 6144;
        (void)mod; (void)abuf; (void)cat; (void)act; (void)ssq1; (void)ssq2; (void)modl; (void)ybuf;
      EpiResid e; e.gscale = 1.f; e.y = ybuf; e.gate = modl + 5120;
      if (l < 3) { e.ng = p.in[10] + (l + 1) * 1024; e.nsc = mod + (size_t)(l + 1) * 9 * 6144 + 1024; } else { e.ng = nullptr; e.nsc = nullptr; }
      e.abuf = abuf; e.ssq_out = ssq1;
      const bf16_t* W = (const bf16_t*)(ws + OFF_W2T) + (size_t)l * 1024 * 4096;
#if PROBE_M2
      e.gscale = 0.f;
      for (int t = bid; t < 64 * 4; t += nb) gemm_tile<192, 4>(act, 4096, W, 4096, (t % 64) * 192, (t / 64) * 256, e, smem);
      e.gscale = 1.f; __syncthreads();
#endif
      for (int t = bid; t < 64 * 4; t += nb) gemm_tile<192, 4>(act, 4096, W, 4096, (t % 64) * 192, (t / 64) * 256, e, smem);
    }
#endif
    if (l < 3) xcd_barrier(xb);
  }
}

static void add_mat(Params& p, int& idx, int& tiles, const float* src, const float* rscale, size_t dst, int K, int N, int Npad, int headpad, int blockdiag) {
  MatDesc& m = p.mats[idx++];
  m.src = src; m.rscale = rscale; m.dst = dst; m.K = K; m.N = N; m.Npad = Npad; m.headpad = headpad; m.tile0 = tiles; m.blockdiag = blockdiag;
  tiles += (K / 128) * (Npad / 64);
}

extern "C" void kernel_launch(void* const* d_in, const int* in_sizes, int n_in, void* d_out, int out_size, void* d_ws, size_t ws_size, hipStream_t stream) {
  if (ws_size < WS_NEED) { fprintf(stderr, "kernel_launch: workspace too small (%zu < %zu)\n", ws_size, (size_t)WS_NEED); return; }
  static int grid_blocks = 0;
  if (!grid_blocks) {
    int dev = 0, cus = 0, per_cu = 0;
    (void)hipGetDevice(&dev);
    (void)hipDeviceGetAttribute(&cus, hipDeviceAttributeMultiprocessorCount, dev);
    (void)hipOccupancyMaxActiveBlocksPerMultiprocessor(&per_cu, fwd_megakernel, NTHREADS, 0);
    if (per_cu < 1) fprintf(stderr, "kernel_launch: occupancy query reports %d blocks per CU\n", per_cu);
    grid_blocks = cus;
  }
  Params p;
  memset(&p, 0, sizeof(p));
  for (int i = 0; i < 30; ++i) p.in[i] = (const float*)d_in[i];
  p.out = (float*)d_out; p.ws = (unsigned char*)d_ws;
  int idx = 0, tiles = 0;
  for (int i = 0; i < 2; ++i) add_mat(p, idx, tiles, p.in[29] + (size_t)i * 1024 * 1024, nullptr, OFF_OWOUT + (size_t)i * 1024 * 1024 * 2, 1024, 1024, 1024, 0, 2 + i);
  for (int l = 0; l < 4; ++l) add_mat(p, idx, tiles, p.in[12] + (size_t)l * 1024 * 4096, nullptr, OFF_W1T + (size_t)l * 4096 * 1024 * 2, 1024, 4096, 4096, 0, 0);
  for (int l = 0; l < 4; ++l) add_mat(p, idx, tiles, p.in[13] + (size_t)l * 4096 * 1024, nullptr, OFF_W2T + (size_t)l * 4096 * 1024 * 2, 4096, 1024, 1024, 0, 0);
  for (int i = 0; i < 2; ++i) add_mat(p, idx, tiles, p.in[14] + (size_t)i * 1024 * 3072, nullptr, OFF_EWIN + (size_t)i * 3072 * 1024 * 2, 1024, 3072, 3072, 0, 0);
  for (int i = 0; i < 2; ++i) add_mat(p, idx, tiles, p.in[19] + (size_t)i * 1024 * 1024, nullptr, OFF_EWOUT + (size_t)i * 1024 * 1024 * 2, 1024, 1024, 1024, 0, 0);
  for (int i = 0; i < 2; ++i) add_mat(p, idx, tiles, p.in[20] + (size_t)i * 1024 * 1184, nullptr, OFF_OWIN + (size_t)i * 1280 * 1024 * 2, 1024, 1184, 1280, 0, 0);
  for (int i = 0; i < 2; ++i) add_mat(p, idx, tiles, p.in[24] + (size_t)i * 384 * 768, p.in[23] + i * 384, OFF_WQB + (size_t)i * 1024 * 384 * 2, 384, 768, 1024, 1, 0);
  for (int i = 0; i < 2; ++i) add_mat(p, idx, tiles, p.in[26] + (size_t)i * 256 * 1024, p.in[25] + i * 256, OFF_WKVB + (size_t)i * 1024 * 256 * 2, 256, 1024, 1024, 0, 0);
  p.conv_tiles = tiles;
  if (hipMemsetAsync((unsigned char*)d_ws + OFF_BAR, 0, 16384, stream) != hipSuccess) { fprintf(stderr, "kernel_launch: memset of barrier words failed\n"); return; }
  void* args[] = {&p};
  hipError_t e = hipLaunchCooperativeKernel((void*)fwd_megakernel, dim3(grid_blocks), dim3(NTHREADS), args, 0, stream);
  if (e != hipSuccess) fprintf(stderr, "cooperative launch failed: %s (grid %d)\n", hipGetErrorString(e), grid_blocks);
}
```

```cpp
#include <hip/hip_runtime.h>
#include <hip/hip_cooperative_groups.h>
#include <cstdio>
#include <cstdint>
#include <cstring>
namespace cg = cooperative_groups;

typedef unsigned short bf16_t;
using bf16x8 = __attribute__((ext_vector_type(8))) short;
using f32x16 = __attribute__((ext_vector_type(16))) float;
typedef __bf16 bf16v2 __attribute__((ext_vector_type(2)));
typedef unsigned u32x4 __attribute__((ext_vector_type(4)));
typedef unsigned u32x2 __attribute__((ext_vector_type(2)));
typedef float f32x4 __attribute__((ext_vector_type(4)));
#define DI __device__ __forceinline__
#define MFMA(a, b, c) __builtin_amdgcn_mfma_f32_32x32x16_bf16((a), (b), (c), 0, 0, 0)
#define CROW(i, h) (((i) & 3) + 8 * ((i) >> 2) + 4 * (h))

#ifndef REP_PH0
#define REP_PH0 1
#endif
#ifndef REP_PH1
#define REP_PH1 1
#endif
#ifndef REP_E2
#define REP_E2 1
#endif
#ifndef REP_E3
#define REP_E3 1
#endif
#ifndef REP_O3
#define REP_O3 1
#endif
#ifndef REP_O4
#define REP_O4 1
#endif
#ifndef REP_M1
#define REP_M1 1
#endif
#ifndef REP_MODS
#define REP_MODS 1
#endif
#ifndef REP_WCONV
#define REP_WCONV 1
#endif
#ifndef REP_CACHE
#define REP_CACHE 1
#endif

#ifndef PROBE_M1
#define PROBE_M1 0
#endif
#ifndef REP_PH0
#define REP_PH0 1
#endif
#ifndef REP_PH1
#define REP_PH1 1
#endif
#ifndef REP_E2
#define REP_E2 1
#endif
#ifndef REP_E3
#define REP_E3 1
#endif
#ifndef REP_O2
#define REP_O2 1
#endif
#ifndef REP_O3
#define REP_O3 1
#endif
#ifndef REP_O4
#define REP_O4 1
#endif
#ifndef PROBE_RESID
#define PROBE_RESID 0
#endif
#ifndef PROBE_M2
#define PROBE_M2 0
#endif
constexpr int T = 12288, TP = 4096;
constexpr float EPS = 1e-6f;
constexpr int NTHREADS = 512;
constexpr int NWAVES = 8;
constexpr int SMEM_BYTES = 147456 + 8192;
constexpr int SIDE_OFF = 147456;

constexpr size_t al(size_t x) { return (x + 255) & ~size_t(255); }
constexpr size_t OFF_BAR   = 0;
constexpr size_t OFF_MOD   = 16384;
constexpr size_t OFF_SHW1  = al(OFF_MOD + 4ull * 9 * 6144 * 4);
constexpr size_t OFF_SHW2  = al(OFF_SHW1 + 4ull * 9 * 3072 * 4);
constexpr size_t OFF_SSQ1  = al(OFF_SHW2 + 4ull * 9 * 4096 * 4);
constexpr size_t OFF_SSQ2  = al(OFF_SSQ1 + 16ull * T * 4);
constexpr size_t OFF_SSQQ  = al(OFF_SSQ2 + 16ull * T * 4);
constexpr size_t OFF_SSQKV = al(OFF_SSQQ + 3ull * T * 4);
constexpr size_t OFF_KPE   = al(OFF_SSQKV + 2ull * T * 4);
constexpr size_t OFF_KVRAW = al(OFF_KPE + (size_t)T * 32 * 4);
constexpr size_t OFF_CNK   = al(OFF_KVRAW + 4096ull * 256 * 4);
constexpr size_t OFF_CNVT  = al(OFF_CNK + 2ull * 2048 * 512 * 2);
constexpr size_t OFF_CCKV  = al(OFF_CNVT + 2ull * 2048 * 512 * 2);
constexpr size_t OFF_W1T   = al(OFF_CCKV + 2ull * 2048 * 256 * 2);
constexpr size_t OFF_W2T   = al(OFF_W1T + 4ull * 4096 * 1024 * 2);
constexpr size_t OFF_EWIN  = al(OFF_W2T + 4ull * 4096 * 1024 * 2);
constexpr size_t OFF_EWOUT = al(OFF_EWIN + 2ull * 3072 * 1024 * 2);
constexpr size_t OFF_OWIN  = al(OFF_EWOUT + 2ull * 1024 * 1024 * 2);
constexpr size_t OFF_WQB   = al(OFF_OWIN + 2ull * 1280 * 1024 * 2);
constexpr size_t OFF_WKVB  = al(OFF_WQB + 2ull * 1024 * 384 * 2);
constexpr size_t OFF_OWOUT = al(OFF_WKVB + 2ull * 1024 * 256 * 2);
constexpr size_t OFF_POOLW = al(OFF_OWOUT + 2ull * 1024 * 1024 * 2);
constexpr size_t OFF_ABUF  = al(OFF_POOLW + 2ull * 512 * 512 * 2);
constexpr size_t OFF_CAT   = al(OFF_ABUF + (size_t)T * 1024 * 2);
constexpr size_t OFF_ACT   = al(OFF_CAT + (size_t)T * 1024 * 2);
constexpr size_t WS_NEED   = al(OFF_ACT + (size_t)T * 4096 * 2);
constexpr size_t OFF_BCONV = OFF_ACT;
constexpr size_t OFF_QBUF  = al(OFF_BCONV + (size_t)T * 1536 * 2);
constexpr size_t OFF_KBUF  = al(OFF_QBUF + (size_t)T * 512 * 2);
constexpr size_t OFF_VTP   = al(OFF_KBUF + (size_t)T * 512 * 2);
constexpr size_t OFF_VTS   = al(OFF_VTP + 16ull * 8 * 64 * 256 * 2);
constexpr size_t OFF_UBUF  = OFF_ACT;
constexpr size_t OFF_QLAT  = al(OFF_UBUF + (size_t)T * 512 * 2);
constexpr size_t OFF_KVLAT = al(OFF_QLAT + (size_t)T * 384 * 2);
constexpr size_t OFF_XP    = al(OFF_KVLAT + (size_t)T * 256 * 2);
constexpr size_t OFF_QMLA  = al(OFF_XP + (size_t)T * 512 * 2);
constexpr size_t OFF_KPM   = al(OFF_QMLA + (size_t)T * 768 * 2);
constexpr size_t OFF_KSM   = al(OFF_KPM + 16ull * 8 * 256 * 96 * 2);
constexpr size_t OFF_VTPM  = al(OFF_KSM + 8ull * 8 * 1280 * 96 * 2);
constexpr size_t OFF_VTSM  = al(OFF_VTPM + 16ull * 8 * 64 * 256 * 2);
static_assert(OFF_VTSM + 8ull * 8 * 64 * 1280 * 2 <= WS_NEED, "odd buffers overflow");
static_assert(OFF_VTS + 8ull * 8 * 64 * 1024 * 2 <= WS_NEED, "even buffers overflow");

constexpr size_t OUT_Y   = 0;
constexpr size_t OUT_NAK = (size_t)T * 1024;
constexpr size_t OUT_NAV = OUT_NAK + 16ull * 2 * 256 * 512;
constexpr size_t OUT_CKV = OUT_NAV + 16ull * 2 * 256 * 512;
constexpr size_t OUT_KPE = OUT_CKV + 16ull * 2 * 256 * 256;

struct MatDesc { const float* src; const float* rscale; unsigned long long dst; int K, N, Npad, headpad, tile0, blockdiag; };
constexpr int NMATS = 20;
struct Params {
  const float* in[30];
  float* out;
  unsigned char* ws;
  MatDesc mats[NMATS];
  int conv_tiles;
  int pad_;
};

__device__ __forceinline__ f32x4 make_f32x4(float a, float b, float c, float d) { f32x4 v = {a, b, c, d}; return v; }
#define GAS __attribute__((address_space(1)))
template <class T> DI void gst(T* p, const T& v) { *(GAS T*)p = v; }
template <class T> DI T gld_nt(const T* p) { return __builtin_nontemporal_load((const GAS T*)p); }
template <class T> DI T gld(const T* p) { return *(const GAS T*)p; }
DI unsigned char* uniform_ptr(const void* p) { const unsigned long long v = (unsigned long long)p; const unsigned lo = __builtin_amdgcn_readfirstlane((unsigned)v), hi = __builtin_amdgcn_readfirstlane((unsigned)(v >> 32)); return (unsigned char*)(((unsigned long long)hi << 32) | lo); }
DI int otid() { int t = threadIdx.x; asm volatile("" : "+v"(t)); return t; }
DI unsigned pack2(float a, float b) { bf16v2 v = {(__bf16)a, (__bf16)b}; return __builtin_bit_cast(unsigned, v); }
DI bf16_t f2bf(float a) { return __builtin_bit_cast(unsigned short, (__bf16)a); }
DI float bf2f(unsigned v16) { return __uint_as_float(v16 << 16); }
DI float bflo(unsigned u) { return __uint_as_float(u << 16); }
DI float bfhi(unsigned u) { return __uint_as_float(u & 0xffff0000u); }
DI int mi_of(int m) { return m < TP ? 0 : 1 + ((m - TP) >> 10); }
DI float xor32(float v) { return __shfl_xor(v, 32, 64); }
template <int CTRL> DI float dpp_get(float v) { return __uint_as_float((unsigned)__builtin_amdgcn_update_dpp(0, (int)__float_as_uint(v), CTRL, 0xf, 0xf, true)); }
DI float sum16(float v) { v += dpp_get<0xB1>(v); v += dpp_get<0x4E>(v); v += dpp_get<0x141>(v); v += dpp_get<0x140>(v); return v; }
DI float hsum32(float v) { const u32x2 r = __builtin_amdgcn_permlane32_swap(__float_as_uint(v), __float_as_uint(v), false, false); return __uint_as_float(r.x) + __uint_as_float(r.y); }
DI float hmax32(float v) { const u32x2 r = __builtin_amdgcn_permlane32_swap(__float_as_uint(v), __float_as_uint(v), false, false); return fmaxf(__uint_as_float(r.x), __uint_as_float(r.y)); }
DI void store_bf4(bf16_t* p, float a, float b, float c, float d) { u32x2 u; u.x = pack2(a, b); u.y = pack2(c, d); *(GAS u32x2*)p = u; }
template <int NP> DI float rstd_parts(const float* ssq, int m, float invn) {
  float v[NP];
#pragma unroll
  for (int p = 0; p < NP; ++p) v[p] = gld(ssq + (size_t)p * T + m);
  float s = 0.f;
#pragma unroll
  for (int p = 0; p < NP; ++p) s += v[p];
  return rsqrtf(s * invn + EPS);
}

#define XB_TMO      128
#define XB_XCNT(j)  (256  + 64 * (j))
#define XB_XSUB(j)  (1280 + 64 * (j))
#define XB_XGEN(j)  (2304 + 64 * (j))
#define XB_TOP      3328
#define XB_TOPGEN   3392
#define XCD_BAR_WORDS 3456
#define XB_SPIN_CAP (1u << 20)
#define LAS __attribute__((address_space(3)))
DI unsigned xb_ld(unsigned* p)              { return __hip_atomic_load(p, __ATOMIC_RELAXED, __HIP_MEMORY_SCOPE_AGENT); }
DI unsigned xb_add(unsigned* p, unsigned v) { return __hip_atomic_fetch_add(p, v, __ATOMIC_RELAXED, __HIP_MEMORY_SCOPE_AGENT); }
DI unsigned xb_xcc_id() { return (unsigned)__builtin_amdgcn_s_getreg((3 << 11) | 20) & 0xFu; }
#define XB_SPIN(cond, bar) do { unsigned _sp = 0; while (cond) { __builtin_amdgcn_s_sleep(1); \
    if ((++_sp & 255u) == 0u) { if (xb_ld(&(bar)[XB_TMO])) break; if (_sp > XB_SPIN_CAP) { atomicAdd(&(bar)[XB_TMO], 1u); break; } } } } while (0)
struct XcdBarrier { unsigned* bar; unsigned x; volatile LAS unsigned* st; };
DI XcdBarrier xcd_barrier_post(unsigned* bar, volatile LAS unsigned* st) {
  XcdBarrier b; b.bar = bar; b.x = xb_xcc_id(); b.st = st;
  if (threadIdx.x == 0) (void)xb_add(&bar[XB_XCNT(b.x)], 1u);
  return b;
}
DI void xcd_barrier_complete(unsigned* bar, unsigned x, unsigned& nloc, unsigned& nx) {
  const unsigned G = gridDim.x * gridDim.y * gridDim.z;
  unsigned sum, cnt, mine, sp = 0u;
  for (;;) {
    sum = 0u; cnt = 0u; mine = 0u;
#pragma unroll
    for (unsigned j = 0; j < 16; ++j) { const unsigned c = xb_ld(&bar[XB_XCNT(j)]); sum += c; cnt += (c > 0u) ? 1u : 0u; mine = (j == x) ? c : mine; }
    if (sum == G) break;
    __builtin_amdgcn_s_sleep(1);
    if ((++sp & 255u) == 0u) { if (xb_ld(&bar[XB_TMO])) break; if (sp > XB_SPIN_CAP) { atomicAdd(&bar[XB_TMO], 1u); break; } }
  }
  nloc = mine > 0u ? mine : 1u; nx = cnt > 0u ? cnt : 1u;
}
DI void xcd_barrier(const XcdBarrier& b) {
  asm volatile("s_waitcnt vmcnt(0)" ::: "memory");
  __syncthreads();
  if (threadIdx.x == 0) {
    unsigned* bar = b.bar;
    __builtin_amdgcn_s_waitcnt(0);
    unsigned nloc = b.st[0], nx = b.st[1];
    if (nloc == 0u) { xcd_barrier_complete(bar, b.x, nloc, nx); b.st[0] = nloc; b.st[1] = nx; }
    const unsigned old = xb_add(&bar[XB_XSUB(b.x)], 1u);
    const unsigned gen = old / nloc;
    if (old + 1u == (gen + 1u) * nloc) {
      __builtin_amdgcn_fence(__ATOMIC_RELEASE, "agent");
      asm volatile("s_waitcnt vmcnt(0)" ::: "memory");
      const unsigned og = xb_add(&bar[XB_TOP], 1u);
      const unsigned tg = og / nx;
      if (og + 1u == (tg + 1u) * nx) xb_add(&bar[XB_TOPGEN], 1u);
      else XB_SPIN(xb_ld(&bar[XB_TOPGEN]) == tg, bar);
      __builtin_amdgcn_fence(__ATOMIC_ACQUIRE, "agent");
      xb_add(&bar[XB_XGEN(b.x)], 1u);
      asm volatile("s_waitcnt vmcnt(0)" ::: "memory");
    } else {
      XB_SPIN(xb_ld(&bar[XB_XGEN(b.x)]) == gen, bar);
      __builtin_amdgcn_fence(__ATOMIC_ACQUIRE, "agent");
      asm volatile("s_waitcnt vmcnt(0)" ::: "memory");
    }
  }
  __syncthreads();
}

typedef __attribute__((address_space(3))) unsigned lds_u32_t;
template <int OFF> DI bf16x8 lds_rd128(unsigned addr) { bf16x8 v; asm volatile("ds_read_b128 %0, %1 offset:%2" : "=v"(v) : "v"(addr), "n"(OFF) : "memory"); return v; }
template <int N, int NW, int NA> DI void lgkm_wait(bf16x8 (&wf)[NW], bf16x8 (&af)[NA]) {
  if constexpr (NW == 4 && NA == 2) asm volatile("s_waitcnt lgkmcnt(%6)" : "+v"(wf[0]), "+v"(wf[1]), "+v"(wf[2]), "+v"(wf[3]), "+v"(af[0]), "+v"(af[1]) : "n"(N) : "memory");
  else if constexpr (NW == 2 && NA == 3) asm volatile("s_waitcnt lgkmcnt(%5)" : "+v"(wf[0]), "+v"(wf[1]), "+v"(af[0]), "+v"(af[1]), "+v"(af[2]) : "n"(N) : "memory");
  else asm volatile("s_waitcnt lgkmcnt(%5)" : "+v"(wf[0]), "+v"(wf[1]), "+v"(wf[2]), "+v"(wf[3]), "+v"(af[0]) : "n"(N) : "memory");
}
template <int TM, int WNW, bool DRY = false, class Epi>
DI void gemm_tile(const bf16_t* __restrict__ A, int lda, const bf16_t* __restrict__ W, int K, int m0, int n0, const Epi& epi, unsigned char* smem) {
  constexpr int WMW = 8 / WNW, NT = 256 / WNW / 32, MT = TM / WMW / 32, NLA = TM / 64, WAVE_N = 256 / WNW, WAVE_M = TM / WMW;
  constexpr int STAGE = (TM + 256) * 128;
  static_assert((NT == 4 && MT == 2) || (NT == 2 && MT == 3) || (NT == 4 && MT == 1), "fragment wait helper covers these shapes");
  const int tid = otid(), lane = tid & 63, w = tid >> 6, r = lane & 31, h = lane >> 5;
  const int wn = w % WNW, wm = w / WNW;
  f32x16 acc[NT][MT];
#pragma unroll
  for (int a = 0; a < NT; ++a)
#pragma unroll
    for (int b = 0; b < MT; ++b)
#pragma unroll
      for (int i = 0; i < 16; ++i) acc[a][b][i] = 0.f;
  const int KT = K >> 6;
  const int lrow = tid >> 3, lkc = (tid & 7) ^ ((tid >> 4) & 7);
  typedef const __attribute__((address_space(1))) unsigned* gsrc_t;
  const bf16_t* ga = A + (size_t)(m0 + lrow) * lda + lkc * 8;
  const bf16_t* gw = W + (size_t)(n0 + lrow) * K + lkc * 8;
#define DMA_TILE(KT_, ST_) do { \
    unsigned char* sa_ = smem + (ST_) * STAGE + tid * 16; \
    _Pragma("unroll") for (int i = 0; i < NLA; ++i) \
      __builtin_amdgcn_global_load_lds((gsrc_t)(ga + (size_t)(64 * i) * lda + (KT_) * 64), (lds_u32_t*)(sa_ + i * 8192), 16, 0, 0); \
    _Pragma("unroll") for (int i = 0; i < 4; ++i) \
      __builtin_amdgcn_global_load_lds((gsrc_t)(gw + (size_t)(64 * i) * K + (KT_) * 64), (lds_u32_t*)(sa_ + TM * 128 + i * 8192), 16, 0, 0); } while (0)
  __syncthreads();
  epi.side(n0, m0, tid, smem + SIDE_OFF);
  DMA_TILE(0, 0);
  const int swz = (r >> 1) & 7;
  const unsigned lbase = (unsigned)(size_t)smem;
  const unsigned offw = lbase + TM * 128 + (wn * WAVE_N + r) * 128, offa = lbase + (wm * WAVE_M + r) * 128;
  unsigned cx[4];
#pragma unroll
  for (int ks = 0; ks < 4; ++ks) cx[ks] = ((2 * ks + h) ^ swz) << 4;
#define FRAGS(BUF, KS_) do { \
    wf[BUF][0] = lds_rd128<0>(pw + cx[KS_]); wf[BUF][1] = lds_rd128<4096>(pw + cx[KS_]); \
    if constexpr (NT == 4) { wf[BUF][2] = lds_rd128<8192>(pw + cx[KS_]); wf[BUF][3] = lds_rd128<12288>(pw + cx[KS_]); } \
    af[BUF][0] = lds_rd128<0>(pa + cx[KS_]); \
    if constexpr (MT >= 2) af[BUF][1] = lds_rd128<4096>(pa + cx[KS_]); \
    if constexpr (MT >= 3) af[BUF][2] = lds_rd128<8192>(pa + cx[KS_]); } while (0)
#define MMAS(BUF) do { _Pragma("unroll") for (int a = 0; a < NT; ++a) _Pragma("unroll") for (int b = 0; b < MT; ++b) acc[a][b] = MFMA(wf[BUF][a], af[BUF][b], acc[a][b]); } while (0)
  for (int kt = 0; kt < KT; ++kt) {
    asm volatile("s_waitcnt vmcnt(0)" ::: "memory");
    __syncthreads();
    if (kt + 1 < KT) DMA_TILE(kt + 1, (kt + 1) & 1);
    __builtin_amdgcn_sched_barrier(0);
    const unsigned pw = offw + (kt & 1) * STAGE, pa = offa + (kt & 1) * STAGE;
    bf16x8 wf[2][NT], af[2][MT];
    FRAGS(0, 0);
    FRAGS(1, 1);
    lgkm_wait<NT + MT>(wf[0], af[0]);
    MMAS(0);
    __builtin_amdgcn_sched_barrier(0);
    FRAGS(0, 2);
    lgkm_wait<NT + MT>(wf[1], af[1]);
    MMAS(1);
    __builtin_amdgcn_sched_barrier(0);
    FRAGS(1, 3);
    lgkm_wait<NT + MT>(wf[0], af[0]);
    MMAS(0);
    __builtin_amdgcn_sched_barrier(0);
    lgkm_wait<0>(wf[1], af[1]);
    MMAS(1);
    __builtin_amdgcn_sched_barrier(0);
  }
#undef DMA_TILE
#undef FRAGS
#undef MMAS
  if (DRY) {
    float sdry = 0.f;
#pragma unroll
    for (int a = 0; a < NT; ++a)
#pragma unroll
      for (int b = 0; b < MT; ++b)
#pragma unroll
        for (int i = 0; i < 16; ++i) sdry += acc[a][b][i];
    if (sdry != 12345.678f) return;
  }
  __syncthreads();
  epi(acc, n0 + wn * WAVE_N, m0 + wm * WAVE_M, lane, smem + w * 9216, smem + SIDE_OFF, n0, m0);
}

struct EpiEvenIn {
  const float* ssq; const float* shw; const float* gq; const float* gk;
  bf16_t* bconv; bf16_t* qbuf; bf16_t* kbuf; bf16_t* vtp; bf16_t* vts; float* out_k; float* out_v; int li;
  DI void side(int n0, int m0, int tid, unsigned char* sd) const {
    float* f = (float*)sd;
    if (tid < 192) f[tid] = rstd_parts<16>(ssq, m0 + tid, 1.f / 1024.f);
    const int mi = mi_of(tid < 256 ? m0 : m0 + 191);
    f[192 + tid] = gld(shw + mi * 3072 + n0 + (tid & 255));
  }
  template <int MT> DI void operator()(f32x16 (&acc)[2][MT], int nb, int mb, int lane, unsigned char* wlds, const unsigned char* side, int n0, int m0) const {
    const int r = lane & 31, h = lane >> 5;
    const int region = nb >> 9;
#pragma unroll
    for (int mt = 0; mt < MT; ++mt) {
      const int m = mb + mt * 32 + r;
      const float* sf = (const float*)side;
      const float rs = sf[m - m0];
      const float* sw = sf + 192 + (mi_of(m) != mi_of(m0) ? 256 : 0) + (nb - n0);
      float ss = 0.f;
#pragma unroll
      for (int nt = 0; nt < 2; ++nt)
#pragma unroll
        for (int g = 0; g < 4; ++g) {
          const f32x4 s4 = *(const f32x4*)(sw + nt * 32 + 8 * g + 4 * h);
          acc[nt][mt][4 * g + 0] = rs * acc[nt][mt][4 * g + 0] + s4.x;
          acc[nt][mt][4 * g + 1] = rs * acc[nt][mt][4 * g + 1] + s4.y;
          acc[nt][mt][4 * g + 2] = rs * acc[nt][mt][4 * g + 2] + s4.z;
          acc[nt][mt][4 * g + 3] = rs * acc[nt][mt][4 * g + 3] + s4.w;
#pragma unroll
          for (int j = 0; j < 4; ++j) ss += acc[nt][mt][4 * g + j] * acc[nt][mt][4 * g + j];
        }
      if (region < 3) {
#pragma unroll
        for (int nt = 0; nt < 2; ++nt)
#pragma unroll
          for (int g = 0; g < 4; ++g)
            store_bf4(bconv + (size_t)m * 1536 + nb + nt * 32 + 8 * g + 4 * h, acc[nt][mt][4 * g], acc[nt][mt][4 * g + 1], acc[nt][mt][4 * g + 2], acc[nt][mt][4 * g + 3]);
      } else if (region < 5) {
        const bool isk = region == 4;
        const float* gain = isk ? gk : gq;
        bf16_t* dst = (isk ? kbuf : qbuf) + (size_t)m * 512 + (nb - (isk ? 2048 : 1536));
        float* od = nullptr;
        if (isk && m < TP) od = out_k + ((size_t)(((m >> 8) * 2 + li) * 256 + (m & 255))) * 512 + (nb - 2048);
        ss = hsum32(ss);
        const float rn = rsqrtf(ss * (1.f / 64.f) + EPS);
#pragma unroll
        for (int nt = 0; nt < 2; ++nt)
#pragma unroll
          for (int g = 0; g < 4; ++g) {
            const int d = nt * 32 + 8 * g + 4 * h;
            const f32x4 g4 = gld((const f32x4*)(gain + d));
            const float o0 = acc[nt][mt][4 * g] * rn * g4.x, o1 = acc[nt][mt][4 * g + 1] * rn * g4.y, o2 = acc[nt][mt][4 * g + 2] * rn * g4.z, o3 = acc[nt][mt][4 * g + 3] * rn * g4.w;
            store_bf4(dst + d, o0, o1, o2, o3);
            if (od) *(GAS f32x4*)(od + d) = make_f32x4(o0, o1, o2, o3);
          }
      } else {
        const bool pr = m < TP;
        const int s = m - TP;
        const int hd = (nb - 2560) >> 6;
        float* od = pr ? out_v + ((size_t)(((m >> 8) * 2 + li) * 256 + (m & 255))) * 512 + (nb - 2560) : nullptr;
        bf16_t* vt0 = pr ? vtp + ((size_t)((m >> 8) * 8 + hd) * 64) * 256 + (m & 255) : vts + ((size_t)((s >> 10) * 8 + hd) * 64) * 1024 + (s & 1023);
        const int st = pr ? 256 : 1024;
#pragma unroll
        for (int nt = 0; nt < 2; ++nt)
#pragma unroll
          for (int g = 0; g < 4; ++g) {
            const int d = nt * 32 + 8 * g + 4 * h;
#pragma unroll
            for (int j = 0; j < 4; ++j) gst(vt0 + (size_t)(d + j) * st, f2bf(acc[nt][mt][4 * g + j]));
            if (pr) *(GAS f32x4*)(od + d) = make_f32x4(acc[nt][mt][4 * g], acc[nt][mt][4 * g + 1], acc[nt][mt][4 * g + 2], acc[nt][mt][4 * g + 3]);
          }
      }
    }
  }
};

struct EpiResid {
  float* y; const float* gate; const float* ng; const float* nsc; bf16_t* abuf; float* ssq_out; float gscale;
  DI void side(int n0, int m0, int tid, unsigned char* sd) const {
    float* f = (float*)sd;
    const int mi = mi_of(tid < 256 ? m0 : m0 + 191), n = n0 + (tid & 255);
    f[tid] = gld(gate + mi * 6144 + n) * gscale;
    f[512 + tid] = ng ? gld(ng + n) * (1.f + gld(nsc + mi * 6144 + n)) : 0.f;
  }
  template <int MT> DI void operator()(f32x16 (&acc)[2][MT], int nb, int mb, int lane, unsigned char* wlds, const unsigned char* side, int n0, int m0) const {
    const int r = lane & 31, h = lane >> 5, cc = lane & 15, rq = lane >> 4;
    const int mi0 = mi_of(m0);
#pragma unroll
    for (int mt = 0; mt < MT; ++mt) {
#pragma unroll
      for (int nt = 0; nt < 2; ++nt)
#pragma unroll
        for (int g = 0; g < 4; ++g)
          *(f32x4*)(wlds + r * 272 + (nt * 32 + 8 * g + 4 * h) * 4) = make_f32x4(acc[nt][mt][4 * g], acc[nt][mt][4 * g + 1], acc[nt][mt][4 * g + 2], acc[nt][mt][4 * g + 3]);
#pragma unroll
      for (int i = 0; i < 8; ++i) {
        const int row = rq + 4 * i;
        const int m = mb + mt * 32 + row, n = nb + cc * 4;
        const float* sf = (const float*)side + (mi_of(m) != mi0 ? 256 : 0) + (n - n0);
        const f32x4 a = *(const f32x4*)(wlds + row * 272 + cc * 16);
        f32x4 yo = gld((const f32x4*)(y + (size_t)m * 1024 + n));
        const f32x4 gt = *(const f32x4*)sf;
        yo.x += gt.x * a.x; yo.y += gt.y * a.y; yo.z += gt.z * a.z; yo.w += gt.w * a.w;
        *(GAS f32x4*)(y + (size_t)m * 1024 + n) = yo;
        if (ng) {
          const f32x4 gg = *(const f32x4*)(sf + 512);
          store_bf4(abuf + (size_t)m * 1024 + n, yo.x * gg.x, yo.y * gg.y, yo.z * gg.z, yo.w * gg.w);
          float ss = yo.x * yo.x + yo.y * yo.y + yo.z * yo.z + yo.w * yo.w;
          ss = sum16(ss);
          if (cc == 0) gst(ssq_out + (size_t)(nb >> 6) * T + m, ss);
        }
      }
    }
  }
};

struct EpiMlp1 {
  const float* ssq; const float* shw; bf16_t* act;
  DI void side(int n0, int m0, int tid, unsigned char* sd) const {
    float* f = (float*)sd;
    if (tid < 256) f[tid] = rstd_parts<16>(ssq, m0 + tid, 1.f / 1024.f);
    else f[tid] = gld(shw + mi_of(m0) * 4096 + n0 + (tid - 256));
  }
  template <int NT, int MT> DI void operator()(f32x16 (&acc)[NT][MT], int nb, int mb, int lane, unsigned char* wlds, const unsigned char* side, int n0, int m0) const {
    const int r = lane & 31, h = lane >> 5;
    constexpr int RS = NT * 64 + 16;
    constexpr int CPR = NT * 4;
#pragma unroll
    for (int mt = 0; mt < MT; ++mt) {
      const float* sf = (const float*)side;
      const float rs = sf[mb - m0 + mt * 32 + r];
#pragma unroll
      for (int nt = 0; nt < NT; ++nt)
#pragma unroll
        for (int g = 0; g < 4; ++g) {
          const int nl = nt * 32 + 8 * g + 4 * h;
          const f32x4 s4 = *(const f32x4*)(sf + 256 + (nb - n0) + nl);
          float v0 = fmaxf(rs * acc[nt][mt][4 * g] + s4.x, 0.f), v1 = fmaxf(rs * acc[nt][mt][4 * g + 1] + s4.y, 0.f);
          float v2 = fmaxf(rs * acc[nt][mt][4 * g + 2] + s4.z, 0.f), v3 = fmaxf(rs * acc[nt][mt][4 * g + 3] + s4.w, 0.f);
          u32x2 u; u.x = pack2(v0 * v0, v1 * v1); u.y = pack2(v2 * v2, v3 * v3);
          *(u32x2*)(wlds + r * RS + nl * 2) = u;
        }
#pragma unroll
      for (int i = 0; i < 32 * CPR / 64; ++i) {
        const int c = lane + 64 * i, row = c / CPR, cc = c % CPR;
        const u32x4 v = *(const u32x4*)(wlds + row * RS + cc * 16);
        *(GAS u32x4*)(act + (size_t)(mb + mt * 32 + row) * 4096 + nb + cc * 8) = v;
      }
    }
  }
};

struct EpiOddIn {
  const float* ssq; const float* shw; bf16_t* ubuf; bf16_t* qlat; bf16_t* kvlat; float* kpebuf; float* ssqq; float* ssqkv; float* out_ckv; float* out_kpe; int li;
  DI void side(int n0, int m0, int tid, unsigned char* sd) const {
    float* f = (float*)sd;
    if (tid < 256) f[tid] = rstd_parts<16>(ssq, m0 + tid, 1.f / 1024.f);
    else f[tid] = gld(shw + mi_of(m0) * 3072 + n0 + (tid - 256));
  }
  template <int MT> DI void operator()(f32x16 (&acc)[4][MT], int nb, int mb, int lane, unsigned char* wlds, const unsigned char* side, int n0, int m0) const {
    const int r = lane & 31, h = lane >> 5;
#pragma unroll
    for (int mt = 0; mt < MT; ++mt) {
      __builtin_amdgcn_sched_barrier(0);
      const int m = mb + mt * 32 + r;
      const float* sf = (const float*)side;
      const float rs = sf[m - m0];
      const float* sw = sf + 256 + (nb - n0);
      float ss = 0.f;
#pragma unroll
      for (int nt = 0; nt < 4; ++nt)
#pragma unroll
        for (int g = 0; g < 4; ++g) {
          const f32x4 s4 = *(const f32x4*)(sw + nt * 32 + 8 * g + 4 * h);
          acc[nt][mt][4 * g + 0] = rs * acc[nt][mt][4 * g + 0] + s4.x;
          acc[nt][mt][4 * g + 1] = rs * acc[nt][mt][4 * g + 1] + s4.y;
          acc[nt][mt][4 * g + 2] = rs * acc[nt][mt][4 * g + 2] + s4.z;
          acc[nt][mt][4 * g + 3] = rs * acc[nt][mt][4 * g + 3] + s4.w;
#pragma unroll
          for (int j = 0; j < 4; ++j) ss += acc[nt][mt][4 * g + j] * acc[nt][mt][4 * g + j];
        }
      ss = hsum32(ss);
      const size_t prow = (size_t)(((m >> 8) * 2 + li) * 256 + (m & 255));
      if (nb < 512) {
#pragma unroll
        for (int nt = 0; nt < 4; ++nt)
#pragma unroll
          for (int g = 0; g < 4; ++g)
            store_bf4(ubuf + (size_t)m * 512 + nb + nt * 32 + 8 * g + 4 * h, acc[nt][mt][4 * g], acc[nt][mt][4 * g + 1], acc[nt][mt][4 * g + 2], acc[nt][mt][4 * g + 3]);
      } else if (nb < 896) {
#pragma unroll
        for (int nt = 0; nt < 4; ++nt)
#pragma unroll
          for (int g = 0; g < 4; ++g)
            store_bf4(qlat + (size_t)m * 384 + (nb - 512) + nt * 32 + 8 * g + 4 * h, acc[nt][mt][4 * g], acc[nt][mt][4 * g + 1], acc[nt][mt][4 * g + 2], acc[nt][mt][4 * g + 3]);
        if (h == 0) gst(ssqq + (size_t)((nb - 512) >> 7) * T + m, ss);
      } else if (nb < 1152) {
#pragma unroll
        for (int nt = 0; nt < 4; ++nt)
#pragma unroll
          for (int g = 0; g < 4; ++g) {
            const int c = (nb - 896) + nt * 32 + 8 * g + 4 * h;
            store_bf4(kvlat + (size_t)m * 256 + c, acc[nt][mt][4 * g], acc[nt][mt][4 * g + 1], acc[nt][mt][4 * g + 2], acc[nt][mt][4 * g + 3]);
            if (m < TP) *(GAS f32x4*)(out_ckv + (size_t)m * 256 + c) = make_f32x4(acc[nt][mt][4 * g], acc[nt][mt][4 * g + 1], acc[nt][mt][4 * g + 2], acc[nt][mt][4 * g + 3]);
          }
        if (h == 0) gst(ssqkv + (size_t)((nb - 896) >> 7) * T + m, ss);
      } else {
#pragma unroll
        for (int g = 0; g < 4; ++g) {
          const int c = 8 * g + 4 * h;
          const f32x4 v = make_f32x4(acc[0][mt][4 * g], acc[0][mt][4 * g + 1], acc[0][mt][4 * g + 2], acc[0][mt][4 * g + 3]);
          *(GAS f32x4*)(kpebuf + (size_t)m * 32 + c) = v;
          if (m < TP) *(GAS f32x4*)(out_kpe + prow * 32 + c) = v;
        }
      }
    }
  }
};

DI void rope_cs(int j8, float posv, float& c, float& s) {
  const float inv = __builtin_amdgcn_exp2f(-1.6609640474436813f * (float)j8);
  const float ang = posv * inv;
  c = __cosf(ang); s = __sinf(ang);
}

struct EpiQUp {
  DI void side(int, int, int, unsigned char*) const {}
  const float* ssqq; const float* gq; bf16_t* qmla;
  template <int MT> DI void operator()(f32x16 (&acc)[4][MT], int nb, int mb, int lane, unsigned char* wlds, const unsigned char* side, int n0, int m0) const {
   const int r = lane & 31, h = lane >> 5, hd = nb >> 7;
#pragma unroll
   for (int mt = 0; mt < MT; ++mt) {
    __builtin_amdgcn_sched_barrier(0);
    const int m = mb + mt * 32 + r;
    const float rq = rstd_parts<3>(ssqq, m, 1.f / 384.f);
    float ss = 0.f;
#pragma unroll
    for (int nt = 0; nt < 3; ++nt)
#pragma unroll
      for (int i = 0; i < 16; ++i) { acc[nt][mt][i] *= rq; ss += acc[nt][mt][i] * acc[nt][mt][i]; }
    ss = hsum32(ss);
    const float rn = rsqrtf(ss * (1.f / 96.f) + EPS);
#pragma unroll
    for (int nt = 0; nt < 3; ++nt)
#pragma unroll
      for (int g = 0; g < 4; ++g) {
        const f32x4 g4 = gld((const f32x4*)(gq + nt * 32 + 8 * g + 4 * h));
        acc[nt][mt][4 * g] *= rn * g4.x; acc[nt][mt][4 * g + 1] *= rn * g4.y; acc[nt][mt][4 * g + 2] *= rn * g4.z; acc[nt][mt][4 * g + 3] *= rn * g4.w;
      }
    if (m >= TP) {
      const int pos = (m - TP) & 1023;
      const float prow = (float)(pos >> 6), pcol = (float)(pos & 63);
#pragma unroll
      for (int g = 0; g < 2; ++g)
#pragma unroll
        for (int j = 0; j < 4; ++j) {
          float c, s; rope_cs(4 * h + j, g == 0 ? prow : pcol, c, s);
          const float x1 = acc[2][mt][4 * g + j], x2 = acc[2][mt][8 + 4 * g + j];
          acc[2][mt][4 * g + j] = x1 * c - x2 * s;
          acc[2][mt][8 + 4 * g + j] = x2 * c + x1 * s;
        }
    }
#pragma unroll
    for (int nt = 0; nt < 3; ++nt)
#pragma unroll
      for (int g = 0; g < 4; ++g)
        store_bf4(qmla + (size_t)m * 768 + hd * 96 + nt * 32 + 8 * g + 4 * h, acc[nt][mt][4 * g], acc[nt][mt][4 * g + 1], acc[nt][mt][4 * g + 2], acc[nt][mt][4 * g + 3]);
   }
  }
};

struct EpiKvUp {
  DI void side(int, int, int, unsigned char*) const {}
  const float* ssqkv; const float* gk; const float* kpebuf; const float* cache_kpe; bf16_t* kpm; bf16_t* ksm; bf16_t* vtpm; bf16_t* vtsm; int li; int cache;
  template <int MT> DI void operator()(f32x16 (&acc)[4][MT], int nb, int mb, int lane, unsigned char* wlds, const unsigned char* side, int n0, int m0) const {
   const int r = lane & 31, h = lane >> 5, hd = nb >> 7;
#pragma unroll
   for (int mt = 0; mt < MT; ++mt) {
    __builtin_amdgcn_sched_barrier(0);
    const int m = mb + mt * 32 + r;
    float rs = 1.f;
    const float* kp;
    bf16_t* kdst; bf16_t* vdst; int vst; bool rope = false; int pos = 0;
    if (cache) {
      const int b = m >> 8, p = m & 255;
      kp = cache_kpe + ((size_t)((b * 2 + li) * 256 + p)) * 32;
      kdst = ksm + ((size_t)(b * 8 + hd) * 1280 + p) * 96;
      vdst = vtsm + ((size_t)(b * 8 + hd) * 64) * 1280 + p; vst = 1280;
    } else {
      rs = rstd_parts<2>(ssqkv, m, 1.f / 256.f);
      kp = kpebuf + (size_t)m * 32;
      if (m < TP) {
        const int b = m >> 8, p = m & 255;
        kdst = kpm + ((size_t)(b * 8 + hd) * 256 + p) * 96;
        vdst = vtpm + ((size_t)(b * 8 + hd) * 64) * 256 + p; vst = 256;
      } else {
        const int s = m - TP, b = s >> 10; pos = s & 1023; rope = true;
        kdst = ksm + ((size_t)(b * 8 + hd) * 1280 + 256 + pos) * 96;
        vdst = vtsm + ((size_t)(b * 8 + hd) * 64) * 1280 + 256 + pos; vst = 1280;
      }
    }
    float ss = 0.f;
#pragma unroll
    for (int nt = 0; nt < 4; ++nt)
#pragma unroll
      for (int i = 0; i < 16; ++i) { acc[nt][mt][i] *= rs; if (nt < 2) ss += acc[nt][mt][i] * acc[nt][mt][i]; }
    ss = hsum32(ss);
    const f32x4 a0 = gld((const f32x4*)(kp + 8 * h)), a1 = gld((const f32x4*)(kp + 8 * h + 4));
    const f32x4 b0 = gld((const f32x4*)(kp + 16 + 8 * h)), b1 = gld((const f32x4*)(kp + 16 + 8 * h + 4));
    float x1[8] = {a0.x, a0.y, a0.z, a0.w, a1.x, a1.y, a1.z, a1.w};
    float x2[8] = {b0.x, b0.y, b0.z, b0.w, b1.x, b1.y, b1.z, b1.w};
    float sp = 0.f;
#pragma unroll
    for (int j = 0; j < 8; ++j) sp += x1[j] * x1[j] + x2[j] * x2[j];
    sp = hsum32(sp);
    const float rn = rsqrtf((ss + sp) * (1.f / 96.f) + EPS);
#pragma unroll
    for (int nt = 0; nt < 2; ++nt)
#pragma unroll
      for (int g = 0; g < 4; ++g) {
        const int d = nt * 32 + 8 * g + 4 * h;
        const f32x4 g4 = gld((const f32x4*)(gk + d));
        store_bf4(kdst + d, acc[nt][mt][4 * g] * rn * g4.x, acc[nt][mt][4 * g + 1] * rn * g4.y, acc[nt][mt][4 * g + 2] * rn * g4.z, acc[nt][mt][4 * g + 3] * rn * g4.w);
      }
    const float prow = (float)(pos >> 6), pcol = (float)(pos & 63);
#pragma unroll
    for (int j = 0; j < 8; ++j) {
      const int jj = 8 * h + j;
      float a = x1[j] * rn * gk[64 + jj], b = x2[j] * rn * gk[80 + jj];
      if (rope) {
        float c, s; rope_cs(j, h == 0 ? prow : pcol, c, s);
        const float na = a * c - b * s, nb2 = b * c + a * s;
        a = na; b = nb2;
      }
      x1[j] = a; x2[j] = b;
    }
    { u32x4 u; u.x = pack2(x1[0], x1[1]); u.y = pack2(x1[2], x1[3]); u.z = pack2(x1[4], x1[5]); u.w = pack2(x1[6], x1[7]); *(GAS u32x4*)(kdst + 64 + 8 * h) = u; }
    { u32x4 u; u.x = pack2(x2[0], x2[1]); u.y = pack2(x2[2], x2[3]); u.z = pack2(x2[4], x2[5]); u.w = pack2(x2[6], x2[7]); *(GAS u32x4*)(kdst + 80 + 8 * h) = u; }
#pragma unroll
    for (int nt = 2; nt < 4; ++nt)
#pragma unroll
      for (int i = 0; i < 16; ++i) {
        const int d = (nt - 2) * 32 + CROW(i, h);
        gst(vdst + (size_t)d * vst, f2bf(acc[nt][mt][i]));
      }
   }
  }
};

struct EpiPool {
  DI void side(int, int, int, unsigned char*) const {}
  const float* scale; bf16_t* cat;
  template <int NT, int MT> DI void operator()(f32x16 (&acc)[NT][MT], int nb, int mb, int lane, unsigned char* wlds, const unsigned char* side, int n0, int m0) const {
    const int r = lane & 31, h = lane >> 5;
#pragma unroll
    for (int mt = 0; mt < MT; ++mt) {
      const int m = mb + mt * 32 + r;
#pragma unroll
      for (int nt = 0; nt < NT; ++nt)
#pragma unroll
        for (int g = 0; g < 4; ++g) {
          const int n = nb + nt * 32 + 8 * g + 4 * h;
          const f32x4 s4 = gld((const f32x4*)(scale + n));
          store_bf4(cat + (size_t)m * 1024 + n, acc[nt][mt][4 * g] * s4.x, acc[nt][mt][4 * g + 1] * s4.y, acc[nt][mt][4 * g + 2] * s4.z, acc[nt][mt][4 * g + 3] * s4.w);
        }
    }
  }
};

template <int DQK>
DI void attn_task(const bf16_t* __restrict__ Q, int qs,
                  const bf16_t* __restrict__ K0, int ks0, const bf16_t* __restrict__ V0, int vs0, int nt0,
                  const bf16_t* __restrict__ K1, int ks1, const bf16_t* __restrict__ V1, int vs1, int nt1,
                  bool na, int qrow0, int krow0, const float* __restrict__ rpb_h,
                  bf16_t* __restrict__ O, int os, float scale, unsigned char* smem) {
  constexpr int KSTR = (DQK + 8) * 2;
  constexpr int CH = DQK / 8;
  constexpr int NKC = (CH * 64 + 511) / 512;
  constexpr int KSTAGE = 64 * 208, VSTAGE = 64 * 144;
  constexpr float LOG2E = 1.4426950408889634f;
  const int tid = otid(), lane = tid & 63, w = tid >> 6, r = lane & 31, h = lane >> 5;
  float* srpb = (float*)(smem + 2 * KSTAGE + 2 * VSTAGE);
  const int NTT = nt0 + nt1;

  __syncthreads();
  if (na) for (int i = tid; i < 465; i += 512) srpb[i] = rpb_h[i] * LOG2E;

  bf16x8 qf[DQK / 16];
  {
    const bf16_t* qp = Q + (size_t)(32 * w + r) * qs + 8 * h;
#pragma unroll
    for (int ks = 0; ks < DQK / 16; ++ks) qf[ks] = gld((const bf16x8*)(qp + ks * 16));
  }
  u32x4 rk[NKC], rv;
  const int vrow = tid >> 3, vkc = tid & 7;
  auto gload = [&](int j) {
    const bf16_t* kp; const bf16_t* vp; int kst, vst;
    if (j < nt0) { kp = K0 + (size_t)j * 64 * ks0; kst = ks0; vp = V0 + j * 64; vst = vs0; }
    else { kp = K1 + (size_t)(j - nt0) * 64 * ks1; kst = ks1; vp = V1 + (j - nt0) * 64; vst = vs1; }
#pragma unroll
    for (int i = 0; i < NKC; ++i) { const int c = tid + 512 * i; if (c < CH * 64) rk[i] = gld((const u32x4*)(kp + (size_t)(c / CH) * kst + (c % CH) * 8)); }
    rv = gld((const u32x4*)(vp + (size_t)vrow * vst + vkc * 8));
  };
  gload(0);

  f32x16 ot[2];
#pragma unroll
  for (int t = 0; t < 2; ++t)
#pragma unroll
    for (int i = 0; i < 16; ++i) ot[t][i] = 0.f;
  float m_run = -3.0e38f, l_run = 0.f;
  const float sc2 = scale * LOG2E;
  const int qrow = qrow0 + (w >> 1), qcol = 32 * (w & 1) + r;
  const int rsw = min(max(qrow - 4, 0), 8);
  const int csq = min(max(qcol - 8, 0), 48);

  for (int j = 0; j < NTT; ++j) {
    unsigned char* sK = smem + (j & 1) * KSTAGE;
    unsigned char* sV = smem + 2 * KSTAGE + (j & 1) * VSTAGE;
#pragma unroll
    for (int i = 0; i < NKC; ++i) { const int c = tid + 512 * i; if (c < CH * 64) *(u32x4*)(sK + (c / CH) * KSTR + (c % CH) * 16) = rk[i]; }
    *(u32x4*)(sV + vrow * 144 + vkc * 16) = rv;
    __syncthreads();
    if (j + 1 < NTT) gload(j + 1);
    __builtin_amdgcn_sched_barrier(0);
    const bool local = na && j < nt0;
    const int keyrow = krow0 + j;
    if (local && (keyrow < rsw || keyrow >= rsw + 8)) continue;
    f32x16 st[2];
#pragma unroll
    for (int t = 0; t < 2; ++t)
#pragma unroll
      for (int i = 0; i < 16; ++i) st[t][i] = 0.f;
    {
      bf16x8 kf[DQK / 16][2];
#pragma unroll
      for (int ks = 0; ks < DQK / 16; ++ks)
#pragma unroll
        for (int t = 0; t < 2; ++t) kf[ks][t] = *(const bf16x8*)(sK + (t * 32 + r) * KSTR + ks * 32 + h * 16);
      __builtin_amdgcn_sched_barrier(0);
#pragma unroll
      for (int ks = 0; ks < DQK / 16; ++ks)
#pragma unroll
        for (int t = 0; t < 2; ++t) st[t] = MFMA(kf[ks][t], qf[ks], st[t]);
    }
    bf16x8 vfr[4][2];
#pragma unroll
    for (int s2 = 0; s2 < 4; ++s2)
#pragma unroll
      for (int dv = 0; dv < 2; ++dv) {
        const unsigned char* vb = sV + (dv * 32 + r) * 144 + (16 * s2 + 4 * h) * 2;
        const u32x2 v0 = *(const u32x2*)(vb), v1 = *(const u32x2*)(vb + 16);
        const u32x4 vu = {v0.x, v0.y, v1.x, v1.y};
        vfr[s2][dv] = __builtin_bit_cast(bf16x8, vu);
      }
    __builtin_amdgcn_sched_barrier(0);
    float mx = -3.0e38f;
    if (local) {
      const int dr = keyrow - qrow + 7;
#pragma unroll
      for (int t = 0; t < 2; ++t)
#pragma unroll
        for (int i = 0; i < 16; ++i) {
          const int kc = t * 32 + CROW(i, h);
          const bool valid = (kc >= csq) && (kc < csq + 16);
          const int dc = min(max(kc - qcol + 15, 0), 30);
          const float bias = srpb[dr * 31 + dc];
          const float s = valid ? __builtin_fmaf(st[t][i], sc2, bias) : -1.0e30f;
          st[t][i] = s; mx = fmaxf(mx, s);
        }
    } else {
#pragma unroll
      for (int t = 0; t < 2; ++t)
#pragma unroll
        for (int i = 0; i < 16; ++i) mx = fmaxf(mx, st[t][i]);
      mx *= sc2;
    }
    mx = hmax32(mx);
    const float m_new = fmaxf(m_run, mx);
    if (__builtin_amdgcn_ballot_w64(m_new > m_run) != 0ull) {
      const float alpha = __builtin_amdgcn_exp2f(m_run - m_new);
      l_run *= alpha;
#pragma unroll
      for (int t = 0; t < 2; ++t)
#pragma unroll
        for (int i = 0; i < 16; ++i) ot[t][i] *= alpha;
    }
    m_run = m_new;
    if (local) {
#pragma unroll
      for (int t = 0; t < 2; ++t)
#pragma unroll
        for (int i = 0; i < 16; ++i) { const float p = __builtin_amdgcn_exp2f(st[t][i] - m_new); st[t][i] = p; l_run += p; }
    } else {
#pragma unroll
      for (int t = 0; t < 2; ++t)
#pragma unroll
        for (int i = 0; i < 16; ++i) { const float p = __builtin_amdgcn_exp2f(__builtin_fmaf(st[t][i], sc2, -m_new)); st[t][i] = p; l_run += p; }
    }
#pragma unroll
    for (int s2 = 0; s2 < 4; ++s2) {
      const int t = s2 >> 1, o = (s2 & 1) * 8;
      const u32x4 pu = {pack2(st[t][o + 0], st[t][o + 1]), pack2(st[t][o + 2], st[t][o + 3]), pack2(st[t][o + 4], st[t][o + 5]), pack2(st[t][o + 6], st[t][o + 7])};
      const bf16x8 pfv = __builtin_bit_cast(bf16x8, pu);
#pragma unroll
      for (int dv = 0; dv < 2; ++dv) ot[dv] = MFMA(vfr[s2][dv], pfv, ot[dv]);
    }
  }
  const float lt = hsum32(l_run);
  const float inv = 1.f / lt;
  bf16_t* op = O + (size_t)(32 * w + r) * os;
#pragma unroll
  for (int dv = 0; dv < 2; ++dv)
#pragma unroll
    for (int g = 0; g < 4; ++g)
      store_bf4(op + dv * 32 + 8 * g + 4 * h, ot[dv][4 * g] * inv, ot[dv][4 * g + 1] * inv, ot[dv][4 * g + 2] * inv, ot[dv][4 * g + 3] * inv);
}

DI void job_mods(const Params& p, int j, unsigned char* smem) {
  const int tid = otid(), lane = tid & 63, w = tid >> 6, kq = lane >> 4, c4 = lane & 15;
  const int l = j / 96, n0 = (j % 96) * 64;
  float* s = (float*)smem;
  __syncthreads();
  for (int idx = tid; idx < 9 * 1024; idx += 512) {
    const int mi = idx >> 10, k = idx & 1023;
    const float x = mi == 0 ? p.in[7][k] : p.in[6][(mi - 1) * 1024 + k];
    s[idx] = x / (1.f + expf(-x));
  }
  __syncthreads();
  const float* Wp = p.in[8] + ((size_t)l * 1024 + w * 128 + kq) * 6144 + n0 + 4 * c4;
  float acc[9][4];
#pragma unroll
  for (int mi = 0; mi < 9; ++mi)
#pragma unroll
    for (int q = 0; q < 4; ++q) acc[mi][q] = 0.f;
#pragma unroll 8
  for (int i = 0; i < 32; ++i) {
    const f32x4 wv = gld_nt((const f32x4*)(Wp + (size_t)(4 * i) * 6144));
    const int k = w * 128 + 4 * i + kq;
#pragma unroll
    for (int mi = 0; mi < 9; ++mi) {
      const float sv = s[mi * 1024 + k];
      acc[mi][0] += sv * wv.x; acc[mi][1] += sv * wv.y; acc[mi][2] += sv * wv.z; acc[mi][3] += sv * wv.w;
    }
  }
#pragma unroll
  for (int mi = 0; mi < 9; ++mi)
#pragma unroll
    for (int q = 0; q < 4; ++q) { float v = acc[mi][q]; v += __shfl_xor(v, 16, 64); v += __shfl_xor(v, 32, 64); acc[mi][q] = v; }
  __syncthreads();
  float* red = (float*)smem;
  if (kq == 0) {
#pragma unroll
    for (int mi = 0; mi < 9; ++mi)
#pragma unroll
      for (int q = 0; q < 4; ++q) red[(w * 9 + mi) * 64 + 4 * c4 + q] = acc[mi][q];
  }
  __syncthreads();
  float* mod = (float*)(p.ws + OFF_MOD);
  for (int idx = tid; idx < 9 * 64; idx += 512) {
    const int mi = idx >> 6, ln = idx & 63;
    float v = 0.f;
#pragma unroll
    for (int q = 0; q < 8; ++q) v += red[(q * 9 + mi) * 64 + ln];
    mod[(size_t)(l * 9 + mi) * 6144 + n0 + ln] = v + p.in[9][l * 6144 + n0 + ln];
  }
}

DI void job_wconv(const Params& p, int t) {
  int mi = 0;
#pragma unroll 1
  for (int i = 1; i < NMATS; ++i) if (t >= p.mats[i].tile0) mi = i;
  const MatDesc md = p.mats[mi];
  const int lt = t - md.tile0;
  const int ktiles = md.K >> 7;
  const int k0 = (lt % ktiles) * 128 + (otid() >> 6) * 16, n = (lt / ktiles) * 64 + (otid() & 63);
  const float* sp; bool ok; size_t rs;
  if (md.blockdiag == 1) { ok = (k0 >> 7) == (n >> 7); sp = md.src + (size_t)(k0 >> 7) * 16384 + (size_t)(k0 & 127) * 128 + (n & 127); rs = 128; }
  else if (md.headpad) { const int hd = n >> 7, d = n & 127; ok = d < 96; sp = md.src + (size_t)k0 * md.N + hd * 96 + d; rs = md.N; }
  else { ok = n < md.N; sp = md.src + (size_t)k0 * md.N + n; rs = md.N; }
  float v[16];
  if (md.blockdiag >= 2 && k0 < 512) {
    const int li = md.blockdiag - 2, g = k0 >> 7;
    const int krow = __builtin_amdgcn_readfirstlane(k0 & 127);
    const float* pw = p.in[21] + ((size_t)(li * 4 + g) * 128 + krow) * 128;
    const float* scp = p.in[22] + li * 512 + g * 128;
    const float* wo = md.src + (size_t)(g * 128) * md.N + n;
#pragma unroll
    for (int q = 0; q < 16; ++q) v[q] = 0.f;
#pragma unroll 8
    for (int d = 0; d < 128; ++d) {
      const float x = scp[d] * wo[(size_t)d * md.N];
#pragma unroll
      for (int q = 0; q < 16; ++q) v[q] += pw[q * 128 + d] * x;
    }
  } else {
#pragma unroll
  for (int q = 0; q < 16; ++q) v[q] = ok ? gld_nt(sp + (size_t)q * rs) : 0.f;
  }
  if (md.rscale) {
#pragma unroll
    for (int q = 0; q < 16; ++q) v[q] *= md.rscale[k0 + q];
  }
  bf16_t* dst = (bf16_t*)(p.ws + md.dst) + (size_t)n * md.K + k0;
  u32x4 u0 = {pack2(v[0], v[1]), pack2(v[2], v[3]), pack2(v[4], v[5]), pack2(v[6], v[7])};
  u32x4 u1 = {pack2(v[8], v[9]), pack2(v[10], v[11]), pack2(v[12], v[13]), pack2(v[14], v[15])};
  *(GAS u32x4*)dst = u0;
  *(GAS u32x4*)(dst + 8) = u1;
}

DI void job_cache(const Params& p, int j) {
  const int tid = otid();
  if (j < 512) {
    const int item = j * 512 + tid;
    const int e = item * 8;
    const int c = e & 511, pos = (e >> 9) & 255, i = (e >> 17) & 1, b = e >> 18;
    const f32x4 a = gld_nt((const f32x4*)(p.in[2] + e)), bq = gld_nt((const f32x4*)(p.in[2] + e + 4));
    u32x4 u; u.x = pack2(a.x, a.y); u.y = pack2(a.z, a.w); u.z = pack2(bq.x, bq.y); u.w = pack2(bq.z, bq.w);
    *(GAS u32x4*)((bf16_t*)(p.ws + OFF_CNK) + ((size_t)(i * 2048 + b * 256 + pos)) * 512 + c) = u;
  } else if (j < 1024) {
    const int item = (j - 512) * 512 + tid;
    const int hd = item & 511, pos8 = (item >> 9) & 31, i = (item >> 14) & 1, b = item >> 15;
    const float* src = p.in[3] + ((size_t)((b * 2 + i) * 256 + pos8 * 8)) * 512 + hd;
    float v[8];
#pragma unroll
    for (int q = 0; q < 8; ++q) v[q] = src[(size_t)q * 512];
    u32x4 u; u.x = pack2(v[0], v[1]); u.y = pack2(v[2], v[3]); u.z = pack2(v[4], v[5]); u.w = pack2(v[6], v[7]);
    *(GAS u32x4*)((bf16_t*)(p.ws + OFF_CNVT) + ((size_t)((i * 8 + b) * 512 + hd)) * 256 + pos8 * 8) = u;
  } else {
    const int item = (j - 1024) * 512 + tid;
    const int e = item * 8;
    const int c = e & 255, pos = (e >> 8) & 255, i = (e >> 16) & 1, b = e >> 17;
    const f32x4 a = gld_nt((const f32x4*)(p.in[4] + e)), bq = gld_nt((const f32x4*)(p.in[4] + e + 4));
    u32x4 u; u.x = pack2(a.x, a.y); u.y = pack2(a.z, a.w); u.z = pack2(bq.x, bq.y); u.w = pack2(bq.z, bq.w);
    *(GAS u32x4*)((bf16_t*)(p.ws + OFF_CCKV) + ((size_t)(i * 2048 + b * 256 + pos)) * 256 + c) = u;
  }
}

DI void job_shw(const Params& p, int j, unsigned char* smem) {
  int l = 0, jj = j;
  if (jj >= 112) { jj -= 112; l = 1; if (jj >= 84) { jj -= 84; l = 2; if (jj >= 112) { jj -= 112; l = 3; } } }
  const int n1 = (l & 1) ? 20 : 48;
  const int which = jj >= n1;
  const int n0 = (which ? jj - n1 : jj) * 64;
  const bf16_t* Wt = which ? (const bf16_t*)(p.ws + OFF_W1T) + (size_t)l * 4096 * 1024
                           : ((l & 1) ? (const bf16_t*)(p.ws + OFF_OWIN) + (size_t)(l >> 1) * 1280 * 1024
                                      : (const bf16_t*)(p.ws + OFF_EWIN) + (size_t)(l >> 1) * 3072 * 1024);
  float* dst = which ? (float*)(p.ws + OFF_SHW2) + (size_t)l * 9 * 4096 : (float*)(p.ws + OFF_SHW1) + (size_t)l * 9 * 3072;
  const int ns = which ? 4096 : 3072;
  const float* mod = (const float*)(p.ws + OFF_MOD) + (size_t)l * 9 * 6144 + (which ? 3072 : 0);
  const int tid = otid(), lane = tid & 63, w = tid >> 6;
  float* s = (float*)smem;
  __syncthreads();
  for (int idx = tid; idx < 9 * 1024; idx += 512) s[idx] = mod[(idx >> 10) * 6144 + (idx & 1023)];
  __syncthreads();
  const bf16_t* wr = Wt + (size_t)(n0 + lane) * 1024 + w * 128;
  float acc[9];
#pragma unroll
  for (int mi = 0; mi < 9; ++mi) acc[mi] = 0.f;
#pragma unroll 2
  for (int c = 0; c < 16; ++c) {
    const u32x4 u = gld((const u32x4*)(wr + c * 8));
    const float wv[8] = {bflo(u.x), bfhi(u.x), bflo(u.y), bfhi(u.y), bflo(u.z), bfhi(u.z), bflo(u.w), bfhi(u.w)};
#pragma unroll
    for (int q = 0; q < 8; ++q)
#pragma unroll
      for (int mi = 0; mi < 9; ++mi) acc[mi] += s[mi * 1024 + w * 128 + c * 8 + q] * wv[q];
  }
  __syncthreads();
  float* red = (float*)smem;
#pragma unroll
  for (int mi = 0; mi < 9; ++mi) red[(w * 9 + mi) * 64 + lane] = acc[mi];
  __syncthreads();
  for (int idx = tid; idx < 9 * 64; idx += 512) {
    const int mi = idx >> 6, ln = idx & 63;
    float v = 0.f;
#pragma unroll
    for (int q = 0; q < 8; ++q) v += red[(q * 9 + mi) * 64 + ln];
    dst[(size_t)mi * ns + n0 + ln] = v;
  }
}

DI void job_xpass(const Params& p, int j) {
  const int tid = otid(), lane = tid & 63, w = tid >> 6;
  const int m = j * 8 + w, mi = mi_of(m);
  const float* x = m < TP ? p.in[0] + (size_t)m * 1024 : p.in[1] + (size_t)(m - TP) * 1024;
  const float* g1 = p.in[10];
  const float* sc = (const float*)(p.ws + OFF_MOD) + (size_t)mi * 6144 + 1024;
  float* y = p.out + OUT_Y + (size_t)m * 1024;
  bf16_t* ab = (bf16_t*)(p.ws + OFF_ABUF) + (size_t)m * 1024;
  float ss = 0.f;
#pragma unroll
  for (int i = 0; i < 4; ++i) {
    const int k = lane * 4 + 256 * i;
    const f32x4 v = gld_nt((const f32x4*)(x + k));
    const f32x4 g = gld((const f32x4*)(g1 + k));
    const f32x4 s4 = gld((const f32x4*)(sc + k));
    ss += v.x * v.x + v.y * v.y + v.z * v.z + v.w * v.w;
    *(GAS f32x4*)(y + k) = v;
    store_bf4(ab + k, v.x * g.x * (1.f + s4.x), v.y * g.y * (1.f + s4.y), v.z * g.z * (1.f + s4.z), v.w * g.w * (1.f + s4.w));
  }
  ss = sum16(ss); ss += __shfl_xor(ss, 16, 64); ss = hsum32(ss);
  float* ssq = (float*)(p.ws + OFF_SSQ1);
  if (lane < 16) ssq[(size_t)lane * T + m] = lane == 0 ? ss : 0.f;
}

DI void job_conv(const Params& p, int j, int li) {
  const int item = j * 512 + otid();
  const int m = item >> 6, c = (item & 63) * 8;
  const bf16_t* bc = (const bf16_t*)(p.ws + OFF_BCONV);
  int pos, L;
  if (m < TP) { pos = m & 255; L = 256; } else { pos = (m - TP) & 1023; L = 1024; }
  const float* cw = p.in[15] + (size_t)li * 3 * 512 + c;
  float accv[8];
#pragma unroll
  for (int q = 0; q < 8; ++q) accv[q] = 0.f;
#pragma unroll
  for (int d = -1; d <= 1; ++d) {
    const int pp = pos + d;
    if (pp < 0 || pp >= L) continue;
    const u32x4 cg = gld((const u32x4*)(bc + (size_t)(m + d) * 1536 + 512 + c));
    const u32x4 xa = gld((const u32x4*)(bc + (size_t)(m + d) * 1536 + 1024 + c));
    const f32x4 w0 = gld((const f32x4*)(cw + (d + 1) * 512)), w1 = gld((const f32x4*)(cw + (d + 1) * 512 + 4));
    accv[0] += bflo(cg.x) * bflo(xa.x) * w0.x; accv[1] += bfhi(cg.x) * bfhi(xa.x) * w0.y;
    accv[2] += bflo(cg.y) * bflo(xa.y) * w0.z; accv[3] += bfhi(cg.y) * bfhi(xa.y) * w0.w;
    accv[4] += bflo(cg.z) * bflo(xa.z) * w1.x; accv[5] += bfhi(cg.z) * bfhi(xa.z) * w1.y;
    accv[6] += bflo(cg.w) * bflo(xa.w) * w1.z; accv[7] += bfhi(cg.w) * bfhi(xa.w) * w1.w;
  }
  const u32x4 bg = gld((const u32x4*)(bc + (size_t)m * 1536 + c));
  u32x4 u;
  u.x = pack2(bflo(bg.x) * accv[0], bfhi(bg.x) * accv[1]); u.y = pack2(bflo(bg.y) * accv[2], bfhi(bg.y) * accv[3]);
  u.z = pack2(bflo(bg.z) * accv[4], bfhi(bg.z) * accv[5]); u.w = pack2(bflo(bg.w) * accv[6], bfhi(bg.w) * accv[7]);
  *(GAS u32x4*)((bf16_t*)(p.ws + OFF_CAT) + (size_t)m * 1024 + c) = u;
}

DI void job_poolx(const Params& p, int j) {
  const int item = j * 512 + otid();
  const int m = item >> 6, c = (item & 63) * 8;
  const bf16_t* ub = (const bf16_t*)(p.ws + OFF_UBUF);
  int pos, L;
  if (m < TP) { pos = m & 255; L = 256; } else { pos = (m - TP) & 1023; L = 1024; }
  const int wsz = 2 << (c >> 7);
  const int lo = min(max(pos - wsz / 2, 0), L), hi = min(max(pos - wsz / 2 + wsz, 0), L);
  float s[8];
#pragma unroll
  for (int q = 0; q < 8; ++q) s[q] = 0.f;
  u32x4 uu[16];
#pragma unroll
  for (int q = 0; q < 16; ++q) {
    const u32x4 z = {0u, 0u, 0u, 0u};
    uu[q] = (lo + q < hi) ? gld((const u32x4*)(ub + (size_t)(m + lo + q - pos) * 512 + c)) : z;
  }
#pragma unroll
  for (int q = 0; q < 16; ++q) {
    const u32x4 u = uu[q];
    s[0] += bflo(u.x); s[1] += bfhi(u.x); s[2] += bflo(u.y); s[3] += bfhi(u.y); s[4] += bflo(u.z); s[5] += bfhi(u.z); s[6] += bflo(u.w); s[7] += bfhi(u.w);
  }
  const float inv = 1.f / (float)(hi - lo);
  const u32x4 u = gld((const u32x4*)(ub + (size_t)m * 512 + c));
  u32x4 o;
  o.x = pack2(s[0] * inv - bflo(u.x), s[1] * inv - bfhi(u.x)); o.y = pack2(s[2] * inv - bflo(u.y), s[3] * inv - bfhi(u.y));
  o.z = pack2(s[4] * inv - bflo(u.z), s[5] * inv - bfhi(u.z)); o.w = pack2(s[6] * inv - bflo(u.w), s[7] * inv - bfhi(u.w));
  *(GAS u32x4*)((bf16_t*)(p.ws + OFF_CAT) + (size_t)m * 1024 + c) = o;
}

DI void job_ckvstate(const Params& p, int j, int li) {
  const int item = j * 512 + otid();
  const int m = item >> 6, c = (item & 63) * 4;
  const float rs = rstd_parts<2>((const float*)(p.ws + OFF_SSQKV), m, 1.f / 256.f);
  float* o = p.out + OUT_CKV + ((size_t)(((m >> 8) * 2 + li) * 256 + (m & 255))) * 256 + c;
  const f32x4 g = gld((const f32x4*)(p.in[25] + li * 256 + c));
  f32x4 v = gld((const f32x4*)((const float*)(p.ws + OFF_KVRAW) + (size_t)m * 256 + c));
  v.x *= rs * g.x; v.y *= rs * g.y; v.z *= rs * g.z; v.w *= rs * g.w;
  *(GAS f32x4*)o = v;
}

__global__ void __launch_bounds__(NTHREADS, 2) fwd_megakernel(Params p) {
  __shared__ __attribute__((aligned(16))) unsigned char smem[SMEM_BYTES];
  __shared__ u32x4 xb_words;
  cg::grid_group grid = cg::this_grid();
  if (p.pad_ == 0x7fffffff) grid.sync();
  if (threadIdx.x == 0) { const u32x4 z = {0u, 0u, 0u, 0u}; xb_words = z; }
  __syncthreads();
  const XcdBarrier xb = xcd_barrier_post((unsigned*)(p.ws + OFF_BAR), (volatile LAS unsigned*)&xb_words);
  const int nb = gridDim.x, bid = blockIdx.x;
  unsigned char* const ws_ = p.ws;
  float* const out_ = p.out;

#ifndef SKIP_PH0
  for (int rep_ = 0; rep_ < REP_PH0; ++rep_) {
    const int n_mod = 384, n_conv = p.conv_tiles, n_cache = 1280;
    for (int j = bid; j < n_mod + n_conv + n_cache; j += nb) {
      if (j < n_mod) { for (int q_ = 0; q_ < REP_MODS; ++q_) job_mods(p, j, smem); }
      else if (j < n_mod + n_conv) { for (int q_ = 0; q_ < REP_WCONV; ++q_) job_wconv(p, j - n_mod); }
      else { for (int q_ = 0; q_ < REP_CACHE; ++q_) job_cache(p, j - n_mod - n_conv); }
    }
  }
#endif
  xcd_barrier(xb);
#ifndef SKIP_PH1
  for (int rep_ = 0; rep_ < REP_PH1; ++rep_) {
    for (int j = bid; j < 392 + 1536; j += nb) {
      if (j < 392) job_shw(p, j, smem); else job_xpass(p, j - 392);
    }
  }
#endif
  xcd_barrier(xb);

#pragma unroll 1
  for (int l = 0; l < 4; ++l) {
    const int li = l >> 1;
    if ((l & 1) == 0) {
#ifndef SKIP_E2
      for (int rep_ = 0; rep_ < REP_E2; ++rep_) {
        unsigned char* ws = uniform_ptr(ws_); float* ybuf = (float*)uniform_ptr(out_); asm volatile("" : "+s"(ws), "+s"(ybuf));
        float* mod = (float*)(ws + OFF_MOD); bf16_t* abuf = (bf16_t*)(ws + OFF_ABUF); bf16_t* cat = (bf16_t*)(ws + OFF_CAT); bf16_t* act = (bf16_t*)(ws + OFF_ACT);
        float* ssq1 = (float*)(ws + OFF_SSQ1); float* ssq2 = (float*)(ws + OFF_SSQ2); const float* modl = mod + (size_t)l * 9 * 6144;
        (void)mod; (void)abuf; (void)cat; (void)act; (void)ssq1; (void)ssq2; (void)modl; (void)ybuf;
        EpiEvenIn e;
        e.ssq = ssq1; e.shw = (const float*)(ws + OFF_SHW1) + (size_t)l * 9 * 3072; e.gq = p.in[16] + li * 64; e.gk = p.in[17] + li * 64;
        e.bconv = (bf16_t*)(ws + OFF_BCONV); e.qbuf = (bf16_t*)(ws + OFF_QBUF); e.kbuf = (bf16_t*)(ws + OFF_KBUF);
        e.vtp = (bf16_t*)(ws + OFF_VTP); e.vts = (bf16_t*)(ws + OFF_VTS); e.out_k = ybuf + OUT_NAK; e.out_v = ybuf + OUT_NAV; e.li = li;
        const bf16_t* W = (const bf16_t*)(ws + OFF_EWIN) + (size_t)li * 3072 * 1024;
        for (int t = bid; t < 64 * 12; t += nb) gemm_tile<192, 4>(abuf, 1024, W, 1024, (t % 64) * 192, (t / 64) * 256, e, smem);
      }
#endif
      xcd_barrier(xb);
#ifndef SKIP_E3
      for (int rep_ = 0; rep_ < REP_E3; ++rep_) {
        unsigned char* ws = uniform_ptr(ws_); float* ybuf = (float*)uniform_ptr(out_); asm volatile("" : "+s"(ws), "+s"(ybuf));
        float* mod = (float*)(ws + OFF_MOD); bf16_t* abuf = (bf16_t*)(ws + OFF_ABUF); bf16_t* cat = (bf16_t*)(ws + OFF_CAT); bf16_t* act = (bf16_t*)(ws + OFF_ACT);
        float* ssq1 = (float*)(ws + OFF_SSQ1); float* ssq2 = (float*)(ws + OFF_SSQ2); const float* modl = mod + (size_t)l * 9 * 6144;
        (void)mod; (void)abuf; (void)cat; (void)act; (void)ssq1; (void)ssq2; (void)modl; (void)ybuf;
        const bf16_t* qb = (const bf16_t*)(ws + OFF_QBUF); const bf16_t* kb = (const bf16_t*)(ws + OFF_KBUF);
        const bf16_t* vtp = (const bf16_t*)(ws + OFF_VTP); const bf16_t* vts = (const bf16_t*)(ws + OFF_VTS);
        const bf16_t* cnk = (const bf16_t*)(ws + OFF_CNK) + (size_t)li * 2048 * 512;
        const bf16_t* cnvt = (const bf16_t*)(ws + OFF_CNVT) + (size_t)li * 2048 * 512;
        for (int j = bid; j < 256 + 128 + 1536; j += nb) {
          if (j < 256) {
            const int rq = j & 3, hd = (j >> 2) & 7, b = j >> 5;
            const int tok0 = TP + b * 1024 + rq * 256;
            const int kr0 = min(max(4 * rq - 4, 0), 8), kr1 = min(max(4 * rq + 3 - 4, 0), 8) + 8;
            attn_task<64>(qb + (size_t)tok0 * 512 + hd * 64, 512,
                          kb + (size_t)(TP + b * 1024 + kr0 * 64) * 512 + hd * 64, 512, vts + ((size_t)(b * 8 + hd) * 64) * 1024 + kr0 * 64, 1024, kr1 - kr0,
                          cnk + (size_t)(b * 256) * 512 + hd * 64, 512, cnvt + ((size_t)(b * 8 + hd) * 64) * 256, 256, 4,
                          true, 4 * rq, kr0, p.in[18] + (size_t)(li * 8 + hd) * 465,
                          cat + (size_t)tok0 * 1024 + 512 + hd * 64, 1024, 0.125f, smem);
          } else if (j < 384) {
            const int jj = j - 256, hd = jj & 7, b = jj >> 3;
            const int tok0 = b * 256;
            attn_task<64>(qb + (size_t)tok0 * 512 + hd * 64, 512,
                          kb + (size_t)(b * 256) * 512 + hd * 64, 512, vtp + ((size_t)(b * 8 + hd) * 64) * 256, 256, 4,
                          kb, 512, vtp, 256, 0,
                          false, 0, 0, p.in[18],
                          cat + (size_t)tok0 * 1024 + 512 + hd * 64, 1024, 0.125f, smem);
          } else job_conv(p, j - 384, li);
        }
      }
#endif
      xcd_barrier(xb);
#ifndef SKIP_E4
      {
        unsigned char* ws = uniform_ptr(ws_); float* ybuf = (float*)uniform_ptr(out_); asm volatile("" : "+s"(ws), "+s"(ybuf));
        float* mod = (float*)(ws + OFF_MOD); bf16_t* abuf = (bf16_t*)(ws + OFF_ABUF); bf16_t* cat = (bf16_t*)(ws + OFF_CAT); bf16_t* act = (bf16_t*)(ws + OFF_ACT);
        float* ssq1 = (float*)(ws + OFF_SSQ1); float* ssq2 = (float*)(ws + OFF_SSQ2); const float* modl = mod + (size_t)l * 9 * 6144;
        (void)mod; (void)abuf; (void)cat; (void)act; (void)ssq1; (void)ssq2; (void)modl; (void)ybuf;
        EpiResid e; e.gscale = 1.f; e.y = ybuf; e.gate = modl + 2048; e.ng = p.in[11] + l * 1024; e.nsc = modl + 4096; e.abuf = abuf; e.ssq_out = ssq2;
        const bf16_t* W = (const bf16_t*)(ws + OFF_EWOUT) + (size_t)li * 1024 * 1024;
#if PROBE_RESID
        e.gscale = 0.f;
        for (int t = bid; t < 64 * 4; t += nb) gemm_tile<192, 4>(cat, 1024, W, 1024, (t % 64) * 192, (t / 64) * 256, e, smem);
        e.gscale = 1.f; __syncthreads();
#endif
        for (int t = bid; t < 64 * 4; t += nb) gemm_tile<192, 4>(cat, 1024, W, 1024, (t % 64) * 192, (t / 64) * 256, e, smem);
      }
#endif
      xcd_barrier(xb);
    } else {
#ifndef SKIP_O2
      for (int rep_ = 0; rep_ < REP_O2; ++rep_) {
        unsigned char* ws = uniform_ptr(ws_); float* ybuf = (float*)uniform_ptr(out_); asm volatile("" : "+s"(ws), "+s"(ybuf));
        float* mod = (float*)(ws + OFF_MOD); bf16_t* abuf = (bf16_t*)(ws + OFF_ABUF); bf16_t* cat = (bf16_t*)(ws + OFF_CAT); bf16_t* act = (bf16_t*)(ws + OFF_ACT);
        float* ssq1 = (float*)(ws + OFF_SSQ1); float* ssq2 = (float*)(ws + OFF_SSQ2); const float* modl = mod + (size_t)l * 9 * 6144;
        (void)mod; (void)abuf; (void)cat; (void)act; (void)ssq1; (void)ssq2; (void)modl; (void)ybuf;
        EpiOddIn e;
        e.ssq = ssq1; e.shw = (const float*)(ws + OFF_SHW1) + (size_t)l * 9 * 3072; e.ubuf = (bf16_t*)(ws + OFF_UBUF); e.qlat = (bf16_t*)(ws + OFF_QLAT);
        e.kvlat = (bf16_t*)(ws + OFF_KVLAT); e.kpebuf = (float*)(ws + OFF_KPE); e.ssqq = (float*)(ws + OFF_SSQQ); e.ssqkv = (float*)(ws + OFF_SSQKV);
        e.out_ckv = (float*)(ws + OFF_KVRAW); e.out_kpe = ybuf + OUT_KPE; e.li = li;
        const bf16_t* W = (const bf16_t*)(ws + OFF_OWIN) + (size_t)li * 1280 * 1024;
        for (int t = bid; t < 48 * 5; t += nb) gemm_tile<256, 2>(abuf, 1024, W, 1024, (t % 48) * 256, (t / 48) * 256, e, smem);
      }
#endif
      xcd_barrier(xb);
#ifndef SKIP_O3
      for (int rep_ = 0; rep_ < REP_O3; ++rep_) {
        unsigned char* ws = uniform_ptr(ws_); float* ybuf = (float*)uniform_ptr(out_); asm volatile("" : "+s"(ws), "+s"(ybuf));
        float* mod = (float*)(ws + OFF_MOD); bf16_t* abuf = (bf16_t*)(ws + OFF_ABUF); bf16_t* cat = (bf16_t*)(ws + OFF_CAT); bf16_t* act = (bf16_t*)(ws + OFF_ACT);
        float* ssq1 = (float*)(ws + OFF_SSQ1); float* ssq2 = (float*)(ws + OFF_SSQ2); const float* modl = mod + (size_t)l * 9 * 6144;
        (void)mod; (void)abuf; (void)cat; (void)act; (void)ssq1; (void)ssq2; (void)modl; (void)ybuf;
        EpiKvUp ek; ek.ssqkv = (const float*)(ws + OFF_SSQKV); ek.gk = p.in[28] + li * 96; ek.kpebuf = (const float*)(ws + OFF_KPE); ek.cache_kpe = p.in[5];
        ek.kpm = (bf16_t*)(ws + OFF_KPM); ek.ksm = (bf16_t*)(ws + OFF_KSM); ek.vtpm = (bf16_t*)(ws + OFF_VTPM); ek.vtsm = (bf16_t*)(ws + OFF_VTSM); ek.li = li; ek.cache = 0;
        EpiQUp eq; eq.ssqq = (const float*)(ws + OFF_SSQQ); eq.gq = p.in[27] + li * 96; eq.qmla = (bf16_t*)(ws + OFF_QMLA);
        const bf16_t* Wkv = (const bf16_t*)(ws + OFF_WKVB) + (size_t)li * 1024 * 256;
        const bf16_t* Wq = (const bf16_t*)(ws + OFF_WQB) + (size_t)li * 1024 * 384;
        const bf16_t* cckv = (const bf16_t*)(ws + OFF_CCKV) + (size_t)li * 2048 * 256;
        for (int j = bid; j < 448 + 384 + 1536 + 512; j += nb) {
          if (j < 448) {
            const int mt = j % 112, nt = j / 112;
            const bool cch = mt >= 96;
            ek.cache = cch ? 1 : 0;
            gemm_tile<128, 2>(cch ? cckv : (const bf16_t*)(ws + OFF_KVLAT), 256, Wkv, 256, (cch ? mt - 96 : mt) * 128, nt * 256, ek, smem);
          } else if (j < 448 + 384) {
            const int jj = j - 448;
            gemm_tile<128, 2>((const bf16_t*)(ws + OFF_QLAT), 384, Wq, 384, (jj % 96) * 128, (jj / 96) * 256, eq, smem);
          } else if (j < 448 + 384 + 1536) job_poolx(p, j - 448 - 384);
          else job_ckvstate(p, j - 448 - 384 - 1536, li);
        }
      }
#endif
      xcd_barrier(xb);
#ifndef SKIP_O4
      for (int rep_ = 0; rep_ < REP_O4; ++rep_) {
        unsigned char* ws = uniform_ptr(ws_); float* ybuf = (float*)uniform_ptr(out_); asm volatile("" : "+s"(ws), "+s"(ybuf));
        float* mod = (float*)(ws + OFF_MOD); bf16_t* abuf = (bf16_t*)(ws + OFF_ABUF); bf16_t* cat = (bf16_t*)(ws + OFF_CAT); bf16_t* act = (bf16_t*)(ws + OFF_ACT);
        float* ssq1 = (float*)(ws + OFF_SSQ1); float* ssq2 = (float*)(ws + OFF_SSQ2); const float* modl = mod + (size_t)l * 9 * 6144;
        (void)mod; (void)abuf; (void)cat; (void)act; (void)ssq1; (void)ssq2; (void)modl; (void)ybuf;
        const bf16_t* qm = (const bf16_t*)(ws + OFF_QMLA);
        const bf16_t* kpm = (const bf16_t*)(ws + OFF_KPM); const bf16_t* ksm = (const bf16_t*)(ws + OFF_KSM);
        const bf16_t* vtpm = (const bf16_t*)(ws + OFF_VTPM); const bf16_t* vtsm = (const bf16_t*)(ws + OFF_VTSM);
        const float sc = 0.10206207261596575f;
        for (int j = bid; j < 256 + 128; j += nb) {
          if (j < 256) {
            const int qb2 = j & 3, hd = (j >> 2) & 7, b = j >> 5;
            const int tok0 = TP + b * 1024 + qb2 * 256;
            attn_task<96>(qm + (size_t)tok0 * 768 + hd * 96, 768,
                          ksm + ((size_t)(b * 8 + hd) * 1280) * 96, 96, vtsm + ((size_t)(b * 8 + hd) * 64) * 1280, 1280, 20,
                          ksm, 96, vtsm, 1280, 0, false, 0, 0, p.in[18],
                          cat + (size_t)tok0 * 1024 + 512 + hd * 64, 1024, sc, smem);
          } else if (j < 384) {
            const int jj = j - 256, hd = jj & 7, b = jj >> 3;
            const int tok0 = b * 256;
            attn_task<96>(qm + (size_t)tok0 * 768 + hd * 96, 768,
                          kpm + ((size_t)(b * 8 + hd) * 256) * 96, 96, vtpm + ((size_t)(b * 8 + hd) * 64) * 256, 256, 4,
                          kpm, 96, vtpm, 256, 0, false, 0, 0, p.in[18],
                          cat + (size_t)tok0 * 1024 + 512 + hd * 64, 1024, sc, smem);
          }
        }
      }
#endif
      xcd_barrier(xb);
#ifndef SKIP_O5
      {
        unsigned char* ws = uniform_ptr(ws_); float* ybuf = (float*)uniform_ptr(out_); asm volatile("" : "+s"(ws), "+s"(ybuf));
        float* mod = (float*)(ws + OFF_MOD); bf16_t* abuf = (bf16_t*)(ws + OFF_ABUF); bf16_t* cat = (bf16_t*)(ws + OFF_CAT); bf16_t* act = (bf16_t*)(ws + OFF_ACT);
        float* ssq1 = (float*)(ws + OFF_SSQ1); float* ssq2 = (float*)(ws + OFF_SSQ2); const float* modl = mod + (size_t)l * 9 * 6144;
        (void)mod; (void)abuf; (void)cat; (void)act; (void)ssq1; (void)ssq2; (void)modl; (void)ybuf;
        EpiResid e; e.gscale = 1.f; e.y = ybuf; e.gate = modl + 2048; e.ng = p.in[11] + l * 1024; e.nsc = modl + 4096; e.abuf = abuf; e.ssq_out = ssq2;
        const bf16_t* W = (const bf16_t*)(ws + OFF_OWOUT) + (size_t)li * 1024 * 1024;
#if PROBE_RESID
        e.gscale = 0.f;
        for (int t = bid; t < 64 * 4; t += nb) gemm_tile<192, 4>(cat, 1024, W, 1024, (t % 64) * 192, (t / 64) * 256, e, smem);
        e.gscale = 1.f; __syncthreads();
#endif
        for (int t = bid; t < 64 * 4; t += nb) gemm_tile<192, 4>(cat, 1024, W, 1024, (t % 64) * 192, (t / 64) * 256, e, smem);
      }
#endif
      xcd_barrier(xb);
    }
#ifndef SKIP_M1
    {
        unsigned char* ws = uniform_ptr(ws_); float* ybuf = (float*)uniform_ptr(out_); asm volatile("" : "+s"(ws), "+s"(ybuf));
        float* mod = (float*)(ws + OFF_MOD); bf16_t* abuf = (bf16_t*)(ws + OFF_ABUF); bf16_t* cat = (bf16_t*)(ws + OFF_CAT); bf16_t* act = (bf16_t*)(ws + OFF_ACT);
        float* ssq1 = (float*)(ws + OFF_SSQ1); float* ssq2 = (float*)(ws + OFF_SSQ2); const float* modl = mod + (size_t)l * 9 * 6144;
        (void)mod; (void)abuf; (void)cat; (void)act; (void)ssq1; (void)ssq2; (void)modl; (void)ybuf;
      EpiMlp1 e; e.ssq = ssq2; e.shw = (const float*)(ws + OFF_SHW2) + (size_t)l * 9 * 4096; e.act = act;
      const bf16_t* W = (const bf16_t*)(ws + OFF_W1T) + (size_t)l * 4096 * 1024;
#if PROBE_M1 == 1
      for (int t = bid; t < 48 * 16; t += nb) gemm_tile<256, 2>(abuf, 1024, W, 1024, (t % 48) * 256, (t / 48) * 256, e, smem);
#elif PROBE_M1 == 2
      for (int t = bid; t < 48 * 16; t += nb) gemm_tile<256, 2, true>(abuf, 1024, W, 1024, (t % 48) * 256, (t / 48) * 256, e, smem);
#endif
      for (int t = bid; t < 48 * 16; t += nb) gemm_tile<256, 2>(abuf, 1024, W, 1024, (t % 48) * 256, (t / 48) * 256, e, smem);
    }
#endif
    xcd_barrier(xb);
#ifndef SKIP_M2
    {
        unsigned char* ws = uniform_ptr(ws_); float* ybuf = (float*)uniform_ptr(out_); asm volatile("" : "+s"(ws), "+s"(ybuf));
        float* mod = (float*)(ws + OFF_MOD); bf16_t* abuf = (bf16_t*)(ws + OFF_ABUF); bf16_t* cat = (bf16_t*)(ws + OFF_CAT); bf16_t* act = (bf16_t*)(ws + OFF_ACT);
        float* ssq1 = (float*)(ws + OFF_SSQ1); float* ssq2 = (float*)(ws + OFF_SSQ2); const float* modl = mod + (size_t)l * 9 * 6144;
        (void)mod; (void)abuf; (void)cat; (void)act; (void)ssq1; (void)ssq2; (void)modl; (void)ybuf;
      EpiResid e; e.gscale = 1.f; e.y = ybuf; e.gate = modl + 5120;
      if (l < 3) { e.ng = p.in[10] + (l + 1) * 1024; e.nsc = mod + (size_t)(l + 1) * 9 * 6144 + 1024; } else { e.ng = nullptr; e.nsc = nullptr; }
      e.abuf = abuf; e.ssq_out = ssq1;
      const bf16_t* W = (const bf16_t*)(ws + OFF_W2T) + (size_t)l * 1024 * 4096;
#if PROBE_M2
      e.gscale = 0.f;
      for (int t = bid; t < 64 * 4; t += nb) gemm_tile<192, 4>(act, 4096, W, 4096, (t % 64) * 192, (t / 64) * 256, e, smem);
      e.gscale = 1.f; __syncthreads();
#endif
      for (int t = bid; t < 64 * 4; t += nb) gemm_tile<192, 4>(act, 4096, W, 4096, (t % 64) * 192, (t / 64) * 256, e, smem);
    }
#endif
    if (l < 3) xcd_barrier(xb);
  }
}

static void add_mat(Params& p, int& idx, int& tiles, const float* src, const float* rscale, size_t dst, int K, int N, int Npad, int headpad, int blockdiag) {
  MatDesc& m = p.mats[idx++];
  m.src = src; m.rscale = rscale; m.dst = dst; m.K = K; m.N = N; m.Npad = Npad; m.headpad = headpad; m.tile0 = tiles; m.blockdiag = blockdiag;
  tiles += (K / 128) * (Npad / 64);
}

extern "C" void kernel_launch(void* const* d_in, const int* in_sizes, int n_in, void* d_out, int out_size, void* d_ws, size_t ws_size, hipStream_t stream) {
  if (ws_size < WS_NEED) { fprintf(stderr, "kernel_launch: workspace too small (%zu < %zu)\n", ws_size, (size_t)WS_NEED); return; }
  static int grid_blocks = 0;
  if (!grid_blocks) {
    int dev = 0, cus = 0, per_cu = 0;
    (void)hipGetDevice(&dev);
    (void)hipDeviceGetAttribute(&cus, hipDeviceAttributeMultiprocessorCount, dev);
    (void)hipOccupancyMaxActiveBlocksPerMultiprocessor(&per_cu, fwd_megakernel, NTHREADS, 0);
    if (per_cu < 1) fprintf(stderr, "kernel_launch: occupancy query reports %d blocks per CU\n", per_cu);
    grid_blocks = cus;
  }
  Params p;
  memset(&p, 0, sizeof(p));
  for (int i = 0; i < 30; ++i) p.in[i] = (const float*)d_in[i];
  p.out = (float*)d_out; p.ws = (unsigned char*)d_ws;
  int idx = 0, tiles = 0;
  for (int i = 0; i < 2; ++i) add_mat(p, idx, tiles, p.in[29] + (size_t)i * 1024 * 1024, nullptr, OFF_OWOUT + (size_t)i * 1024 * 1024 * 2, 1024, 1024, 1024, 0, 2 + i);
  for (int l = 0; l < 4; ++l) add_mat(p, idx, tiles, p.in[12] + (size_t)l * 1024 * 4096, nullptr, OFF_W1T + (size_t)l * 4096 * 1024 * 2, 1024, 4096, 4096, 0, 0);
  for (int l = 0; l < 4; ++l) add_mat(p, idx, tiles, p.in[13] + (size_t)l * 4096 * 1024, nullptr, OFF_W2T + (size_t)l * 4096 * 1024 * 2, 4096, 1024, 1024, 0, 0);
  for (int i = 0; i < 2; ++i) add_mat(p, idx, tiles, p.in[14] + (size_t)i * 1024 * 3072, nullptr, OFF_EWIN + (size_t)i * 3072 * 1024 * 2, 1024, 3072, 3072, 0, 0);
  for (int i = 0; i < 2; ++i) add_mat(p, idx, tiles, p.in[19] + (size_t)i * 1024 * 1024, nullptr, OFF_EWOUT + (size_t)i * 1024 * 1024 * 2, 1024, 1024, 1024, 0, 0);
  for (int i = 0; i < 2; ++i) add_mat(p, idx, tiles, p.in[20] + (size_t)i * 1024 * 1184, nullptr, OFF_OWIN + (size_t)i * 1280 * 1024 * 2, 1024, 1184, 1280, 0, 0);
  for (int i = 0; i < 2; ++i) add_mat(p, idx, tiles, p.in[24] + (size_t)i * 384 * 768, p.in[23] + i * 384, OFF_WQB + (size_t)i * 1024 * 384 * 2, 384, 768, 1024, 1, 0);
  for (int i = 0; i < 2; ++i) add_mat(p, idx, tiles, p.in[26] + (size_t)i * 256 * 1024, p.in[25] + i * 256, OFF_WKVB + (size_t)i * 1024 * 256 * 2, 256, 1024, 1024, 0, 0);
  p.conv_tiles = tiles;
  if (hipMemsetAsync((unsigned char*)d_ws + OFF_BAR, 0, 16384, stream) != hipSuccess) { fprintf(stderr, "kernel_launch: memset of barrier words failed\n"); return; }
  void* args[] = {&p};
  hipError_t e = hipLaunchCooperativeKernel((void*)fwd_megakernel, dim3(grid_blocks), dim3(NTHREADS), args, 0, stream);
  if (e != hipSuccess) fprintf(stderr, "cooperative launch failed: %s (grid %d)\n", hipGetErrorString(e), grid_blocks);
}
```

```cpp
#include <hip/hip_runtime.h>
#include <hip/hip_cooperative_groups.h>
#include <cstdio>
#include <cstdint>
#include <cstring>
namespace cg = cooperative_groups;

typedef unsigned short bf16_t;
using bf16x8 = __attribute__((ext_vector_type(8))) short;
using f32x16 = __attribute__((ext_vector_type(16))) float;
typedef __bf16 bf16v2 __attribute__((ext_vector_type(2)));
typedef unsigned u32x4 __attribute__((ext_vector_type(4)));
typedef unsigned u32x2 __attribute__((ext_vector_type(2)));
typedef float f32x4 __attribute__((ext_vector_type(4)));
#define DI __device__ __forceinline__
#define MFMA(a, b, c) __builtin_amdgcn_mfma_f32_32x32x16_bf16((a), (b), (c), 0, 0, 0)
#define CROW(i, h) (((i) & 3) + 8 * ((i) >> 2) + 4 * (h))

#ifndef REP_PH0
#define REP_PH0 1
#endif
#ifndef REP_PH1
#define REP_PH1 1
#endif
#ifndef REP_E2
#define REP_E2 1
#endif
#ifndef REP_E3
#define REP_E3 1
#endif
#ifndef REP_O3
#define REP_O3 1
#endif
#ifndef REP_O4
#define REP_O4 1
#endif
#ifndef REP_M1
#define REP_M1 1
#endif
#ifndef REP_MODS
#define REP_MODS 1
#endif
#ifndef REP_WCONV
#define REP_WCONV 1
#endif
#ifndef REP_CACHE
#define REP_CACHE 1
#endif

#ifndef PROBE_M1
#define PROBE_M1 0
#endif
#ifndef REP_PH0
#define REP_PH0 1
#endif
#ifndef REP_PH1
#define REP_PH1 1
#endif
#ifndef REP_E2
#define REP_E2 1
#endif
#ifndef REP_E3
#define REP_E3 1
#endif
#ifndef REP_O2
#define REP_O2 1
#endif
#ifndef REP_O3
#define REP_O3 1
#endif
#ifndef REP_O4
#define REP_O4 1
#endif
#ifndef PROBE_RESID
#define PROBE_RESID 0
#endif
#ifndef PROBE_M2
#define PROBE_M2 0
#endif
constexpr int T = 12288, TP = 4096;
constexpr float EPS = 1e-6f;
constexpr int NTHREADS = 512;
constexpr int NWAVES = 8;
constexpr int SMEM_BYTES = 147456 + 8192;
constexpr int SIDE_OFF = 147456;

constexpr size_t al(size_t x) { return (x + 255) & ~size_t(255); }
constexpr size_t OFF_BAR   = 0;
constexpr size_t OFF_MOD   = 16384;
constexpr size_t OFF_SHW1  = al(OFF_MOD + 4ull * 9 * 6144 * 4);
constexpr size_t OFF_SHW2  = al(OFF_SHW1 + 4ull * 9 * 3072 * 4);
constexpr size_t OFF_SSQ1  = al(OFF_SHW2 + 4ull * 9 * 4096 * 4);
constexpr size_t OFF_SSQ2  = al(OFF_SSQ1 + 16ull * T * 4);
constexpr size_t OFF_SSQQ  = al(OFF_SSQ2 + 16ull * T * 4);
constexpr size_t OFF_SSQKV = al(OFF_SSQQ + 3ull * T * 4);
constexpr size_t OFF_KPE   = al(OFF_SSQKV + 2ull * T * 4);
constexpr size_t OFF_KVRAW = al(OFF_KPE + (size_t)T * 32 * 4);
constexpr size_t OFF_CNK   = al(OFF_KVRAW + 4096ull * 256 * 4);
constexpr size_t OFF_CNVT  = al(OFF_CNK + 2ull * 2048 * 512 * 2);
constexpr size_t OFF_CCKV  = al(OFF_CNVT + 2ull * 2048 * 512 * 2);
constexpr size_t OFF_W1T   = al(OFF_CCKV + 2ull * 2048 * 256 * 2);
constexpr size_t OFF_W2T   = al(OFF_W1T + 4ull * 4096 * 1024 * 2);
constexpr size_t OFF_EWIN  = al(OFF_W2T + 4ull * 4096 * 1024 * 2);
constexpr size_t OFF_EWOUT = al(OFF_EWIN + 2ull * 3072 * 1024 * 2);
constexpr size_t OFF_OWIN  = al(OFF_EWOUT + 2ull * 1024 * 1024 * 2);
constexpr size_t OFF_WQB   = al(OFF_OWIN + 2ull * 1280 * 1024 * 2);
constexpr size_t OFF_WKVB  = al(OFF_WQB + 2ull * 1024 * 384 * 2);
constexpr size_t OFF_OWOUT = al(OFF_WKVB + 2ull * 1024 * 256 * 2);
constexpr size_t OFF_POOLW = al(OFF_OWOUT + 2ull * 1024 * 1024 * 2);
constexpr size_t OFF_ABUF  = al(OFF_POOLW + 2ull * 512 * 512 * 2);
constexpr size_t OFF_CAT   = al(OFF_ABUF + (size_t)T * 1024 * 2);
constexpr size_t OFF_ACT   = al(OFF_CAT + (size_t)T * 1024 * 2);
constexpr size_t WS_NEED   = al(OFF_ACT + (size_t)T * 4096 * 2);
constexpr size_t OFF_BCONV = OFF_ACT;
constexpr size_t OFF_QBUF  = al(OFF_BCONV + (size_t)T * 1536 * 2);
constexpr size_t OFF_KBUF  = al(OFF_QBUF + (size_t)T * 512 * 2);
constexpr size_t OFF_VTP   = al(OFF_KBUF + (size_t)T * 512 * 2);
constexpr size_t OFF_VTS   = al(OFF_VTP + 16ull * 8 * 64 * 256 * 2);
constexpr size_t OFF_UBUF  = OFF_ACT;
constexpr size_t OFF_QLAT  = al(OFF_UBUF + (size_t)T * 512 * 2);
constexpr size_t OFF_KVLAT = al(OFF_QLAT + (size_t)T * 384 * 2);
constexpr size_t OFF_XP    = al(OFF_KVLAT + (size_t)T * 256 * 2);
constexpr size_t OFF_QMLA  = al(OFF_XP + (size_t)T * 512 * 2);
constexpr size_t OFF_KPM   = al(OFF_QMLA + (size_t)T * 768 * 2);
constexpr size_t OFF_KSM   = al(OFF_KPM + 16ull * 8 * 256 * 96 * 2);
constexpr size_t OFF_VTPM  = al(OFF_KSM + 8ull * 8 * 1280 * 96 * 2);
constexpr size_t OFF_VTSM  = al(OFF_VTPM + 16ull * 8 * 64 * 256 * 2);
static_assert(OFF_VTSM + 8ull * 8 * 64 * 1280 * 2 <= WS_NEED, "odd buffers overflow");
static_assert(OFF_VTS + 8ull * 8 * 64 * 1024 * 2 <= WS_NEED, "even buffers overflow");

constexpr size_t OUT_Y   = 0;
constexpr size_t OUT_NAK = (size_t)T * 1024;
constexpr size_t OUT_NAV = OUT_NAK + 16ull * 2 * 256 * 512;
constexpr size_t OUT_CKV = OUT_NAV + 16ull * 2 * 256 * 512;
constexpr size_t OUT_KPE = OUT_CKV + 16ull * 2 * 256 * 256;

struct MatDesc { const float* src; const float* rscale; unsigned long long dst; int K, N, Npad, headpad, tile0, blockdiag; };
constexpr int NMATS = 20;
struct Params {
  const float* in[30];
  float* out;
  unsigned char* ws;
  MatDesc mats[NMATS];
  int conv_tiles;
  int pad_;
};

__device__ __forceinline__ f32x4 make_f32x4(float a, float b, float c, float d) { f32x4 v = {a, b, c, d}; return v; }
#define GAS __attribute__((address_space(1)))
template <class T> DI void gst(T* p, const T& v) { *(GAS T*)p = v; }
template <class T> DI T gld_nt(const T* p) { return __builtin_nontemporal_load((const GAS T*)p); }
template <class T> DI T gld(const T* p) { return *(const GAS T*)p; }
DI unsigned char* uniform_ptr(const void* p) { const unsigned long long v = (unsigned long long)p; const unsigned lo = __builtin_amdgcn_readfirstlane((unsigned)v), hi = __builtin_amdgcn_readfirstlane((unsigned)(v >> 32)); return (unsigned char*)(((unsigned long long)hi << 32) | lo); }
DI int otid() { int t = threadIdx.x; asm volatile("" : "+v"(t)); return t; }
DI unsigned pack2(float a, float b) { bf16v2 v = {(__bf16)a, (__bf16)b}; return __builtin_bit_cast(unsigned, v); }
DI bf16_t f2bf(float a) { return __builtin_bit_cast(unsigned short, (__bf16)a); }
DI float bf2f(unsigned v16) { return __uint_as_float(v16 << 16); }
DI float bflo(unsigned u) { return __uint_as_float(u << 16); }
DI float bfhi(unsigned u) { return __uint_as_float(u & 0xffff0000u); }
DI int mi_of(int m) { return m < TP ? 0 : 1 + ((m - TP) >> 10); }
DI float xor32(float v) { return __shfl_xor(v, 32, 64); }
template <int CTRL> DI float dpp_get(float v) { return __uint_as_float((unsigned)__builtin_amdgcn_update_dpp(0, (int)__float_as_uint(v), CTRL, 0xf, 0xf, true)); }
DI float sum16(float v) { v += dpp_get<0xB1>(v); v += dpp_get<0x4E>(v); v += dpp_get<0x141>(v); v += dpp_get<0x140>(v); return v; }
DI float hsum32(float v) { const u32x2 r = __builtin_amdgcn_permlane32_swap(__float_as_uint(v), __float_as_uint(v), false, false); return __uint_as_float(r.x) + __uint_as_float(r.y); }
DI float hmax32(float v) { const u32x2 r = __builtin_amdgcn_permlane32_swap(__float_as_uint(v), __float_as_uint(v), false, false); return fmaxf(__uint_as_float(r.x), __uint_as_float(r.y)); }
DI void store_bf4(bf16_t* p, float a, float b, float c, float d) { u32x2 u; u.x = pack2(a, b); u.y = pack2(c, d); *(GAS u32x2*)p = u; }
template <int NP> DI float rstd_parts(const float* ssq, int m, float invn) {
  float v[NP];
#pragma unroll
  for (int p = 0; p < NP; ++p) v[p] = gld(ssq + (size_t)p * T + m);
  float s = 0.f;
#pragma unroll
  for (int p = 0; p < NP; ++p) s += v[p];
  return rsqrtf(s * invn + EPS);
}

#define XB_TMO      128
#define XB_XCNT(j)  (256  + 64 * (j))
#define XB_XSUB(j)  (1280 + 64 * (j))
#define XB_XGEN(j)  (2304 + 64 * (j))
#define XB_TOP      3328
#define XB_TOPGEN   3392
#define XCD_BAR_WORDS 3456
#define XB_SPIN_CAP (1u << 20)
#define LAS __attribute__((address_space(3)))
DI unsigned xb_ld(unsigned* p)              { return __hip_atomic_load(p, __ATOMIC_RELAXED, __HIP_MEMORY_SCOPE_AGENT); }
DI unsigned xb_add(unsigned* p, unsigned v) { return __hip_atomic_fetch_add(p, v, __ATOMIC_RELAXED, __HIP_MEMORY_SCOPE_AGENT); }
DI unsigned xb_xcc_id() { return (unsigned)__builtin_amdgcn_s_getreg((3 << 11) | 20) & 0xFu; }
#define XB_SPIN(cond, bar) do { unsigned _sp = 0; while (cond) { __builtin_amdgcn_s_sleep(1); \
    if ((++_sp & 255u) == 0u) { if (xb_ld(&(bar)[XB_TMO])) break; if (_sp > XB_SPIN_CAP) { atomicAdd(&(bar)[XB_TMO], 1u); break; } } } } while (0)
struct XcdBarrier { unsigned* bar; unsigned x; volatile LAS unsigned* st; };
DI XcdBarrier xcd_barrier_post(unsigned* bar, volatile LAS unsigned* st) {
  XcdBarrier b; b.bar = bar; b.x = xb_xcc_id(); b.st = st;
  if (threadIdx.x == 0) (void)xb_add(&bar[XB_XCNT(b.x)], 1u);
  return b;
}
DI void xcd_barrier_complete(unsigned* bar, unsigned x, unsigned& nloc, unsigned& nx) {
  const unsigned G = gridDim.x * gridDim.y * gridDim.z;
  unsigned sum, cnt, mine, sp = 0u;
  for (;;) {
    sum = 0u; cnt = 0u; mine = 0u;
#pragma unroll
    for (unsigned j = 0; j < 16; ++j) { const unsigned c = xb_ld(&bar[XB_XCNT(j)]); sum += c; cnt += (c > 0u) ? 1u : 0u; mine = (j == x) ? c : mine; }
    if (sum == G) break;
    __builtin_amdgcn_s_sleep(1);
    if ((++sp & 255u) == 0u) { if (xb_ld(&bar[XB_TMO])) break; if (sp > XB_SPIN_CAP) { atomicAdd(&bar[XB_TMO], 1u); break; } }
  }
  nloc = mine > 0u ? mine : 1u; nx = cnt > 0u ? cnt : 1u;
}
DI void xcd_barrier(const XcdBarrier& b) {
  asm volatile("s_waitcnt vmcnt(0)" ::: "memory");
  __syncthreads();
  if (threadIdx.x == 0) {
    unsigned* bar = b.bar;
    __builtin_amdgcn_s_waitcnt(0);
    unsigned nloc = b.st[0], nx = b.st[1];
    if (nloc == 0u) { xcd_barrier_complete(bar, b.x, nloc, nx); b.st[0] = nloc; b.st[1] = nx; }
    const unsigned old = xb_add(&bar[XB_XSUB(b.x)], 1u);
    const unsigned gen = old / nloc;
    if (old + 1u == (gen + 1u) * nloc) {
      __builtin_amdgcn_fence(__ATOMIC_RELEASE, "agent");
      asm volatile("s_waitcnt vmcnt(0)" ::: "memory");
      const unsigned og = xb_add(&bar[XB_TOP], 1u);
      const unsigned tg = og / nx;
      if (og + 1u == (tg + 1u) * nx) xb_add(&bar[XB_TOPGEN], 1u);
      else XB_SPIN(xb_ld(&bar[XB_TOPGEN]) == tg, bar);
      __builtin_amdgcn_fence(__ATOMIC_ACQUIRE, "agent");
      xb_add(&bar[XB_XGEN(b.x)], 1u);
      asm volatile("s_waitcnt vmcnt(0)" ::: "memory");
    } else {
      XB_SPIN(xb_ld(&bar[XB_XGEN(b.x)]) == gen, bar);
      __builtin_amdgcn_fence(__ATOMIC_ACQUIRE, "agent");
      asm volatile("s_waitcnt vmcnt(0)" ::: "memory");
    }
  }
  __syncthreads();
}

typedef __attribute__((address_space(3))) unsigned lds_u32_t;
template <int OFF> DI bf16x8 lds_rd128(unsigned addr) { bf16x8 v; asm volatile("ds_read_b128 %0, %1 offset:%2" : "=v"(v) : "v"(addr), "n"(OFF) : "memory"); return v; }
template <int N, int NW, int NA> DI void lgkm_wait(bf16x8 (&wf)[NW], bf16x8 (&af)[NA]) {
  if constexpr (NW == 4 && NA == 2) asm volatile("s_waitcnt lgkmcnt(%6)" : "+v"(wf[0]), "+v"(wf[1]), "+v"(wf[2]), "+v"(wf[3]), "+v"(af[0]), "+v"(af[1]) : "n"(N) : "memory");
  else if constexpr (NW == 2 && NA == 3) asm volatile("s_waitcnt lgkmcnt(%5)" : "+v"(wf[0]), "+v"(wf[1]), "+v"(af[0]), "+v"(af[1]), "+v"(af[2]) : "n"(N) : "memory");
  else asm volatile("s_waitcnt lgkmcnt(%5)" : "+v"(wf[0]), "+v"(wf[1]), "+v"(wf[2]), "+v"(wf[3]), "+v"(af[0]) : "n"(N) : "memory");
}
template <int TM, int WNW, bool DRY = false, class Epi>
DI void gemm_tile(const bf16_t* __restrict__ A, int lda, const bf16_t* __restrict__ W, int K, int m0, int n0, const Epi& epi, unsigned char* smem) {
  constexpr int WMW = 8 / WNW, NT = 256 / WNW / 32, MT = TM / WMW / 32, NLA = TM / 64, WAVE_N = 256 / WNW, WAVE_M = TM / WMW;
  constexpr int STAGE = (TM + 256) * 128;
  static_assert((NT == 4 && MT == 2) || (NT == 2 && MT == 3) || (NT == 4 && MT == 1), "fragment wait helper covers these shapes");
  const int tid = otid(), lane = tid & 63, w = tid >> 6, r = lane & 31, h = lane >> 5;
  const int wn = w % WNW, wm = w / WNW;
  f32x16 acc[NT][MT];
#pragma unroll
  for (int a = 0; a < NT; ++a)
#pragma unroll
    for (int b = 0; b < MT; ++b)
#pragma unroll
      for (int i = 0; i < 16; ++i) acc[a][b][i] = 0.f;
  const int KT = K >> 6;
  const int lrow = tid >> 3, lkc = (tid & 7) ^ ((tid >> 4) & 7);
  typedef const __attribute__((address_space(1))) unsigned* gsrc_t;
  const bf16_t* ga = A + (size_t)(m0 + lrow) * lda + lkc * 8;
  const bf16_t* gw = W + (size_t)(n0 + lrow) * K + lkc * 8;
#define DMA_TILE(KT_, ST_) do { \
    unsigned char* sa_ = smem + (ST_) * STAGE + tid * 16; \
    _Pragma("unroll") for (int i = 0; i < NLA; ++i) \
      __builtin_amdgcn_global_load_lds((gsrc_t)(ga + (size_t)(64 * i) * lda + (KT_) * 64), (lds_u32_t*)(sa_ + i * 8192), 16, 0, 0); \
    _Pragma("unroll") for (int i = 0; i < 4; ++i) \
      __builtin_amdgcn_global_load_lds((gsrc_t)(gw + (size_t)(64 * i) * K + (KT_) * 64), (lds_u32_t*)(sa_ + TM * 128 + i * 8192), 16, 0, 0); } while (0)
  __syncthreads();
  epi.side(n0, m0, tid, smem + SIDE_OFF);
  DMA_TILE(0, 0);
  const int swz = (r >> 1) & 7;
  const unsigned lbase = (unsigned)(size_t)smem;
  const unsigned offw = lbase + TM * 128 + (wn * WAVE_N + r) * 128, offa = lbase + (wm * WAVE_M + r) * 128;
  unsigned cx[4];
#pragma unroll
  for (int ks = 0; ks < 4; ++ks) cx[ks] = ((2 * ks + h) ^ swz) << 4;
#define FRAGS(BUF, KS_) do { \
    wf[BUF][0] = lds_rd128<0>(pw + cx[KS_]); wf[BUF][1] = lds_rd128<4096>(pw + cx[KS_]); \
    if constexpr (NT == 4) { wf[BUF][2] = lds_rd128<8192>(pw + cx[KS_]); wf[BUF][3] = lds_rd128<12288>(pw + cx[KS_]); } \
    af[BUF][0] = lds_rd128<0>(pa + cx[KS_]); \
    if constexpr (MT >= 2) af[BUF][1] = lds_rd128<4096>(pa + cx[KS_]); \
    if constexpr (MT >= 3) af[BUF][2] = lds_rd128<8192>(pa + cx[KS_]); } while (0)
#define MMAS(BUF) do { _Pragma("unroll") for (int a = 0; a < NT; ++a) _Pragma("unroll") for (int b = 0; b < MT; ++b) acc[a][b] = MFMA(wf[BUF][a], af[BUF][b], acc[a][b]); } while (0)
  for (int kt = 0; kt < KT; ++kt) {
    asm volatile("s_waitcnt vmcnt(0)" ::: "memory");
    __syncthreads();
    if (kt + 1 < KT) DMA_TILE(kt + 1, (kt + 1) & 1);
    __builtin_amdgcn_sched_barrier(0);
    const unsigned pw = offw + (kt & 1) * STAGE, pa = offa + (kt & 1) * STAGE;
    bf16x8 wf[2][NT], af[2][MT];
    FRAGS(0, 0);
    FRAGS(1, 1);
    lgkm_wait<NT + MT>(wf[0], af[0]);
    MMAS(0);
    __builtin_amdgcn_sched_barrier(0);
    FRAGS(0, 2);
    lgkm_wait<NT + MT>(wf[1], af[1]);
    MMAS(1);
    __builtin_amdgcn_sched_barrier(0);
    FRAGS(1, 3);
    lgkm_wait<NT + MT>(wf[0], af[0]);
    MMAS(0);
    __builtin_amdgcn_sched_barrier(0);
    lgkm_wait<0>(wf[1], af[1]);
    MMAS(1);
    __builtin_amdgcn_sched_barrier(0);
  }
#undef DMA_TILE
#undef FRAGS
#undef MMAS
  if (DRY) {
    float sdry = 0.f;
#pragma unroll
    for (int a = 0; a < NT; ++a)
#pragma unroll
      for (int b = 0; b < MT; ++b)
#pragma unroll
        for (int i = 0; i < 16; ++i) sdry += acc[a][b][i];
    if (sdry != 12345.678f) return;
  }
  __syncthreads();
  epi(acc, n0 + wn * WAVE_N, m0 + wm * WAVE_M, lane, smem + w * 9216, smem + SIDE_OFF, n0, m0);
}

struct EpiEvenIn {
  const float* ssq; const float* shw; const float* gq; const float* gk;
  bf16_t* bconv; bf16_t* qbuf; bf16_t* kbuf; bf16_t* vtp; bf16_t* vts; float* out_k; float* out_v; int li;
  DI void side(int n0, int m0, int tid, unsigned char* sd) const {
    float* f = (float*)sd;
    if (tid < 192) f[tid] = rstd_parts<16>(ssq, m0 + tid, 1.f / 1024.f);
    const int mi = mi_of(tid < 256 ? m0 : m0 + 191);
    f[192 + tid] = gld(shw + mi * 3072 + n0 + (tid & 255));
  }
  template <int MT> DI void operator()(f32x16 (&acc)[2][MT], int nb, int mb, int lane, unsigned char* wlds, const unsigned char* side, int n0, int m0) const {
    const int r = lane & 31, h = lane >> 5;
    const int region = nb >> 9;
#pragma unroll
    for (int mt = 0; mt < MT; ++mt) {
      const int m = mb + mt * 32 + r;
      const float* sf = (const float*)side;
      const float rs = sf[m - m0];
      const float* sw = sf + 192 + (mi_of(m) != mi_of(m0) ? 256 : 0) + (nb - n0);
      float ss = 0.f;
#pragma unroll
      for (int nt = 0; nt < 2; ++nt)
#pragma unroll
        for (int g = 0; g < 4; ++g) {
          const f32x4 s4 = *(const f32x4*)(sw + nt * 32 + 8 * g + 4 * h);
          acc[nt][mt][4 * g + 0] = rs * acc[nt][mt][4 * g + 0] + s4.x;
          acc[nt][mt][4 * g + 1] = rs * acc[nt][mt][4 * g + 1] + s4.y;
          acc[nt][mt][4 * g + 2] = rs * acc[nt][mt][4 * g + 2] + s4.z;
          acc[nt][mt][4 * g + 3] = rs * acc[nt][mt][4 * g + 3] + s4.w;
#pragma unroll
          for (int j = 0; j < 4; ++j) ss += acc[nt][mt][4 * g + j] * acc[nt][mt][4 * g + j];
        }
      if (region < 3) {
#pragma unroll
        for (int nt = 0; nt < 2; ++nt)
#pragma unroll
          for (int g = 0; g < 4; ++g)
            store_bf4(bconv + (size_t)m * 1536 + nb + nt * 32 + 8 * g + 4 * h, acc[nt][mt][4 * g], acc[nt][mt][4 * g + 1], acc[nt][mt][4 * g + 2], acc[nt][mt][4 * g + 3]);
      } else if (region < 5) {
        const bool isk = region == 4;
        const float* gain = isk ? gk : gq;
        bf16_t* dst = (isk ? kbuf : qbuf) + (size_t)m * 512 + (nb - (isk ? 2048 : 1536));
        float* od = nullptr;
        if (isk && m < TP) od = out_k + ((size_t)(((m >> 8) * 2 + li) * 256 + (m & 255))) * 512 + (nb - 2048);
        ss = hsum32(ss);
        const float rn = rsqrtf(ss * (1.f / 64.f) + EPS);
#pragma unroll
        for (int nt = 0; nt < 2; ++nt)
#pragma unroll
          for (int g = 0; g < 4; ++g) {
            const int d = nt * 32 + 8 * g + 4 * h;
            const f32x4 g4 = gld((const f32x4*)(gain + d));
            const float o0 = acc[nt][mt][4 * g] * rn * g4.x, o1 = acc[nt][mt][4 * g + 1] * rn * g4.y, o2 = acc[nt][mt][4 * g + 2] * rn * g4.z, o3 = acc[nt][mt][4 * g + 3] * rn * g4.w;
            store_bf4(dst + d, o0, o1, o2, o3);
            if (od) *(GAS f32x4*)(od + d) = make_f32x4(o0, o1, o2, o3);
          }
      } else {
        const bool pr = m < TP;
        const int s = m - TP;
        const int hd = (nb - 2560) >> 6;
        float* od = pr ? out_v + ((size_t)(((m >> 8) * 2 + li) * 256 + (m & 255))) * 512 + (nb - 2560) : nullptr;
        bf16_t* vt0 = pr ? vtp + ((size_t)((m >> 8) * 8 + hd) * 64) * 256 + (m & 255) : vts + ((size_t)((s >> 10) * 8 + hd) * 64) * 1024 + (s & 1023);
        const int st = pr ? 256 : 1024;
#pragma unroll
        for (int nt = 0; nt < 2; ++nt)
#pragma unroll
          for (int g = 0; g < 4; ++g) {
            const int d = nt * 32 + 8 * g + 4 * h;
#pragma unroll
            for (int j = 0; j < 4; ++j) gst(vt0 + (size_t)(d + j) * st, f2bf(acc[nt][mt][4 * g + j]));
            if (pr) *(GAS f32x4*)(od + d) = make_f32x4(acc[nt][mt][4 * g], acc[nt][mt][4 * g + 1], acc[nt][mt][4 * g + 2], acc[nt][mt][4 * g + 3]);
          }
      }
    }
  }
};

struct EpiResid {
  float* y; const float* gate; const float* ng; const float* nsc; bf16_t* abuf; float* ssq_out; float gscale;
  DI void side(int n0, int m0, int tid, unsigned char* sd) const {
    float* f = (float*)sd;
    const int mi = mi_of(tid < 256 ? m0 : m0 + 191), n = n0 + (tid & 255);
    f[tid] = gld(gate + mi * 6144 + n) * gscale;
    f[512 + tid] = ng ? gld(ng + n) * (1.f + gld(nsc + mi * 6144 + n)) : 0.f;
  }
  template <int MT> DI void operator()(f32x16 (&acc)[2][MT], int nb, int mb, int lane, unsigned char* wlds, const unsigned char* side, int n0, int m0) const {
    const int r = lane & 31, h = lane >> 5, cc = lane & 15, rq = lane >> 4;
    const int mi0 = mi_of(m0);
#pragma unroll
    for (int mt = 0; mt < MT; ++mt) {
#pragma unroll
      for (int nt = 0; nt < 2; ++nt)
#pragma unroll
        for (int g = 0; g < 4; ++g)
          *(f32x4*)(wlds + r * 272 + (nt * 32 + 8 * g + 4 * h) * 4) = make_f32x4(acc[nt][mt][4 * g], acc[nt][mt][4 * g + 1], acc[nt][mt][4 * g + 2], acc[nt][mt][4 * g + 3]);
#pragma unroll
      for (int i = 0; i < 8; ++i) {
        const int row = rq + 4 * i;
        const int m = mb + mt * 32 + row, n = nb + cc * 4;
        const float* sf = (const float*)side + (mi_of(m) != mi0 ? 256 : 0) + (n - n0);
        const f32x4 a = *(const f32x4*)(wlds + row * 272 + cc * 16);
        f32x4 yo = gld((const f32x4*)(y + (size_t)m * 1024 + n));
        const f32x4 gt = *(const f32x4*)sf;
        yo.x += gt.x * a.x; yo.y += gt.y * a.y; yo.z += gt.z * a.z; yo.w += gt.w * a.w;
        *(GAS f32x4*)(y + (size_t)m * 1024 + n) = yo;
        if (ng) {
          const f32x4 gg = *(const f32x4*)(sf + 512);
          store_bf4(abuf + (size_t)m * 1024 + n, yo.x * gg.x, yo.y * gg.y, yo.z * gg.z, yo.w * gg.w);
          float ss = yo.x * yo.x + yo.y * yo.y + yo.z * yo.z + yo.w * yo.w;
          ss = sum16(ss);
          if (cc == 0) gst(ssq_out + (size_t)(nb >> 6) * T + m, ss);
        }
      }
    }
  }
};

struct EpiMlp1 {
  const float* ssq; const float* shw; bf16_t* act;
  DI void side(int n0, int m0, int tid, unsigned char* sd) const {
    float* f = (float*)sd;
    if (tid < 256) f[tid] = rstd_parts<16>(ssq, m0 + tid, 1.f / 1024.f);
    else f[tid] = gld(shw + mi_of(m0) * 4096 + n0 + (tid - 256));
  }
  template <int NT, int MT> DI void operator()(f32x16 (&acc)[NT][MT], int nb, int mb, int lane, unsigned char* wlds, const unsigned char* side, int n0, int m0) const {
    const int r = lane & 31, h = lane >> 5;
    constexpr int RS = NT * 64 + 16;
    constexpr int CPR = NT * 4;
#pragma unroll
    for (int mt = 0; mt < MT; ++mt) {
      const float* sf = (const float*)side;
      const float rs = sf[mb - m0 + mt * 32 + r];
#pragma unroll
      for (int nt = 0; nt < NT; ++nt)
#pragma unroll
        for (int g = 0; g < 4; ++g) {
          const int nl = nt * 32 + 8 * g + 4 * h;
          const f32x4 s4 = *(const f32x4*)(sf + 256 + (nb - n0) + nl);
          float v0 = fmaxf(rs * acc[nt][mt][4 * g] + s4.x, 0.f), v1 = fmaxf(rs * acc[nt][mt][4 * g + 1] + s4.y, 0.f);
          float v2 = fmaxf(rs * acc[nt][mt][4 * g + 2] + s4.z, 0.f), v3 = fmaxf(rs * acc[nt][mt][4 * g + 3] + s4.w, 0.f);
          u32x2 u; u.x = pack2(v0 * v0, v1 * v1); u.y = pack2(v2 * v2, v3 * v3);
          *(u32x2*)(wlds + r * RS + nl * 2) = u;
        }
#pragma unroll
      for (int i = 0; i < 32 * CPR / 64; ++i) {
        const int c = lane + 64 * i, row = c / CPR, cc = c % CPR;
        const u32x4 v = *(const u32x4*)(wlds + row * RS + cc * 16);
        *(GAS u32x4*)(act + (size_t)(mb + mt * 32 + row) * 4096 + nb + cc * 8) = v;
      }
    }
  }
};

struct EpiOddIn {
  const float* ssq; const float* shw; bf16_t* ubuf; bf16_t* qlat; bf16_t* kvlat; float* kpebuf; float* ssqq; float* ssqkv; float* out_ckv; float* out_kpe; int li;
  DI void side(int n0, int m0, int tid, unsigned char* sd) const {
    float* f = (float*)sd;
    if (tid < 256) f[tid] = rstd_parts<16>(ssq, m0 + tid, 1.f / 1024.f);
    else f[tid] = gld(shw + mi_of(m0) * 3072 + n0 + (tid - 256));
  }
  template <int MT> DI void operator()(f32x16 (&acc)[4][MT], int nb, int mb, int lane, unsigned char* wlds, const unsigned char* side, int n0, int m0) const {
    const int r = lane & 31, h = lane >> 5;
#pragma unroll
    for (int mt = 0; mt < MT; ++mt) {
      __builtin_amdgcn_sched_barrier(0);
      const int m = mb + mt * 32 + r;
      const float* sf = (const float*)side;
      const float rs = sf[m - m0];
      const float* sw = sf + 256 + (nb - n0);
      float ss = 0.f;
#pragma unroll
      for (int nt = 0; nt < 4; ++nt)
#pragma unroll
        for (int g = 0; g < 4; ++g) {
          const f32x4 s4 = *(const f32x4*)(sw + nt * 32 + 8 * g + 4 * h);
          acc[nt][mt][4 * g + 0] = rs * acc[nt][mt][4 * g + 0] + s4.x;
          acc[nt][mt][4 * g + 1] = rs * acc[nt][mt][4 * g + 1] + s4.y;
          acc[nt][mt][4 * g + 2] = rs * acc[nt][mt][4 * g + 2] + s4.z;
          acc[nt][mt][4 * g + 3] = rs * acc[nt][mt][4 * g + 3] + s4.w;
#pragma unroll
          for (int j = 0; j < 4; ++j) ss += acc[nt][mt][4 * g + j] * acc[nt][mt][4 * g + j];
        }
      ss = hsum32(ss);
      const size_t prow = (size_t)(((m >> 8) * 2 + li) * 256 + (m & 255));
      if (nb < 512) {
#pragma unroll
        for (int nt = 0; nt < 4; ++nt)
#pragma unroll
          for (int g = 0; g < 4; ++g)
            store_bf4(ubuf + (size_t)m * 512 + nb + nt * 32 + 8 * g + 4 * h, acc[nt][mt][4 * g], acc[nt][mt][4 * g + 1], acc[nt][mt][4 * g + 2], acc[nt][mt][4 * g + 3]);
      } else if (nb < 896) {
#pragma unroll
        for (int nt = 0; nt < 4; ++nt)
#pragma unroll
          for (int g = 0; g < 4; ++g)
            store_bf4(qlat + (size_t)m * 384 + (nb - 512) + nt * 32 + 8 * g + 4 * h, acc[nt][mt][4 * g], acc[nt][mt][4 * g + 1], acc[nt][mt][4 * g + 2], acc[nt][mt][4 * g + 3]);
        if (h == 0) gst(ssqq + (size_t)((nb - 512) >> 7) * T + m, ss);
      } else if (nb < 1152) {
#pragma unroll
        for (int nt = 0; nt < 4; ++nt)
#pragma unroll
          for (int g = 0; g < 4; ++g) {
            const int c = (nb - 896) + nt * 32 + 8 * g + 4 * h;
            store_bf4(kvlat + (size_t)m * 256 + c, acc[nt][mt][4 * g], acc[nt][mt][4 * g + 1], acc[nt][mt][4 * g + 2], acc[nt][mt][4 * g + 3]);
            if (m < TP) *(GAS f32x4*)(out_ckv + (size_t)m * 256 + c) = make_f32x4(acc[nt][mt][4 * g], acc[nt][mt][4 * g + 1], acc[nt][mt][4 * g + 2], acc[nt][mt][4 * g + 3]);
          }
        if (h == 0) gst(ssqkv + (size_t)((nb - 896) >> 7) * T + m, ss);
      } else {
#pragma unroll
        for (int g = 0; g < 4; ++g) {
          const int c = 8 * g + 4 * h;
          const f32x4 v = make_f32x4(acc[0][mt][4 * g], acc[0][mt][4 * g + 1], acc[0][mt][4 * g + 2], acc[0][mt][4 * g + 3]);
          *(GAS f32x4*)(kpebuf + (size_t)m * 32 + c) = v;
          if (m < TP) *(GAS f32x4*)(out_kpe + prow * 32 + c) = v;
        }
      }
    }
  }
};

DI void rope_cs(int j8, float posv, float& c, float& s) {
  const float inv = __builtin_amdgcn_exp2f(-1.6609640474436813f * (float)j8);
  const float ang = posv * inv;
  c = __cosf(ang); s = __sinf(ang);
}

struct EpiQUp {
  DI void side(int, int, int, unsigned char*) const {}
  const float* ssqq; const float* gq; bf16_t* qmla;
  template <int MT> DI void operator()(f32x16 (&acc)[4][MT], int nb, int mb, int lane, unsigned char* wlds, const unsigned char* side, int n0, int m0) const {
   const int r = lane & 31, h = lane >> 5, hd = nb >> 7;
#pragma unroll
   for (int mt = 0; mt < MT; ++mt) {
    __builtin_amdgcn_sched_barrier(0);
    const int m = mb + mt * 32 + r;
    const float rq = rstd_parts<3>(ssqq, m, 1.f / 384.f);
    float ss = 0.f;
#pragma unroll
    for (int nt = 0; nt < 3; ++nt)
#pragma unroll
      for (int i = 0; i < 16; ++i) { acc[nt][mt][i] *= rq; ss += acc[nt][mt][i] * acc[nt][mt][i]; }
    ss = hsum32(ss);
    const float rn = rsqrtf(ss * (1.f / 96.f) + EPS);
#pragma unroll
    for (int nt = 0; nt < 3; ++nt)
#pragma unroll
      for (int g = 0; g < 4; ++g) {
        const f32x4 g4 = gld((const f32x4*)(gq + nt * 32 + 8 * g + 4 * h));
        acc[nt][mt][4 * g] *= rn * g4.x; acc[nt][mt][4 * g + 1] *= rn * g4.y; acc[nt][mt][4 * g + 2] *= rn * g4.z; acc[nt][mt][4 * g + 3] *= rn * g4.w;
      }
    if (m >= TP) {
      const int pos = (m - TP) & 1023;
      const float prow = (float)(pos >> 6), pcol = (float)(pos & 63);
#pragma unroll
      for (int g = 0; g < 2; ++g)
#pragma unroll
        for (int j = 0; j < 4; ++j) {
          float c, s; rope_cs(4 * h + j, g == 0 ? prow : pcol, c, s);
          const float x1 = acc[2][mt][4 * g + j], x2 = acc[2][mt][8 + 4 * g + j];
          acc[2][mt][4 * g + j] = x1 * c - x2 * s;
          acc[2][mt][8 + 4 * g + j] = x2 * c + x1 * s;
        }
    }
#pragma unroll
    for (int nt = 0; nt < 3; ++nt)
#pragma unroll
      for (int g = 0; g < 4; ++g)
        store_bf4(qmla + (size_t)m * 768 + hd * 96 + nt * 32 + 8 * g + 4 * h, acc[nt][mt][4 * g], acc[nt][mt][4 * g + 1], acc[nt][mt][4 * g + 2], acc[nt][mt][4 * g + 3]);
   }
  }
};

struct EpiKvUp {
  DI void side(int, int, int, unsigned char*) const {}
  const float* ssqkv; const float* gk; const float* kpebuf; const float* cache_kpe; bf16_t* kpm; bf16_t* ksm; bf16_t* vtpm; bf16_t* vtsm; int li; int cache;
  template <int MT> DI void operator()(f32x16 (&acc)[4][MT], int nb, int mb, int lane, unsigned char* wlds, const unsigned char* side, int n0, int m0) const {
   const int r = lane & 31, h = lane >> 5, hd = nb >> 7;
#pragma unroll
   for (int mt = 0; mt < MT; ++mt) {
    __builtin_amdgcn_sched_barrier(0);
    const int m = mb + mt * 32 + r;
    float rs = 1.f;
    const float* kp;
    bf16_t* kdst; bf16_t* vdst; int vst; bool rope = false; int pos = 0;
    if (cache) {
      const int b = m >> 8, p = m & 255;
      kp = cache_kpe + ((size_t)((b * 2 + li) * 256 + p)) * 32;
      kdst = ksm + ((size_t)(b * 8 + hd) * 1280 + p) * 96;
      vdst = vtsm + ((size_t)(b * 8 + hd) * 64) * 1280 + p; vst = 1280;
    } else {
      rs = rstd_parts<2>(ssqkv, m, 1.f / 256.f);
      kp = kpebuf + (size_t)m * 32;
      if (m < TP) {
        const int b = m >> 8, p = m & 255;
        kdst = kpm + ((size_t)(b * 8 + hd) * 256 + p) * 96;
        vdst = vtpm + ((size_t)(b * 8 + hd) * 64) * 256 + p; vst = 256;
      } else {
        const int s = m - TP, b = s >> 10; pos = s & 1023; rope = true;
        kdst = ksm + ((size_t)(b * 8 + hd) * 1280 + 256 + pos) * 96;
        vdst = vtsm + ((size_t)(b * 8 + hd) * 64) * 1280 + 256 + pos; vst = 1280;
      }
    }
    float ss = 0.f;
#pragma unroll
    for (int nt = 0; nt < 4; ++nt)
#pragma unroll
      for (int i = 0; i < 16; ++i) { acc[nt][mt][i] *= rs; if (nt < 2) ss += acc[nt][mt][i] * acc[nt][mt][i]; }
    ss = hsum32(ss);
    const f32x4 a0 = gld((const f32x4*)(kp + 8 * h)), a1 = gld((const f32x4*)(kp + 8 * h + 4));
    const f32x4 b0 = gld((const f32x4*)(kp + 16 + 8 * h)), b1 = gld((const f32x4*)(kp + 16 + 8 * h + 4));
    float x1[8] = {a0.x, a0.y, a0.z, a0.w, a1.x, a1.y, a1.z, a1.w};
    float x2[8] = {b0.x, b0.y, b0.z, b0.w, b1.x, b1.y, b1.z, b1.w};
    float sp = 0.f;
#pragma unroll
    for (int j = 0; j < 8; ++j) sp += x1[j] * x1[j] + x2[j] * x2[j];
    sp = hsum32(sp);
    const float rn = rsqrtf((ss + sp) * (1.f / 96.f) + EPS);
#pragma unroll
    for (int nt = 0; nt < 2; ++nt)
#pragma unroll
      for (int g = 0; g < 4; ++g) {
        const int d = nt * 32 + 8 * g + 4 * h;
        const f32x4 g4 = gld((const f32x4*)(gk + d));
        store_bf4(kdst + d, acc[nt][mt][4 * g] * rn * g4.x, acc[nt][mt][4 * g + 1] * rn * g4.y, acc[nt][mt][4 * g + 2] * rn * g4.z, acc[nt][mt][4 * g + 3] * rn * g4.w);
      }
    const float prow = (float)(pos >> 6), pcol = (float)(pos & 63);
#pragma unroll
    for (int j = 0; j < 8; ++j) {
      const int jj = 8 * h + j;
      float a = x1[j] * rn * gk[64 + jj], b = x2[j] * rn * gk[80 + jj];
      if (rope) {
        float c, s; rope_cs(j, h == 0 ? prow : pcol, c, s);
        const float na = a * c - b * s, nb2 = b * c + a * s;
        a = na; b = nb2;
      }
      x1[j] = a; x2[j] = b;
    }
    { u32x4 u; u.x = pack2(x1[0], x1[1]); u.y = pack2(x1[2], x1[3]); u.z = pack2(x1[4], x1[5]); u.w = pack2(x1[6], x1[7]); *(GAS u32x4*)(kdst + 64 + 8 * h) = u; }
    { u32x4 u; u.x = pack2(x2[0], x2[1]); u.y = pack2(x2[2], x2[3]); u.z = pack2(x2[4], x2[5]); u.w = pack2(x2[6], x2[7]); *(GAS u32x4*)(kdst + 80 + 8 * h) = u; }
#pragma unroll
    for (int nt = 2; nt < 4; ++nt)
#pragma unroll
      for (int i = 0; i < 16; ++i) {
        const int d = (nt - 2) * 32 + CROW(i, h);
        gst(vdst + (size_t)d * vst, f2bf(acc[nt][mt][i]));
      }
   }
  }
};

struct EpiPool {
  DI void side(int, int, int, unsigned char*) const {}
  const float* scale; bf16_t* cat;
  template <int NT, int MT> DI void operator()(f32x16 (&acc)[NT][MT], int nb, int mb, int lane, unsigned char* wlds, const unsigned char* side, int n0, int m0) const {
    const int r = lane & 31, h = lane >> 5;
#pragma unroll
    for (int mt = 0; mt < MT; ++mt) {
      const int m = mb + mt * 32 + r;
#pragma unroll
      for (int nt = 0; nt < NT; ++nt)
#pragma unroll
        for (int g = 0; g < 4; ++g) {
          const int n = nb + nt * 32 + 8 * g + 4 * h;
          const f32x4 s4 = gld((const f32x4*)(scale + n));
          store_bf4(cat + (size_t)m * 1024 + n, acc[nt][mt][4 * g] * s4.x, acc[nt][mt][4 * g + 1] * s4.y, acc[nt][mt][4 * g + 2] * s4.z, acc[nt][mt][4 * g + 3] * s4.w);
        }
    }
  }
};

template <int DQK>
DI void attn_task(const bf16_t* __restrict__ Q, int qs,
                  const bf16_t* __restrict__ K0, int ks0, const bf16_t* __restrict__ V0, int vs0, int nt0,
                  const bf16_t* __restrict__ K1, int ks1, const bf16_t* __restrict__ V1, int vs1, int nt1,
                  bool na, int qrow0, int krow0, const float* __restrict__ rpb_h,
                  bf16_t* __restrict__ O, int os, float scale, unsigned char* smem) {
  constexpr int KSTR = (DQK + 8) * 2;
  constexpr int CH = DQK / 8;
  constexpr int NKC = (CH * 64 + 511) / 512;
  constexpr int KSTAGE = 64 * 208, VSTAGE = 64 * 144;
  constexpr float LOG2E = 1.4426950408889634f;
  const int tid = otid(), lane = tid & 63, w = tid >> 6, r = lane & 31, h = lane >> 5;
  float* srpb = (float*)(smem + 2 * KSTAGE + 2 * VSTAGE);
  const int NTT = nt0 + nt1;

  __syncthreads();
  if (na) for (int i = tid; i < 465; i += 512) srpb[i] = rpb_h[i] * LOG2E;

  bf16x8 qf[DQK / 16];
  {
    const bf16_t* qp = Q + (size_t)(32 * w + r) * qs + 8 * h;
#pragma unroll
    for (int ks = 0; ks < DQK / 16; ++ks) qf[ks] = gld((const bf16x8*)(qp + ks * 16));
  }
  u32x4 rk[NKC], rv;
  const int vrow = tid >> 3, vkc = tid & 7;
  auto gload = [&](int j) {
    const bf16_t* kp; const bf16_t* vp; int kst, vst;
    if (j < nt0) { kp = K0 + (size_t)j * 64 * ks0; kst = ks0; vp = V0 + j * 64; vst = vs0; }
    else { kp = K1 + (size_t)(j - nt0) * 64 * ks1; kst = ks1; vp = V1 + (j - nt0) * 64; vst = vs1; }
#pragma unroll
    for (int i = 0; i < NKC; ++i) { const int c = tid + 512 * i; if (c < CH * 64) rk[i] = gld((const u32x4*)(kp + (size_t)(c / CH) * kst + (c % CH) * 8)); }
    rv = gld((const u32x4*)(vp + (size_t)vrow * vst + vkc * 8));
  };
  gload(0);

  f32x16 ot[2];
#pragma unroll
  for (int t = 0; t < 2; ++t)
#pragma unroll
    for (int i = 0; i < 16; ++i) ot[t][i] = 0.f;
  float m_run = -3.0e38f, l_run = 0.f;
  const float sc2 = scale * LOG2E;
  const int qrow = qrow0 + (w >> 1), qcol = 32 * (w & 1) + r;
  const int rsw = min(max(qrow - 4, 0), 8);
  const int csq = min(max(qcol - 8, 0), 48);

  for (int j = 0; j < NTT; ++j) {
    unsigned char* sK = smem + (j & 1) * KSTAGE;
    unsigned char* sV = smem + 2 * KSTAGE + (j & 1) * VSTAGE;
#pragma unroll
    for (int i = 0; i < NKC; ++i) { const int c = tid + 512 * i; if (c < CH * 64) *(u32x4*)(sK + (c / CH) * KSTR + (c % CH) * 16) = rk[i]; }
    *(u32x4*)(sV + vrow * 144 + vkc * 16) = rv;
    __syncthreads();
    if (j + 1 < NTT) gload(j + 1);
    __builtin_amdgcn_sched_barrier(0);
    const bool local = na && j < nt0;
    const int keyrow = krow0 + j;
    if (local && (keyrow < rsw || keyrow >= rsw + 8)) continue;
    f32x16 st[2];
#pragma unroll
    for (int t = 0; t < 2; ++t)
#pragma unroll
      for (int i = 0; i < 16; ++i) st[t][i] = 0.f;
    {
      bf16x8 kf[DQK / 16][2];
#pragma unroll
      for (int ks = 0; ks < DQK / 16; ++ks)
#pragma unroll
        for (int t = 0; t < 2; ++t) kf[ks][t] = *(const bf16x8*)(sK + (t * 32 + r) * KSTR + ks * 32 + h * 16);
      __builtin_amdgcn_sched_barrier(0);
#pragma unroll
      for (int ks = 0; ks < DQK / 16; ++ks)
#pragma unroll
        for (int t = 0; t < 2; ++t) st[t] = MFMA(kf[ks][t], qf[ks], st[t]);
    }
    bf16x8 vfr[4][2];
#pragma unroll
    for (int s2 = 0; s2 < 4; ++s2)
#pragma unroll
      for (int dv = 0; dv < 2; ++dv) {
        const unsigned char* vb = sV + (dv * 32 + r) * 144 + (16 * s2 + 4 * h) * 2;
        const u32x2 v0 = *(const u32x2*)(vb), v1 = *(const u32x2*)(vb + 16);
        const u32x4 vu = {v0.x, v0.y, v1.x, v1.y};
        vfr[s2][dv] = __builtin_bit_cast(bf16x8, vu);
      }
    __builtin_amdgcn_sched_barrier(0);
    float mx = -3.0e38f;
    if (local) {
      const int dr = keyrow - qrow + 7;
#pragma unroll
      for (int t = 0; t < 2; ++t)
#pragma unroll
        for (int i = 0; i < 16; ++i) {
          const int kc = t * 32 + CROW(i, h);
          const bool valid = (kc >= csq) && (kc < csq + 16);
          const int dc = min(max(kc - qcol + 15, 0), 30);
          const float bias = srpb[dr * 31 + dc];
          const float s = valid ? __builtin_fmaf(st[t][i], sc2, bias) : -1.0e30f;
          st[t][i] = s; mx = fmaxf(mx, s);
        }
    } else {
#pragma unroll
      for (int t = 0; t < 2; ++t)
#pragma unroll
        for (int i = 0; i < 16; ++i) mx = fmaxf(mx, st[t][i]);
      mx *= sc2;
    }
    mx = hmax32(mx);
    const float m_new = fmaxf(m_run, mx);
    if (__builtin_amdgcn_ballot_w64(m_new - m_run > 8.0f) != 0ull) {
      const float alpha = __builtin_amdgcn_exp2f(m_run - m_new);
      l_run *= alpha;
#pragma unroll
      for (int t = 0; t < 2; ++t)
#pragma unroll
        for (int i = 0; i < 16; ++i) ot[t][i] *= alpha;
      m_run = m_new;
    }
    if (local) {
#pragma unroll
      for (int t = 0; t < 2; ++t)
#pragma unroll
        for (int i = 0; i < 16; ++i) { const float p = __builtin_amdgcn_exp2f(st[t][i] - m_run); st[t][i] = p; l_run += p; }
    } else {
#pragma unroll
      for (int t = 0; t < 2; ++t)
#pragma unroll
        for (int i = 0; i < 16; ++i) { const float p = __builtin_amdgcn_exp2f(__builtin_fmaf(st[t][i], sc2, -m_run)); st[t][i] = p; l_run += p; }
    }
#pragma unroll
    for (int s2 = 0; s2 < 4; ++s2) {
      const int t = s2 >> 1, o = (s2 & 1) * 8;
      const u32x4 pu = {pack2(st[t][o + 0], st[t][o + 1]), pack2(st[t][o + 2], st[t][o + 3]), pack2(st[t][o + 4], st[t][o + 5]), pack2(st[t][o + 6], st[t][o + 7])};
      const bf16x8 pfv = __builtin_bit_cast(bf16x8, pu);
#pragma unroll
      for (int dv = 0; dv < 2; ++dv) ot[dv] = MFMA(vfr[s2][dv], pfv, ot[dv]);
    }
  }
  const float lt = hsum32(l_run);
  const float inv = 1.f / lt;
  bf16_t* op = O + (size_t)(32 * w + r) * os;
#pragma unroll
  for (int dv = 0; dv < 2; ++dv)
#pragma unroll
    for (int g = 0; g < 4; ++g)
      store_bf4(op + dv * 32 + 8 * g + 4 * h, ot[dv][4 * g] * inv, ot[dv][4 * g + 1] * inv, ot[dv][4 * g + 2] * inv, ot[dv][4 * g + 3] * inv);
}

DI void job_mods(const Params& p, int j, unsigned char* smem) {
  const int tid = otid(), lane = tid & 63, w = tid >> 6, kq = lane >> 4, c4 = lane & 15;
  const int l = j / 96, n0 = (j % 96) * 64;
  float* s = (float*)smem;
  __syncthreads();
  for (int idx = tid; idx < 9 * 1024; idx += 512) {
    const int mi = idx >> 10, k = idx & 1023;
    const float x = mi == 0 ? p.in[7][k] : p.in[6][(mi - 1) * 1024 + k];
    s[idx] = x / (1.f + expf(-x));
  }
  __syncthreads();
  const float* Wp = p.in[8] + ((size_t)l * 1024 + w * 128 + kq) * 6144 + n0 + 4 * c4;
  float acc[9][4];
#pragma unroll
  for (int mi = 0; mi < 9; ++mi)
#pragma unroll
    for (int q = 0; q < 4; ++q) acc[mi][q] = 0.f;
#pragma unroll 8
  for (int i = 0; i < 32; ++i) {
    const f32x4 wv = gld_nt((const f32x4*)(Wp + (size_t)(4 * i) * 6144));
    const int k = w * 128 + 4 * i + kq;
#pragma unroll
    for (int mi = 0; mi < 9; ++mi) {
      const float sv = s[mi * 1024 + k];
      acc[mi][0] += sv * wv.x; acc[mi][1] += sv * wv.y; acc[mi][2] += sv * wv.z; acc[mi][3] += sv * wv.w;
    }
  }
#pragma unroll
  for (int mi = 0; mi < 9; ++mi)
#pragma unroll
    for (int q = 0; q < 4; ++q) { float v = acc[mi][q]; v += __shfl_xor(v, 16, 64); v += __shfl_xor(v, 32, 64); acc[mi][q] = v; }
  __syncthreads();
  float* red = (float*)smem;
  if (kq == 0) {
#pragma unroll
    for (int mi = 0; mi < 9; ++mi)
#pragma unroll
      for (int q = 0; q < 4; ++q) red[(w * 9 + mi) * 64 + 4 * c4 + q] = acc[mi][q];
  }
  __syncthreads();
  float* mod = (float*)(p.ws + OFF_MOD);
  for (int idx = tid; idx < 9 * 64; idx += 512) {
    const int mi = idx >> 6, ln = idx & 63;
    float v = 0.f;
#pragma unroll
    for (int q = 0; q < 8; ++q) v += red[(q * 9 + mi) * 64 + ln];
    mod[(size_t)(l * 9 + mi) * 6144 + n0 + ln] = v + p.in[9][l * 6144 + n0 + ln];
  }
}

DI void job_wconv(const Params& p, int t) {
  int mi = 0;
#pragma unroll 1
  for (int i = 1; i < NMATS; ++i) if (t >= p.mats[i].tile0) mi = i;
  const MatDesc md = p.mats[mi];
  const int lt = t - md.tile0;
  const int ktiles = md.K >> 7;
  const int k0 = (lt % ktiles) * 128 + (otid() >> 6) * 16, n = (lt / ktiles) * 64 + (otid() & 63);
  const float* sp; bool ok; size_t rs;
  if (md.blockdiag == 1) { ok = (k0 >> 7) == (n >> 7); sp = md.src + (size_t)(k0 >> 7) * 16384 + (size_t)(k0 & 127) * 128 + (n & 127); rs = 128; }
  else if (md.headpad) { const int hd = n >> 7, d = n & 127; ok = d < 96; sp = md.src + (size_t)k0 * md.N + hd * 96 + d; rs = md.N; }
  else { ok = n < md.N; sp = md.src + (size_t)k0 * md.N + n; rs = md.N; }
  float v[16];
  if (md.blockdiag >= 2 && k0 < 512) {
    const int li = md.blockdiag - 2, g = k0 >> 7;
    const int krow = __builtin_amdgcn_readfirstlane(k0 & 127);
    const float* pw = p.in[21] + ((size_t)(li * 4 + g) * 128 + krow) * 128;
    const float* scp = p.in[22] + li * 512 + g * 128;
    const float* wo = md.src + (size_t)(g * 128) * md.N + n;
#pragma unroll
    for (int q = 0; q < 16; ++q) v[q] = 0.f;
#pragma unroll 8
    for (int d = 0; d < 128; ++d) {
      const float x = scp[d] * wo[(size_t)d * md.N];
#pragma unroll
      for (int q = 0; q < 16; ++q) v[q] += pw[q * 128 + d] * x;
    }
  } else {
#pragma unroll
  for (int q = 0; q < 16; ++q) v[q] = ok ? gld_nt(sp + (size_t)q * rs) : 0.f;
  }
  if (md.rscale) {
#pragma unroll
    for (int q = 0; q < 16; ++q) v[q] *= md.rscale[k0 + q];
  }
  bf16_t* dst = (bf16_t*)(p.ws + md.dst) + (size_t)n * md.K + k0;
  u32x4 u0 = {pack2(v[0], v[1]), pack2(v[2], v[3]), pack2(v[4], v[5]), pack2(v[6], v[7])};
  u32x4 u1 = {pack2(v[8], v[9]), pack2(v[10], v[11]), pack2(v[12], v[13]), pack2(v[14], v[15])};
  *(GAS u32x4*)dst = u0;
  *(GAS u32x4*)(dst + 8) = u1;
}

DI void job_cache(const Params& p, int j) {
  const int tid = otid();
  if (j < 512) {
    const int item = j * 512 + tid;
    const int e = item * 8;
    const int c = e & 511, pos = (e >> 9) & 255, i = (e >> 17) & 1, b = e >> 18;
    const f32x4 a = gld_nt((const f32x4*)(p.in[2] + e)), bq = gld_nt((const f32x4*)(p.in[2] + e + 4));
    u32x4 u; u.x = pack2(a.x, a.y); u.y = pack2(a.z, a.w); u.z = pack2(bq.x, bq.y); u.w = pack2(bq.z, bq.w);
    *(GAS u32x4*)((bf16_t*)(p.ws + OFF_CNK) + ((size_t)(i * 2048 + b * 256 + pos)) * 512 + c) = u;
  } else if (j < 1024) {
    const int item = (j - 512) * 512 + tid;
    const int hd = item & 511, pos8 = (item >> 9) & 31, i = (item >> 14) & 1, b = item >> 15;
    const float* src = p.in[3] + ((size_t)((b * 2 + i) * 256 + pos8 * 8)) * 512 + hd;
    float v[8];
#pragma unroll
    for (int q = 0; q < 8; ++q) v[q] = src[(size_t)q * 512];
    u32x4 u; u.x = pack2(v[0], v[1]); u.y = pack2(v[2], v[3]); u.z = pack2(v[4], v[5]); u.w = pack2(v[6], v[7]);
    *(GAS u32x4*)((bf16_t*)(p.ws + OFF_CNVT) + ((size_t)((i * 8 + b) * 512 + hd)) * 256 + pos8 * 8) = u;
  } else {
    const int item = (j - 1024) * 512 + tid;
    const int e = item * 8;
    const int c = e & 255, pos = (e >> 8) & 255, i = (e >> 16) & 1, b = e >> 17;
    const f32x4 a = gld_nt((const f32x4*)(p.in[4] + e)), bq = gld_nt((const f32x4*)(p.in[4] + e + 4));
    u32x4 u; u.x = pack2(a.x, a.y); u.y = pack2(a.z, a.w); u.z = pack2(bq.x, bq.y); u.w = pack2(bq.z, bq.w);
    *(GAS u32x4*)((bf16_t*)(p.ws + OFF_CCKV) + ((size_t)(i * 2048 + b * 256 + pos)) * 256 + c) = u;
  }
}

DI void job_shw(const Params& p, int j, unsigned char* smem) {
  int l = 0, jj = j;
  if (jj >= 112) { jj -= 112; l = 1; if (jj >= 84) { jj -= 84; l = 2; if (jj >= 112) { jj -= 112; l = 3; } } }
  const int n1 = (l & 1) ? 20 : 48;
  const int which = jj >= n1;
  const int n0 = (which ? jj - n1 : jj) * 64;
  const bf16_t* Wt = which ? (const bf16_t*)(p.ws + OFF_W1T) + (size_t)l * 4096 * 1024
                           : ((l & 1) ? (const bf16_t*)(p.ws + OFF_OWIN) + (size_t)(l >> 1) * 1280 * 1024
                                      : (const bf16_t*)(p.ws + OFF_EWIN) + (size_t)(l >> 1) * 3072 * 1024);
  float* dst = which ? (float*)(p.ws + OFF_SHW2) + (size_t)l * 9 * 4096 : (float*)(p.ws + OFF_SHW1) + (size_t)l * 9 * 3072;
  const int ns = which ? 4096 : 3072;
  const float* mod = (const float*)(p.ws + OFF_MOD) + (size_t)l * 9 * 6144 + (which ? 3072 : 0);
  const int tid = otid(), lane = tid & 63, w = tid >> 6;
  float* s = (float*)smem;
  __syncthreads();
  for (int idx = tid; idx < 9 * 1024; idx += 512) s[idx] = mod[(idx >> 10) * 6144 + (idx & 1023)];
  __syncthreads();
  const bf16_t* wr = Wt + (size_t)(n0 + lane) * 1024 + w * 128;
  float acc[9];
#pragma unroll
  for (int mi = 0; mi < 9; ++mi) acc[mi] = 0.f;
#pragma unroll 2
  for (int c = 0; c < 16; ++c) {
    const u32x4 u = gld((const u32x4*)(wr + c * 8));
    const float wv[8] = {bflo(u.x), bfhi(u.x), bflo(u.y), bfhi(u.y), bflo(u.z), bfhi(u.z), bflo(u.w), bfhi(u.w)};
#pragma unroll
    for (int q = 0; q < 8; ++q)
#pragma unroll
      for (int mi = 0; mi < 9; ++mi) acc[mi] += s[mi * 1024 + w * 128 + c * 8 + q] * wv[q];
  }
  __syncthreads();
  float* red = (float*)smem;
#pragma unroll
  for (int mi = 0; mi < 9; ++mi) red[(w * 9 + mi) * 64 + lane] = acc[mi];
  __syncthreads();
  for (int idx = tid; idx < 9 * 64; idx += 512) {
    const int mi = idx >> 6, ln = idx & 63;
    float v = 0.f;
#pragma unroll
    for (int q = 0; q < 8; ++q) v += red[(q * 9 + mi) * 64 + ln];
    dst[(size_t)mi * ns + n0 + ln] = v;
  }
}

DI void job_xpass(const Params& p, int j) {
  const int tid = otid(), lane = tid & 63, w = tid >> 6;
  const int m = j * 8 + w, mi = mi_of(m);
  const float* x = m < TP ? p.in[0] + (size_t)m * 1024 : p.in[1] + (size_t)(m - TP) * 1024;
  const float* g1 = p.in[10];
  const float* sc = (const float*)(p.ws + OFF_MOD) + (size_t)mi * 6144 + 1024;
  float* y = p.out + OUT_Y + (size_t)m * 1024;
  bf16_t* ab = (bf16_t*)(p.ws + OFF_ABUF) + (size_t)m * 1024;
  float ss = 0.f;
#pragma unroll
  for (int i = 0; i < 4; ++i) {
    const int k = lane * 4 + 256 * i;
    const f32x4 v = gld_nt((const f32x4*)(x + k));
    const f32x4 g = gld((const f32x4*)(g1 + k));
    const f32x4 s4 = gld((const f32x4*)(sc + k));
    ss += v.x * v.x + v.y * v.y + v.z * v.z + v.w * v.w;
    *(GAS f32x4*)(y + k) = v;
    store_bf4(ab + k, v.x * g.x * (1.f + s4.x), v.y * g.y * (1.f + s4.y), v.z * g.z * (1.f + s4.z), v.w * g.w * (1.f + s4.w));
  }
  ss = sum16(ss); ss += __shfl_xor(ss, 16, 64); ss = hsum32(ss);
  float* ssq = (float*)(p.ws + OFF_SSQ1);
  if (lane < 16) ssq[(size_t)lane * T + m] = lane == 0 ? ss : 0.f;
}

DI void job_conv(const Params& p, int j, int li) {
  const int item = j * 512 + otid();
  const int m = item >> 6, c = (item & 63) * 8;
  const bf16_t* bc = (const bf16_t*)(p.ws + OFF_BCONV);
  int pos, L;
  if (m < TP) { pos = m & 255; L = 256; } else { pos = (m - TP) & 1023; L = 1024; }
  const float* cw = p.in[15] + (size_t)li * 3 * 512 + c;
  float accv[8];
#pragma unroll
  for (int q = 0; q < 8; ++q) accv[q] = 0.f;
#pragma unroll
  for (int d = -1; d <= 1; ++d) {
    const int pp = pos + d;
    if (pp < 0 || pp >= L) continue;
    const u32x4 cg = gld((const u32x4*)(bc + (size_t)(m + d) * 1536 + 512 + c));
    const u32x4 xa = gld((const u32x4*)(bc + (size_t)(m + d) * 1536 + 1024 + c));
    const f32x4 w0 = gld((const f32x4*)(cw + (d + 1) * 512)), w1 = gld((const f32x4*)(cw + (d + 1) * 512 + 4));
    accv[0] += bflo(cg.x) * bflo(xa.x) * w0.x; accv[1] += bfhi(cg.x) * bfhi(xa.x) * w0.y;
    accv[2] += bflo(cg.y) * bflo(xa.y) * w0.z; accv[3] += bfhi(cg.y) * bfhi(xa.y) * w0.w;
    accv[4] += bflo(cg.z) * bflo(xa.z) * w1.x; accv[5] += bfhi(cg.z) * bfhi(xa.z) * w1.y;
    accv[6] += bflo(cg.w) * bflo(xa.w) * w1.z; accv[7] += bfhi(cg.w) * bfhi(xa.w) * w1.w;
  }
  const u32x4 bg = gld((const u32x4*)(bc + (size_t)m * 1536 + c));
  u32x4 u;
  u.x = pack2(bflo(bg.x) * accv[0], bfhi(bg.x) * accv[1]); u.y = pack2(bflo(bg.y) * accv[2], bfhi(bg.y) * accv[3]);
  u.z = pack2(bflo(bg.z) * accv[4], bfhi(bg.z) * accv[5]); u.w = pack2(bflo(bg.w) * accv[6], bfhi(bg.w) * accv[7]);
  *(GAS u32x4*)((bf16_t*)(p.ws + OFF_CAT) + (size_t)m * 1024 + c) = u;
}

DI void job_poolx(const Params& p, int j) {
  const int item = j * 512 + otid();
  const int m = item >> 6, c = (item & 63) * 8;
  const bf16_t* ub = (const bf16_t*)(p.ws + OFF_UBUF);
  int pos, L;
  if (m < TP) { pos = m & 255; L = 256; } else { pos = (m - TP) & 1023; L = 1024; }
  const int wsz = 2 << (c >> 7);
  const int lo = min(max(pos - wsz / 2, 0), L), hi = min(max(pos - wsz / 2 + wsz, 0), L);
  float s[8];
#pragma unroll
  for (int q = 0; q < 8; ++q) s[q] = 0.f;
  u32x4 uu[16];
#pragma unroll
  for (int q = 0; q < 16; ++q) {
    const u32x4 z = {0u, 0u, 0u, 0u};
    uu[q] = (lo + q < hi) ? gld((const u32x4*)(ub + (size_t)(m + lo + q - pos) * 512 + c)) : z;
  }
#pragma unroll
  for (int q = 0; q < 16; ++q) {
    const u32x4 u = uu[q];
    s[0] += bflo(u.x); s[1] += bfhi(u.x); s[2] += bflo(u.y); s[3] += bfhi(u.y); s[4] += bflo(u.z); s[5] += bfhi(u.z); s[6] += bflo(u.w); s[7] += bfhi(u.w);
  }
  const float inv = 1.f / (float)(hi - lo);
  const u32x4 u = gld((const u32x4*)(ub + (size_t)m * 512 + c));
  u32x4 o;
  o.x = pack2(s[0] * inv - bflo(u.x), s[1] * inv - bfhi(u.x)); o.y = pack2(s[2] * inv - bflo(u.y), s[3] * inv - bfhi(u.y));
  o.z = pack2(s[4] * inv - bflo(u.z), s[5] * inv - bfhi(u.z)); o.w = pack2(s[6] * inv - bflo(u.w), s[7] * inv - bfhi(u.w));
  *(GAS u32x4*)((bf16_t*)(p.ws + OFF_CAT) + (size_t)m * 1024 + c) = o;
}

DI void job_ckvstate(const Params& p, int j, int li) {
  const int item = j * 512 + otid();
  const int m = item >> 6, c = (item & 63) * 4;
  const float rs = rstd_parts<2>((const float*)(p.ws + OFF_SSQKV), m, 1.f / 256.f);
  float* o = p.out + OUT_CKV + ((size_t)(((m >> 8) * 2 + li) * 256 + (m & 255))) * 256 + c;
  const f32x4 g = gld((const f32x4*)(p.in[25] + li * 256 + c));
  f32x4 v = gld((const f32x4*)((const float*)(p.ws + OFF_KVRAW) + (size_t)m * 256 + c));
  v.x *= rs * g.x; v.y *= rs * g.y; v.z *= rs * g.z; v.w *= rs * g.w;
  *(GAS f32x4*)o = v;
}

__global__ void __launch_bounds__(NTHREADS, 2) fwd_megakernel(Params p) {
  __shared__ __attribute__((aligned(16))) unsigned char smem[SMEM_BYTES];
  __shared__ u32x4 xb_words;
  cg::grid_group grid = cg::this_grid();
  if (p.pad_ == 0x7fffffff) grid.sync();
  if (threadIdx.x == 0) { const u32x4 z = {0u, 0u, 0u, 0u}; xb_words = z; }
  __syncthreads();
  const XcdBarrier xb = xcd_barrier_post((unsigned*)(p.ws + OFF_BAR), (volatile LAS unsigned*)&xb_words);
  const int nb = gridDim.x, bid = blockIdx.x;
  unsigned char* const ws_ = p.ws;
  float* const out_ = p.out;

#ifndef SKIP_PH0
  for (int rep_ = 0; rep_ < REP_PH0; ++rep_) {
    const int n_mod = 384, n_conv = p.conv_tiles, n_cache = 1280;
    for (int j = bid; j < n_mod + n_conv + n_cache; j += nb) {
      if (j < n_mod) { for (int q_ = 0; q_ < REP_MODS; ++q_) job_mods(p, j, smem); }
      else if (j < n_mod + n_conv) { for (int q_ = 0; q_ < REP_WCONV; ++q_) job_wconv(p, j - n_mod); }
      else { for (int q_ = 0; q_ < REP_CACHE; ++q_) job_cache(p, j - n_mod - n_conv); }
    }
  }
#endif
  xcd_barrier(xb);
#ifndef SKIP_PH1
  for (int rep_ = 0; rep_ < REP_PH1; ++rep_) {
    for (int j = bid; j < 392 + 1536; j += nb) {
      if (j < 392) job_shw(p, j, smem); else job_xpass(p, j - 392);
    }
  }
#endif
  xcd_barrier(xb);

#pragma unroll 1
  for (int l = 0; l < 4; ++l) {
    const int li = l >> 1;
    if ((l & 1) == 0) {
#ifndef SKIP_E2
      for (int rep_ = 0; rep_ < REP_E2; ++rep_) {
        unsigned char* ws = uniform_ptr(ws_); float* ybuf = (float*)uniform_ptr(out_); asm volatile("" : "+s"(ws), "+s"(ybuf));
        float* mod = (float*)(ws + OFF_MOD); bf16_t* abuf = (bf16_t*)(ws + OFF_ABUF); bf16_t* cat = (bf16_t*)(ws + OFF_CAT); bf16_t* act = (bf16_t*)(ws + OFF_ACT);
        float* ssq1 = (float*)(ws + OFF_SSQ1); float* ssq2 = (float*)(ws + OFF_SSQ2); const float* modl = mod + (size_t)l * 9 * 6144;
        (void)mod; (void)abuf; (void)cat; (void)act; (void)ssq1; (void)ssq2; (void)modl; (void)ybuf;
        EpiEvenIn e;
        e.ssq = ssq1; e.shw = (const float*)(ws + OFF_SHW1) + (size_t)l * 9 * 3072; e.gq = p.in[16] + li * 64; e.gk = p.in[17] + li * 64;
        e.bconv = (bf16_t*)(ws + OFF_BCONV); e.qbuf = (bf16_t*)(ws + OFF_QBUF); e.kbuf = (bf16_t*)(ws + OFF_KBUF);
        e.vtp = (bf16_t*)(ws + OFF_VTP); e.vts = (bf16_t*)(ws + OFF_VTS); e.out_k = ybuf + OUT_NAK; e.out_v = ybuf + OUT_NAV; e.li = li;
        const bf16_t* W = (const bf16_t*)(ws + OFF_EWIN) + (size_t)li * 3072 * 1024;
        for (int t = bid; t < 64 * 12; t += nb) gemm_tile<192, 4>(abuf, 1024, W, 1024, (t % 64) * 192, (t / 64) * 256, e, smem);
      }
#endif
      xcd_barrier(xb);
#ifndef SKIP_E3
      for (int rep_ = 0; rep_ < REP_E3; ++rep_) {
        unsigned char* ws = uniform_ptr(ws_); float* ybuf = (float*)uniform_ptr(out_); asm volatile("" : "+s"(ws), "+s"(ybuf));
        float* mod = (float*)(ws + OFF_MOD); bf16_t* abuf = (bf16_t*)(ws + OFF_ABUF); bf16_t* cat = (bf16_t*)(ws + OFF_CAT); bf16_t* act = (bf16_t*)(ws + OFF_ACT);
        float* ssq1 = (float*)(ws + OFF_SSQ1); float* ssq2 = (float*)(ws + OFF_SSQ2); const float* modl = mod + (size_t)l * 9 * 6144;
        (void)mod; (void)abuf; (void)cat; (void)act; (void)ssq1; (void)ssq2; (void)modl; (void)ybuf;
        const bf16_t* qb = (const bf16_t*)(ws + OFF_QBUF); const bf16_t* kb = (const bf16_t*)(ws + OFF_KBUF);
        const bf16_t* vtp = (const bf16_t*)(ws + OFF_VTP); const bf16_t* vts = (const bf16_t*)(ws + OFF_VTS);
        const bf16_t* cnk = (const bf16_t*)(ws + OFF_CNK) + (size_t)li * 2048 * 512;
        const bf16_t* cnvt = (const bf16_t*)(ws + OFF_CNVT) + (size_t)li * 2048 * 512;
        for (int j = bid; j < 256 + 128 + 1536; j += nb) {
          if (j < 256) {
            const int rq = j & 3, hd = (j >> 2) & 7, b = j >> 5;
            const int tok0 = TP + b * 1024 + rq * 256;
            const int kr0 = min(max(4 * rq - 4, 0), 8), kr1 = min(max(4 * rq + 3 - 4, 0), 8) + 8;
            attn_task<64>(qb + (size_t)tok0 * 512 + hd * 64, 512,
                          kb + (size_t)(TP + b * 1024 + kr0 * 64) * 512 + hd * 64, 512, vts + ((size_t)(b * 8 + hd) * 64) * 1024 + kr0 * 64, 1024, kr1 - kr0,
                          cnk + (size_t)(b * 256) * 512 + hd * 64, 512, cnvt + ((size_t)(b * 8 + hd) * 64) * 256, 256, 4,
                          true, 4 * rq, kr0, p.in[18] + (size_t)(li * 8 + hd) * 465,
                          cat + (size_t)tok0 * 1024 + 512 + hd * 64, 1024, 0.125f, smem);
          } else if (j < 384) {
            const int jj = j - 256, hd = jj & 7, b = jj >> 3;
            const int tok0 = b * 256;
            attn_task<64>(qb + (size_t)tok0 * 512 + hd * 64, 512,
                          kb + (size_t)(b * 256) * 512 + hd * 64, 512, vtp + ((size_t)(b * 8 + hd) * 64) * 256, 256, 4,
                          kb, 512, vtp, 256, 0,
                          false, 0, 0, p.in[18],
                          cat + (size_t)tok0 * 1024 + 512 + hd * 64, 1024, 0.125f, smem);
          } else job_conv(p, j - 384, li);
        }
      }
#endif
      xcd_barrier(xb);
#ifndef SKIP_E4
      {
        unsigned char* ws = uniform_ptr(ws_); float* ybuf = (float*)uniform_ptr(out_); asm volatile("" : "+s"(ws), "+s"(ybuf));
        float* mod = (float*)(ws + OFF_MOD); bf16_t* abuf = (bf16_t*)(ws + OFF_ABUF); bf16_t* cat = (bf16_t*)(ws + OFF_CAT); bf16_t* act = (bf16_t*)(ws + OFF_ACT);
        float* ssq1 = (float*)(ws + OFF_SSQ1); float* ssq2 = (float*)(ws + OFF_SSQ2); const float* modl = mod + (size_t)l * 9 * 6144;
        (void)mod; (void)abuf; (void)cat; (void)act; (void)ssq1; (void)ssq2; (void)modl; (void)ybuf;
        EpiResid e; e.gscale = 1.f; e.y = ybuf; e.gate = modl + 2048; e.ng = p.in[11] + l * 1024; e.nsc = modl + 4096; e.abuf = abuf; e.ssq_out = ssq2;
        const bf16_t* W = (const bf16_t*)(ws + OFF_EWOUT) + (size_t)li * 1024 * 1024;
#if PROBE_RESID
        e.gscale = 0.f;
        for (int t = bid; t < 64 * 4; t += nb) gemm_tile<192, 4>(cat, 1024, W, 1024, (t % 64) * 192, (t / 64) * 256, e, smem);
        e.gscale = 1.f; __syncthreads();
#endif
        for (int t = bid; t < 64 * 4; t += nb) gemm_tile<192, 4>(cat, 1024, W, 1024, (t % 64) * 192, (t / 64) * 256, e, smem);
      }
#endif
      xcd_barrier(xb);
    } else {
#ifndef SKIP_O2
      for (int rep_ = 0; rep_ < REP_O2; ++rep_) {
        unsigned char* ws = uniform_ptr(ws_); float* ybuf = (float*)uniform_ptr(out_); asm volatile("" : "+s"(ws), "+s"(ybuf));
        float* mod = (float*)(ws + OFF_MOD); bf16_t* abuf = (bf16_t*)(ws + OFF_ABUF); bf16_t* cat = (bf16_t*)(ws + OFF_CAT); bf16_t* act = (bf16_t*)(ws + OFF_ACT);
        float* ssq1 = (float*)(ws + OFF_SSQ1); float* ssq2 = (float*)(ws + OFF_SSQ2); const float* modl = mod + (size_t)l * 9 * 6144;
        (void)mod; (void)abuf; (void)cat; (void)act; (void)ssq1; (void)ssq2; (void)modl; (void)ybuf;
        EpiOddIn e;
        e.ssq = ssq1; e.shw = (const float*)(ws + OFF_SHW1) + (size_t)l * 9 * 3072; e.ubuf = (bf16_t*)(ws + OFF_UBUF); e.qlat = (bf16_t*)(ws + OFF_QLAT);
        e.kvlat = (bf16_t*)(ws + OFF_KVLAT); e.kpebuf = (float*)(ws + OFF_KPE); e.ssqq = (float*)(ws + OFF_SSQQ); e.ssqkv = (float*)(ws + OFF_SSQKV);
        e.out_ckv = (float*)(ws + OFF_KVRAW); e.out_kpe = ybuf + OUT_KPE; e.li = li;
        const bf16_t* W = (const bf16_t*)(ws + OFF_OWIN) + (size_t)li * 1280 * 1024;
        for (int t = bid; t < 48 * 5; t += nb) gemm_tile<256, 2>(abuf, 1024, W, 1024, (t % 48) * 256, (t / 48) * 256, e, smem);
      }
#endif
      xcd_barrier(xb);
#ifndef SKIP_O3
      for (int rep_ = 0; rep_ < REP_O3; ++rep_) {
        unsigned char* ws = uniform_ptr(ws_); float* ybuf = (float*)uniform_ptr(out_); asm volatile("" : "+s"(ws), "+s"(ybuf));
        float* mod = (float*)(ws + OFF_MOD); bf16_t* abuf = (bf16_t*)(ws + OFF_ABUF); bf16_t* cat = (bf16_t*)(ws + OFF_CAT); bf16_t* act = (bf16_t*)(ws + OFF_ACT);
        float* ssq1 = (float*)(ws + OFF_SSQ1); float* ssq2 = (float*)(ws + OFF_SSQ2); const float* modl = mod + (size_t)l * 9 * 6144;
        (void)mod; (void)abuf; (void)cat; (void)act; (void)ssq1; (void)ssq2; (void)modl; (void)ybuf;
        EpiKvUp ek; ek.ssqkv = (const float*)(ws + OFF_SSQKV); ek.gk = p.in[28] + li * 96; ek.kpebuf = (const float*)(ws + OFF_KPE); ek.cache_kpe = p.in[5];
        ek.kpm = (bf16_t*)(ws + OFF_KPM); ek.ksm = (bf16_t*)(ws + OFF_KSM); ek.vtpm = (bf16_t*)(ws + OFF_VTPM); ek.vtsm = (bf16_t*)(ws + OFF_VTSM); ek.li = li; ek.cache = 0;
        EpiQUp eq; eq.ssqq = (const float*)(ws + OFF_SSQQ); eq.gq = p.in[27] + li * 96; eq.qmla = (bf16_t*)(ws + OFF_QMLA);
        const bf16_t* Wkv = (const bf16_t*)(ws + OFF_WKVB) + (size_t)li * 1024 * 256;
        const bf16_t* Wq = (const bf16_t*)(ws + OFF_WQB) + (size_t)li * 1024 * 384;
        const bf16_t* cckv = (const bf16_t*)(ws + OFF_CCKV) + (size_t)li * 2048 * 256;
        for (int j = bid; j < 448 + 384 + 1536 + 512; j += nb) {
          if (j < 448) {
            const int mt = j % 112, nt = j / 112;
            const bool cch = mt >= 96;
            ek.cache = cch ? 1 : 0;
            gemm_tile<128, 2>(cch ? cckv : (const bf16_t*)(ws + OFF_KVLAT), 256, Wkv, 256, (cch ? mt - 96 : mt) * 128, nt * 256, ek, smem);
          } else if (j < 448 + 384) {
            const int jj = j - 448;
            gemm_tile<128, 2>((const bf16_t*)(ws + OFF_QLAT), 384, Wq, 384, (jj % 96) * 128, (jj / 96) * 256, eq, smem);
          } else if (j < 448 + 384 + 1536) job_poolx(p, j - 448 - 384);
          else job_ckvstate(p, j - 448 - 384 - 1536, li);
        }
      }
#endif
      xcd_barrier(xb);
#ifndef SKIP_O4
      for (int rep_ = 0; rep_ < REP_O4; ++rep_) {
        unsigned char* ws = uniform_ptr(ws_); float* ybuf = (float*)uniform_ptr(out_); asm volatile("" : "+s"(ws), "+s"(ybuf));
        float* mod = (float*)(ws + OFF_MOD); bf16_t* abuf = (bf16_t*)(ws + OFF_ABUF); bf16_t* cat = (bf16_t*)(ws + OFF_CAT); bf16_t* act = (bf16_t*)(ws + OFF_ACT);
        float* ssq1 = (float*)(ws + OFF_SSQ1); float* ssq2 = (float*)(ws + OFF_SSQ2); const float* modl = mod + (size_t)l * 9 * 6144;
        (void)mod; (void)abuf; (void)cat; (void)act; (void)ssq1; (void)ssq2; (void)modl; (void)ybuf;
        const bf16_t* qm = (const bf16_t*)(ws + OFF_QMLA);
        const bf16_t* kpm = (const bf16_t*)(ws + OFF_KPM); const bf16_t* ksm = (const bf16_t*)(ws + OFF_KSM);
        const bf16_t* vtpm = (const bf16_t*)(ws + OFF_VTPM); const bf16_t* vtsm = (const bf16_t*)(ws + OFF_VTSM);
        const float sc = 0.10206207261596575f;
        for (int j = bid; j < 256 + 128; j += nb) {
          if (j < 256) {
            const int qb2 = j & 3, hd = (j >> 2) & 7, b = j >> 5;
            const int tok0 = TP + b * 1024 + qb2 * 256;
            attn_task<96>(qm + (size_t)tok0 * 768 + hd * 96, 768,
                          ksm + ((size_t)(b * 8 + hd) * 1280) * 96, 96, vtsm + ((size_t)(b * 8 + hd) * 64) * 1280, 1280, 20,
                          ksm, 96, vtsm, 1280, 0, false, 0, 0, p.in[18],
                          cat + (size_t)tok0 * 1024 + 512 + hd * 64, 1024, sc, smem);
          } else if (j < 384) {
            const int jj = j - 256, hd = jj & 7, b = jj >> 3;
            const int tok0 = b * 256;
            attn_task<96>(qm + (size_t)tok0 * 768 + hd * 96, 768,
                          kpm + ((size_t)(b * 8 + hd) * 256) * 96, 96, vtpm + ((size_t)(b * 8 + hd) * 64) * 256, 256, 4,
                          kpm, 96, vtpm, 256, 0, false, 0, 0, p.in[18],
                          cat + (size_t)tok0 * 1024 + 512 + hd * 64, 1024, sc, smem);
          }
        }
      }
#endif
      xcd_barrier(xb);
#ifndef SKIP_O5
      {
        unsigned char* ws = uniform_ptr(ws_); float* ybuf = (float*)uniform_ptr(out_); asm volatile("" : "+s"(ws), "+s"(ybuf));
        float* mod = (float*)(ws + OFF_MOD); bf16_t* abuf = (bf16_t*)(ws + OFF_ABUF); bf16_t* cat = (bf16_t*)(ws + OFF_CAT); bf16_t* act = (bf16_t*)(ws + OFF_ACT);
        float* ssq1 = (float*)(ws + OFF_SSQ1); float* ssq2 = (float*)(ws + OFF_SSQ2); const float* modl = mod + (size_t)l * 9 * 6144;
        (void)mod; (void)abuf; (void)cat; (void)act; (void)ssq1; (void)ssq2; (void)modl; (void)ybuf;
        EpiResid e; e.gscale = 1.f; e.y = ybuf; e.gate = modl + 2048; e.ng = p.in[11] + l * 1024; e.nsc = modl + 4096; e.abuf = abuf; e.ssq_out = ssq2;
        const bf16_t* W = (const bf16_t*)(ws + OFF_OWOUT) + (size_t)li * 1024 * 1024;
#if PROBE_RESID
        e.gscale = 0.f;
        for (int t = bid; t < 64 * 4; t += nb) gemm_tile<192, 4>(cat, 1024, W, 1024, (t % 64) * 192, (t / 64) * 256, e, smem);
        e.gscale = 1.f; __syncthreads();
#endif
        for (int t = bid; t < 64 * 4; t += nb) gemm_tile<192, 4>(cat, 1024, W, 1024, (t % 64) * 192, (t / 64) * 256, e, smem);
      }
#endif
      xcd_barrier(xb);
    }
#ifndef SKIP_M1
    {
        unsigned char* ws = uniform_ptr(ws_); float* ybuf = (float*)uniform_ptr(out_); asm volatile("" : "+s"(ws), "+s"(ybuf));
        float* mod = (float*)(ws + OFF_MOD); bf16_t* abuf = (bf16_t*)(ws + OFF_ABUF); bf16_t* cat = (bf16_t*)(ws + OFF_CAT); bf16_t* act = (bf16_t*)(ws + OFF_ACT);
        float* ssq1 = (float*)(ws + OFF_SSQ1); float* ssq2 = (float*)(ws + OFF_SSQ2); const float* modl = mod + (size_t)l * 9 * 6144;
        (void)mod; (void)abuf; (void)cat; (void)act; (void)ssq1; (void)ssq2; (void)modl; (void)ybuf;
      EpiMlp1 e; e.ssq = ssq2; e.shw = (const float*)(ws + OFF_SHW2) + (size_t)l * 9 * 4096; e.act = act;
      const bf16_t* W = (const bf16_t*)(ws + OFF_W1T) + (size_t)l * 4096 * 1024;
#if PROBE_M1 == 1
      for (int t = bid; t < 48 * 16; t += nb) gemm_tile<256, 2>(abuf, 1024, W, 1024, (t % 48) * 256, (t / 48) * 256, e, smem);
#elif PROBE_M1 == 2
      for (int t = bid; t < 48 * 16; t += nb) gemm_tile<256, 2, true>(abuf, 1024, W, 1024, (t % 48) * 256, (t / 48) * 256, e, smem);
#endif
      for (int t = bid; t < 48 * 16; t += nb) gemm_tile<256, 2>(abuf, 1024, W, 1024, (t % 48) * 256, (t / 48) * 256, e, smem);
    }
#endif
    xcd_barrier(xb);
#ifndef SKIP_M2
    {
        unsigned char* ws = uniform_ptr(ws_); float* ybuf = (float*)uniform_ptr(out_); asm volatile("" : "+s"(ws), "+s"(ybuf));
        float* mod = (float*)(ws + OFF_MOD); bf16_t* abuf = (bf16_t*)(ws + OFF_ABUF); bf16_t* cat = (bf16_t*)(ws + OFF_CAT); bf16_t* act = (bf16_t*)(ws + OFF_ACT);
        float* ssq1 = (float*)(ws + OFF_SSQ1); float* ssq2 = (float*)(ws + OFF_SSQ2); const float* modl = mod + (size_t)l * 9 * 6144;
        (void)mod; (void)abuf; (void)cat; (void)act; (void)ssq1; (void)ssq2; (void)modl; (void)ybuf;
      EpiResid e; e.gscale = 1.f; e.y = ybuf; e.gate = modl + 5120;
      if (l < 3) { e.ng = p.in[10] + (l + 1) * 1024; e.nsc = mod + (size_t)(l + 1) * 9 * 6144 + 1024; } else { e.ng = nullptr; e.nsc = nullptr; }
      e.abuf = abuf; e.ssq_out = ssq1;
      const bf16_t* W = (const bf16_t*)(ws + OFF_W2T) + (size_t)l * 1024 * 4096;
#if PROBE_M2
      e.gscale = 0.f;
      for (int t = bid; t < 64 * 4; t += nb) gemm_tile<192, 4>(act, 4096, W, 4096, (t % 64) * 192, (t / 64) * 256, e, smem);
      e.gscale = 1.f; __syncthreads();
#endif
      for (int t = bid; t < 64 * 4; t += nb) gemm_tile<192, 4>(act, 4096, W, 4096, (t % 64) * 192, (t / 64) * 256, e, smem);
    }
#endif
    if (l < 3) xcd_barrier(xb);
  }
}

static void add_mat(Params& p, int& idx, int& tiles, const float* src, const float* rscale, size_t dst, int K, int N, int Npad, int headpad, int blockdiag) {
  MatDesc& m = p.mats[idx++];
  m.src = src; m.rscale = rscale; m.dst = dst; m.K = K; m.N = N; m.Npad = Npad; m.headpad = headpad; m.tile0 = tiles; m.blockdiag = blockdiag;
  tiles += (K / 128) * (Npad / 64);
}

extern "C" void kernel_launch(void* const* d_in, const int* in_sizes, int n_in, void* d_out, int out_size, void* d_ws, size_t ws_size, hipStream_t stream) {
  if (ws_size < WS_NEED) { fprintf(stderr, "kernel_launch: workspace too small (%zu < %zu)\n", ws_size, (size_t)WS_NEED); return; }
  static int grid_blocks = 0;
  if (!grid_blocks) {
    int dev = 0, cus = 0, per_cu = 0;
    (void)hipGetDevice(&dev);
    (void)hipDeviceGetAttribute(&cus, hipDeviceAttributeMultiprocessorCount, dev);
    (void)hipOccupancyMaxActiveBlocksPerMultiprocessor(&per_cu, fwd_megakernel, NTHREADS, 0);
    if (per_cu < 1) fprintf(stderr, "kernel_launch: occupancy query reports %d blocks per CU\n", per_cu);
    grid_blocks = cus;
  }
  Params p;
  memset(&p, 0, sizeof(p));
  for (int i = 0; i < 30; ++i) p.in[i] = (const float*)d_in[i];
  p.out = (float*)d_out; p.ws = (unsigned char*)d_ws;
  int idx = 0, tiles = 0;
  for (int i = 0; i < 2; ++i) add_mat(p, idx, tiles, p.in[29] + (size_t)i * 1024 * 1024, nullptr, OFF_OWOUT + (size_t)i * 1024 * 1024 * 2, 1024, 1024, 1024, 0, 2 + i);
  for (int l = 0; l < 4; ++l) add_mat(p, idx, tiles, p.in[12] + (size_t)l * 1024 * 4096, nullptr, OFF_W1T + (size_t)l * 4096 * 1024 * 2, 1024, 4096, 4096, 0, 0);
  for (int l = 0; l < 4; ++l) add_mat(p, idx, tiles, p.in[13] + (size_t)l * 4096 * 1024, nullptr, OFF_W2T + (size_t)l * 4096 * 1024 * 2, 4096, 1024, 1024, 0, 0);
  for (int i = 0; i < 2; ++i) add_mat(p, idx, tiles, p.in[14] + (size_t)i * 1024 * 3072, nullptr, OFF_EWIN + (size_t)i * 3072 * 1024 * 2, 1024, 3072, 3072, 0, 0);
  for (int i = 0; i < 2; ++i) add_mat(p, idx, tiles, p.in[19] + (size_t)i * 1024 * 1024, nullptr, OFF_EWOUT + (size_t)i * 1024 * 1024 * 2, 1024, 1024, 1024, 0, 0);
  for (int i = 0; i < 2; ++i) add_mat(p, idx, tiles, p.in[20] + (size_t)i * 1024 * 1184, nullptr, OFF_OWIN + (size_t)i * 1280 * 1024 * 2, 1024, 1184, 1280, 0, 0);
  for (int i = 0; i < 2; ++i) add_mat(p, idx, tiles, p.in[24] + (size_t)i * 384 * 768, p.in[23] + i * 384, OFF_WQB + (size_t)i * 1024 * 384 * 2, 384, 768, 1024, 1, 0);
  for (int i = 0; i < 2; ++i) add_mat(p, idx, tiles, p.in[26] + (size_t)i * 256 * 1024, p.in[25] + i * 256, OFF_WKVB + (size_t)i * 1024 * 256 * 2, 256, 1024, 1024, 0, 0);
  p.conv_tiles = tiles;
  if (hipMemsetAsync((unsigned char*)d_ws + OFF_BAR, 0, 16384, stream) != hipSuccess) { fprintf(stderr, "kernel_launch: memset of barrier words failed\n"); return; }
  void* args[] = {&p};
  hipError_t e = hipLaunchCooperativeKernel((void*)fwd_megakernel, dim3(grid_blocks), dim3(NTHREADS), args, 0, stream);
  if (e != hipSuccess) fprintf(stderr, "cooperative launch failed: %s (grid %d)\n", hipGetErrorString(e), grid_blocks);
}
```
